# Optimizing an MI355X kernel written in HIP

```python
import math
import jax, jax.numpy as jnp
from jax import lax
import numpy as np

D_MODEL = 2048
BATCH = 1
SEQ = 8192
DEPTH = 2

HEAD_DIM = 128
FOX_HEADS = 6
GLA_HEADS = 4
DSA_HEADS = 6
FOX_W = FOX_HEADS * HEAD_DIM
GLA_DK = HEAD_DIM
GLA_DV = HEAD_DIM
GLA_W = GLA_HEADS * GLA_DV
DSA_W = DSA_HEADS * HEAD_DIM
MIX_W = FOX_W + GLA_W + DSA_W
Q_BLOCK = 128
GLA_GATE_RANK = 16
GLA_GATE_TAU = 16.0
GLA_CHUNK = 64
IDX_HEADS = 16
IDX_DIM = 64
DSA_MAX_TOPK = 256
PEER_HEADS = 8
PEER_DQ = 256
PEER_DHALF = PEER_DQ // 2
PEER_NKEYS = 128
PEER_EXPERTS = PEER_NKEYS * PEER_NKEYS
PEER_TOPK = 16
PEER_BLOCK = 64
RMS_EPS = 1e-6
N_MOD = 6

IN_SIZES = (
    FOX_W, FOX_W, FOX_W, FOX_HEADS,
    GLA_HEADS * GLA_DK, GLA_HEADS * GLA_DK, GLA_W, GLA_W, GLA_GATE_RANK,
    DSA_W, DSA_W, DSA_W,
    IDX_HEADS * IDX_DIM, IDX_DIM, IDX_HEADS,
)
N_IN = sum(IN_SIZES)

kernel_name = 'hybrid_fox_gla_dsa_peer'


def rmsnorm(x, g):
    xf = x.astype(jnp.float32)
    y = xf * lax.rsqrt(jnp.mean(xf * xf, axis=-1, keepdims=True) + RMS_EPS)
    return (y * g.astype(jnp.float32)).astype(x.dtype)


def split_cols(z):
    parts, o = [], 0
    for n in IN_SIZES:
        parts.append(z[..., o:o + n])
        o += n
    return parts


def fox_attention(q, k, v, f_logit, f_bias):
    B, S, H, dh = q.shape
    logf = jax.nn.log_sigmoid(f_logit.astype(jnp.float32) + f_bias.astype(jnp.float32))
    F = jnp.cumsum(logf, axis=1).transpose(0, 2, 1)
    kh = k.transpose(0, 2, 1, 3)
    vh = v.transpose(0, 2, 1, 3)
    scale = dh ** -0.5
    kpos = jnp.arange(S)

    def block(i):
        start = i * Q_BLOCK
        qb = lax.dynamic_slice_in_dim(q, start, Q_BLOCK, axis=1)
        Fq = lax.dynamic_slice_in_dim(F, start, Q_BLOCK, axis=2)
        s = jnp.einsum('bthd,bhsd->bhts', qb, kh).astype(jnp.float32) * scale
        s = s + Fq[..., :, None] - F[..., None, :]
        qpos = start + jnp.arange(Q_BLOCK)
        causal = kpos[None, :] <= qpos[:, None]
        s = jnp.where(causal, s, -jnp.inf)
        p = jax.nn.softmax(s, axis=-1).astype(v.dtype)
        return jnp.einsum('bhts,bhsd->bthd', p, vh)

    out = lax.map(block, jnp.arange(S // Q_BLOCK))
    return out.transpose(1, 0, 2, 3, 4).reshape(B, S, H * dh)


def gla_attention(q, k, v, log_a):
    B, S, H, dk = q.shape
    dv = v.shape[-1]
    C = GLA_CHUNK
    n = S // C

    def chunks(t):
        return t.astype(jnp.float32).reshape(B, n, C, H, t.shape[-1]).transpose(1, 0, 3, 2, 4)

    qc = chunks(q) * (dk ** -0.5)
    kc = chunks(k)
    vc = chunks(v)
    gc = jnp.cumsum(chunks(log_a), axis=3)
    tri = jnp.tril(jnp.ones((C, C), dtype=bool))

    def step(state, inp):
        qi, ki, vi, gi = inp
        inter = jnp.einsum('bhtd,bhde->bhte', qi * jnp.exp(gi), state)
        diff = gi[:, :, :, None, :] - gi[:, :, None, :, :]
        decay = jnp.exp(jnp.where(tri[:, :, None], diff, -jnp.inf))
        A = jnp.einsum('bhtd,bhsd,bhtsd->bhts', qi, ki, decay)
        intra = jnp.einsum('bhts,bhse->bhte', A, vi)
        glast = gi[:, :, -1:, :]
        state = jnp.exp(glast[:, :, 0, :])[..., None] * state + jnp.einsum(
            'bhsd,bhse->bhde', ki * jnp.exp(glast - gi), vi)
        return state, inter + intra

    state0 = jnp.zeros((B, H, dk, dv), jnp.float32)
    _, out = lax.scan(step, state0, (qc, kc, vc, gc))
    return out.transpose(1, 0, 3, 2, 4).reshape(B, S, H, dv)


def dsa_attention(q, k, v, iq, ik, iw):
    B, S, H, dh = q.shape
    topk = min(DSA_MAX_TOPK, S // 4)
    scale = dh ** -0.5
    w = iw.astype(jnp.float32) * (IDX_HEADS ** -0.5)
    kpos = jnp.arange(S)
    gather = jax.vmap(lambda t, i: t[i])

    def block(i):
        start = i * Q_BLOCK
        qpos = start + jnp.arange(Q_BLOCK)
        iqb = lax.dynamic_slice_in_dim(iq, start, Q_BLOCK, axis=1)
        wb = lax.dynamic_slice_in_dim(w, start, Q_BLOCK, axis=1)
        rel = jax.nn.relu(jnp.einsum('bthd,bsd->bths', iqb, ik).astype(jnp.float32) * (IDX_DIM ** -0.5))
        score = jnp.einsum('bths,bth->bts', rel, wb)
        causal = kpos[None, :] <= qpos[:, None]
        score = jnp.where(causal[None], score, -jnp.inf)
        _, idx = lax.top_k(score, topk)
        valid = idx <= qpos[None, :, None]
        kg = gather(k, idx)
        vg = gather(v, idx)
        qb = lax.dynamic_slice_in_dim(q, start, Q_BLOCK, axis=1)
        s = jnp.einsum('bthd,btkhd->bhtk', qb, kg).astype(jnp.float32) * scale
        s = jnp.where(valid[:, None], s, -jnp.inf)
        p = jax.nn.softmax(s, axis=-1).astype(v.dtype)
        return jnp.einsum('bhtk,btkhd->bthd', p, vg)

    out = lax.map(block, jnp.arange(S // Q_BLOCK))
    return out.transpose(1, 0, 2, 3, 4).reshape(B, S, H * dh)


def peer_ffn(h, wq, k1, k2, u, v):
    B, S, D = h.shape
    q = jnp.einsum('bsd,de->bse', h, wq).reshape(B, S, PEER_HEADS, 2, PEER_DHALF)
    s1 = jnp.einsum('bshd,hnd->bshn', q[..., 0, :], k1).astype(jnp.float32)
    s2 = jnp.einsum('bshd,hnd->bshn', q[..., 1, :], k2).astype(jnp.float32)
    v1, i1 = lax.top_k(s1, PEER_TOPK)
    v2, i2 = lax.top_k(s2, PEER_TOPK)
    cand = (v1[..., :, None] + v2[..., None, :]).reshape(B, S, PEER_HEADS, PEER_TOPK * PEER_TOPK)
    cidx = (i1[..., :, None] * PEER_NKEYS + i2[..., None, :]).reshape(B, S, PEER_HEADS, PEER_TOPK * PEER_TOPK)
    best, pos = lax.top_k(cand, PEER_TOPK)
    eidx = jnp.take_along_axis(cidx, pos, axis=-1)
    gate = jax.nn.softmax(best, axis=-1)

    def block(i):
        start = i * PEER_BLOCK
        hb = lax.dynamic_slice_in_dim(h, start, PEER_BLOCK, axis=1)
        eb = lax.dynamic_slice_in_dim(eidx, start, PEER_BLOCK, axis=1)
        gb = lax.dynamic_slice_in_dim(gate, start, PEER_BLOCK, axis=1)
        ub = u[eb]
        vb = v[eb]
        a = jax.nn.gelu(jnp.einsum('btd,bthkd->bthk', hb, ub).astype(jnp.float32))
        return jnp.einsum('bthk,bthkd->btd', (gb * a).astype(h.dtype), vb)

    out = lax.map(block, jnp.arange(S // PEER_BLOCK))
    return out.transpose(1, 0, 2, 3).reshape(B, S, D)


def setup_inputs(seed: int = 0) -> dict:
    key = jax.random.key(seed)
    ks = jax.random.split(key, 20)
    f32 = jnp.float32
    L, D = DEPTH, D_MODEL
    nrm = lambda k, shape, s: jax.random.normal(k, shape, f32) * s
    return {
        'x': nrm(ks[0], (BATCH, SEQ, D), 1.0),
        'c': nrm(ks[1], (BATCH, D), 1.0),
        'ada_w': nrm(ks[2], (L, D, N_MOD * D), 0.5 * D ** -0.5),
        'ada_b': nrm(ks[3], (L, N_MOD * D), 0.01),
        'norm1_g': 1.0 + nrm(ks[4], (L, D), 0.01),
        'norm2_g': 1.0 + nrm(ks[5], (L, D), 0.01),
        'final_g': 1.0 + nrm(ks[6], (D,), 0.01),
        'w_in': nrm(ks[7], (L, D, N_IN), D ** -0.5),
        'fox_fbias': 3.0 + nrm(ks[8], (L, FOX_HEADS), 0.5),
        'gla_wa2': nrm(ks[9], (L, GLA_GATE_RANK, GLA_HEADS * GLA_DK), GLA_GATE_RANK ** -0.5),
        'gla_ba': nrm(ks[10], (L, GLA_HEADS * GLA_DK), 0.01),
        'gla_norm_g': 1.0 + nrm(ks[11], (L, GLA_DV), 0.01),
        'w_out': nrm(ks[12], (L, MIX_W, D), MIX_W ** -0.5),
        'peer_wq': nrm(ks[13], (L, D, PEER_HEADS * PEER_DQ), D ** -0.5),
        'peer_k1': nrm(ks[14], (L, PEER_HEADS, PEER_NKEYS, PEER_DHALF), PEER_DHALF ** -0.5),
        'peer_k2': nrm(ks[15], (L, PEER_HEADS, PEER_NKEYS, PEER_DHALF), PEER_DHALF ** -0.5),
        'peer_u': nrm(ks[16], (L, PEER_EXPERTS, D), D ** -0.5),
        'peer_v': nrm(ks[17], (L, PEER_EXPERTS, D), PEER_HEADS ** -0.5),
    }


def reference(x, c, ada_w, ada_b, norm1_g, norm2_g, final_g, w_in, fox_fbias, gla_wa2, gla_ba,
              gla_norm_g, w_out, peer_wq, peer_k1, peer_k2, peer_u, peer_v):
    B, S, D = x.shape
    c_act = jax.nn.silu(c)
    for l in range(DEPTH):
        mod = jnp.einsum('bd,de->be', c_act, ada_w[l]) + ada_b[l]
        sh1, sc1, g1, sh2, sc2, g2 = [m[:, None, :] for m in jnp.split(mod, N_MOD, axis=-1)]

        h = rmsnorm(x, norm1_g[l]) * (1.0 + sc1) + sh1
        z = jnp.einsum('bsd,de->bse', h, w_in[l])
        (fq, fk, fv, ff, gq, gk, gv, gr, ga, dq, dk, dv, iq, ik, iw) = split_cols(z)

        fox = fox_attention(fq.reshape(B, S, FOX_HEADS, HEAD_DIM), fk.reshape(B, S, FOX_HEADS, HEAD_DIM),
                            fv.reshape(B, S, FOX_HEADS, HEAD_DIM), ff, fox_fbias[l])

        log_a = jax.nn.log_sigmoid(jnp.einsum('bsr,re->bse', ga, gla_wa2[l]).astype(jnp.float32)
                                   + gla_ba[l].astype(jnp.float32)) / GLA_GATE_TAU
        go = gla_attention(gq.reshape(B, S, GLA_HEADS, GLA_DK), gk.reshape(B, S, GLA_HEADS, GLA_DK),
                           gv.reshape(B, S, GLA_HEADS, GLA_DV), log_a.reshape(B, S, GLA_HEADS, GLA_DK))
        gla = (rmsnorm(go, gla_norm_g[l]).reshape(B, S, GLA_W)
               * jax.nn.silu(gr.astype(jnp.float32))).astype(x.dtype)

        dsa = dsa_attention(dq.reshape(B, S, DSA_HEADS, HEAD_DIM), dk.reshape(B, S, DSA_HEADS, HEAD_DIM),
                            dv.reshape(B, S, DSA_HEADS, HEAD_DIM), iq.reshape(B, S, IDX_HEADS, IDX_DIM), ik, iw)

        mix = jnp.concatenate([fox, gla, dsa], axis=-1)
        x = x + g1 * jnp.einsum('bse,ed->bsd', mix, w_out[l])

        h = rmsnorm(x, norm2_g[l]) * (1.0 + sc2) + sh2
        x = x + g2 * peer_ffn(h, peer_wq[l], peer_k1[l], peer_k2[l], peer_u[l], peer_v[l])
    return rmsnorm(x, final_g)
```

```cpp
#include <hip/hip_runtime.h>
#include <hip/hip_bf16.h>
#include <hip/hip_cooperative_groups.h>
#include <cstdio>
#include <cstdint>
#include <cmath>

#ifndef MK_MULTI
#define MK_MULTI 0
#endif

#ifndef EN_ALL
#define EN_ALL 1
#endif
#ifndef EN_PRO
#define EN_PRO EN_ALL
#endif
#ifndef EN_GEMM
#define EN_GEMM EN_ALL
#endif
#ifndef EN_IDX
#define EN_IDX EN_ALL
#endif
#ifndef EN_G1
#define EN_G1 EN_ALL
#endif
#ifndef EN_SEL
#define EN_SEL EN_ALL
#endif
#ifndef EN_ATT
#define EN_ATT EN_ALL
#endif
#ifndef EN_TOPK
#define EN_TOPK EN_ALL
#endif
#ifndef EN_GATHER
#define EN_GATHER EN_ALL
#endif
#ifndef DIAG
#define DIAG 0
#endif
#ifndef REPEAT_N
#define REPEAT_N 1
#define REPEAT_PHASE -1
#endif
#ifndef REP_IDX
#define REP_IDX 1
#endif
#ifndef REP_G1
#define REP_G1 1
#endif
#ifndef REP_SEL
#define REP_SEL 1
#endif
#ifndef MK_COOP
#define MK_COOP 1
#endif
#ifndef WT_STORES
#define WT_STORES 0
#endif
#ifndef REP_G3
#define REP_G3 1
#endif
#ifndef FUSE_PG
#define FUSE_PG 0
#endif
#ifndef REP_FOX
#define REP_FOX 1
#endif
#ifndef WIN_FP8
#define WIN_FP8 1
#endif
#ifndef WIN_BF16_TILES
#define WIN_BF16_TILES 0x00000000u
#endif
#ifndef GATHER_PROBE
#define GATHER_PROBE 0
#endif
#ifndef CONV_IN_QUEUES
#define CONV_IN_QUEUES 1
#endif
#ifndef EPI_PROBE
#define EPI_PROBE 0
#endif
#ifndef WT_EPI
#define WT_EPI 0
#endif
#ifndef WO_FP8
#define WO_FP8 0
#endif
#define MIX_S 8.0f

namespace pg8 {
#define PG8_LAS __attribute__((address_space(3)))
typedef unsigned short bf16_t;
typedef short bf16x8 __attribute__((ext_vector_type(8)));
typedef float f32x4 __attribute__((ext_vector_type(4)));
typedef unsigned u32x4 __attribute__((ext_vector_type(4)));
typedef int i32x4 __attribute__((ext_vector_type(4)));
constexpr int BM = 256, BK = 64, HALF = 128, HTB = HALF * BK * 2  , STAGE_BYTES = 8 * HTB, NXCD = 8, WGM = 8;

__host__ __device__ __forceinline__ int lds_byte(int r, int c) { const int st = (r >> 4) * 2 + (c >> 5), rr = r & 15, cc = c & 31, ob = rr * 64 + cc * 2; return st * 1024 + (ob ^ (((ob >> 9) & 1) << 5)); }
__host__ __device__ __forceinline__ void stage_rc(int b, int& R, int& C) { const int st = b / 1024, sb = b % 1024, swz = sb ^ (((sb >> 9) & 1) << 5); R = (st >> 1) * 16 + swz / 64; C = (st & 1) * 32 + (swz % 64) / 2; }
__host__ __device__ __forceinline__ int perm32(int rho) { const int n = rho >> 4, i = rho & 15; return 8 * (i >> 2) + 4 * n + (i & 3); }

struct Unit { int pm, pn; };
struct Gemm { const bf16_t* A; const bf16_t* Bt; int M, N, K; };

struct StaticOrder {
    int nM, nN, nwg, G, c;
    __host__ __device__ void init(int M, int N, int G_, int c_) { nM = M / BM; nN = N / BM; nwg = nM * nN; G = G_; c = c_; }
    __host__ __device__ bool next(int i, Unit& u) const { const long L = (long)i * G + c; if (L >= nwg) return false; map((int)L, u); return true; }
    __host__ __device__ void map(int L, Unit& u) const {
        int wgid = L; { const int q = nwg / NXCD, r = nwg % NXCD, xcd = wgid % NXCD, off = wgid / NXCD; wgid = (xcd < r ? xcd * (q + 1) : r * (q + 1) + (xcd - r) * q) + off; }
        const int nig = WGM * nN, gid = wgid / nig, fm = gid * WGM, gsz = (nM - fm) < WGM ? (nM - fm) : WGM;
        u.pm = fm + ((wgid % nig) % gsz); u.pn = (wgid % nig) / gsz;
    }
    __device__ __forceinline__ void a_ready(const Unit&) const {}
    __device__ __forceinline__ void done(const Unit&) const {}
};

__host__ __device__ __forceinline__ int kth_tile(unsigned mask, int k) { int t = 0; for (;; ++t) if ((mask >> t) & 1u) { if (k == 0) break; --k; } return t; }
struct SubsetOrder { StaticOrder o; unsigned mask;
    __host__ __device__ bool next(int i, Unit& u) const { if (!o.next(i, u)) return false; u.pn = kth_tile(mask, u.pn); return true; }
    __device__ __forceinline__ void a_ready(const Unit&) const {}
    __device__ __forceinline__ void done(const Unit&) const {} };
struct SplitOrder {
    StaticOrder o; unsigned mask; int nlight, klight, kheavy;
    __host__ __device__ bool next(int i, Unit& u) const {
        const int nh = o.G - nlight; int L;
        if (o.c >= nlight) { if (i >= kheavy) return false; L = i * nh + (o.c - nlight); } else { if (i >= klight) return false; L = kheavy * nh + i * nlight + o.c; }
        if (L >= o.nwg) return false; o.map(L, u); u.pn = kth_tile(mask, u.pn); return true; }
    __device__ __forceinline__ void a_ready(const Unit&) const {}
    __device__ __forceinline__ void done(const Unit&) const {}
};
struct MaybeUnit { Unit u; bool has;
    __device__ __forceinline__ bool next(int i, Unit& o) const { if (i || !has) return false; o = u; return true; }
    __device__ __forceinline__ void a_ready(const Unit&) const {}
    __device__ __forceinline__ void done(const Unit&) const {} };

__device__ __forceinline__ void epi_store16(void* p, u32x4 v) {
#if WT_EPI
    asm volatile("global_store_dwordx4 %0, %1, off sc0 sc1" :: "v"(p), "v"(v) : "memory");
#else
    *(u32x4*)p = v;
#endif
}
__device__ __forceinline__ unsigned cvt_pk_bf16(float lo, float hi) { unsigned r; asm volatile("v_cvt_pk_bf16_f32 %0, %1, %2" : "=v"(r) : "v"(lo), "v"(hi)); return r; }
typedef float f32x2 __attribute__((ext_vector_type(2)));
__device__ __forceinline__ f32x2 gelu_pk(f32x2 v) {
    const f32x2 av = __builtin_elementwise_abs(v), d = av * 0.2316418882f + 1.0f;
    f32x2 t; t.x = __builtin_amdgcn_rcpf(d.x); t.y = __builtin_amdgcn_rcpf(d.y);
    f32x2 q = t * 0.5307027145f + (-0.7265760135f); q = q * t + 0.7107068705f; q = q * t + (-0.142248368f); q = q * t + 0.127414796f; q = q * t;
    const f32x2 s = (v * v) * (-0.72134752044f);
    f32x2 e; e.x = __builtin_amdgcn_exp2f(s.x); e.y = __builtin_amdgcn_exp2f(s.y);
    const f32x2 m = v * (q * e), r = v - m;
    f32x2 o; o.x = v.x < 0.f ? m.x : r.x; o.y = v.y < 0.f ? m.y : r.y; return o;
}

template <int ACT  > struct EpiBf16 {
    static constexpr bool PERM = true, AFTER_DRAIN = false; static_assert(ACT == 0 || ACT == 1, "EpiBf16: ACT is 0 (none) or 1 (gelu_pk)");
    bf16_t* O; int ldc; const float* bias; int split_cols; size_t split_stride; float scale0;
    __device__ __forceinline__ void operator()(const f32x4 (&acc)[2][2][4][2], const Unit& u, int wr, int wc, int fr, int fq) const {
        const int row0 = u.pm * BM + wr * 64 + fr; int colt = u.pn * BM; bf16_t* base = O;
        float sc = 1.f; if (split_cols) { const int t = colt / split_cols; base += (size_t)t * split_stride; colt -= t * split_cols; if (t == 0) sc = scale0; }
        const int col0 = colt + wc * 32 + 8 * fq, bcol0 = u.pn * BM + wc * 32 + 8 * fq;
        f32x4 bv[2][2];
#pragma unroll
        for (int bj = 0; bj < 2; ++bj)
#pragma unroll
            for (int n = 0; n < 2; ++n) bv[bj][n] = bias ? *(const f32x4*)(bias + bcol0 + bj * HALF + 4 * n) : (f32x4){0.f, 0.f, 0.f, 0.f};
#pragma unroll
        for (int ai = 0; ai < 2; ++ai)
#pragma unroll
            for (int m = 0; m < 4; ++m) { bf16_t* rowp = base + (size_t)(row0 + ai * HALF + m * 16) * ldc + col0;
#pragma unroll
                for (int bj = 0; bj < 2; ++bj) { f32x4 v0 = acc[ai][bj][m][0] + bv[bj][0], v1 = acc[ai][bj][m][1] + bv[bj][1];
                    if (ACT == 1) { f32x2 a = gelu_pk((f32x2){v0[0], v0[1]}), b = gelu_pk((f32x2){v0[2], v0[3]}), c = gelu_pk((f32x2){v1[0], v1[1]}), d = gelu_pk((f32x2){v1[2], v1[3]});
                        v0 = (f32x4){a.x, a.y, b.x, b.y}; v1 = (f32x4){c.x, c.y, d.x, d.y}; }
                    v0 = v0 * sc; v1 = v1 * sc; u32x4 w; w.x = cvt_pk_bf16(v0[0], v0[1]); w.y = cvt_pk_bf16(v0[2], v0[3]); w.z = cvt_pk_bf16(v1[0], v1[1]); w.w = cvt_pk_bf16(v1[2], v1[3]);
                    epi_store16(rowp + bj * HALF, w); } }
    }
};

typedef int i32x8 __attribute__((ext_vector_type(8)));
template <bool F8> struct Frag2;
template <> struct Frag2<false> { bf16x8 k[2];
    __device__ __forceinline__ void load(const PG8_LAS unsigned char* p) { k[0] = *(const PG8_LAS bf16x8*)p; k[1] = *(const PG8_LAS bf16x8*)(p + 1024); } };
template <> struct Frag2<true> { i32x8 v;
    __device__ __forceinline__ void load(const PG8_LAS unsigned char* p) { const i32x4 a = *(const PG8_LAS i32x4*)p, b = *(const PG8_LAS i32x4*)(p + 1024); v = __builtin_shufflevector(a, b, 0, 1, 2, 3, 4, 5, 6, 7); } };
__device__ __forceinline__ f32x4 frag_mma(const Frag2<false>& b, const Frag2<false>& a, f32x4 c) { c = __builtin_amdgcn_mfma_f32_16x16x32_bf16(b.k[0], a.k[0], c, 0, 0, 0); return __builtin_amdgcn_mfma_f32_16x16x32_bf16(b.k[1], a.k[1], c, 0, 0, 0); }
__device__ __forceinline__ f32x4 frag_mma(const Frag2<true>& b, const Frag2<true>& a, f32x4 c) { asm volatile("v_mfma_f32_16x16x128_f8f6f4 %0, %1, %2, %0" : "+v"(c) : "v"(b.v), "v"(a.v)); return c; }
template <class Epi, class Sched, bool ALIGN_EPI = false, bool SP2 = false, bool F8 = false>
__device__ __forceinline__ void gemm_phase(PG8_LAS unsigned char* lds, const Gemm g, const Sched& S, const Epi& E) {
    int tid = threadIdx.x; asm volatile("" : "+v"(tid));
    const int wid = __builtin_amdgcn_readfirstlane(tid >> 6), lane = tid & 63, wr = wid >> 2, wc = wid & 3, fr = lane & 15, fq = lane >> 4;
    const int K = g.K, nt = K / BK;
    unsigned voffA[2], voffB[2];
#pragma unroll
    for (int i = 0; i < 2; ++i) { int R, C; stage_rc(tid * 16 + i * 8192, R, C); const int Rb = Epi::PERM ? ((R & ~31) + perm32(R & 31)) : R;
        voffA[i] = (unsigned)(R * K + C) * 2u; voffB[i] = (unsigned)(Rb * K + C) * 2u; }
    const size_t kstep = (size_t)(BK * 2);
    const size_t hstep = (size_t)HALF * K * 2;
    const size_t tstep = 2 * hstep;
    const unsigned ldsw = (unsigned)wid * 1024u;
    const int aoff = lds_byte(wr * 64 + fr, fq * 8), boff = lds_byte(wc * 32 + fr, fq * 8);
#define PG8_SA(b, h) (((b) * 2 + (h)) * HTB)
#define PG8_SB(b, h) ((4 + (b) * 2 + (h)) * HTB)
#define PG8_STAGE(bufoff, gbase, voff) do { _Pragma("unroll") for (int _i = 0; _i < 2; ++_i) \
        __builtin_amdgcn_global_load_lds((const unsigned*)((const char*)(gbase) + (voff)[_i]), (PG8_LAS unsigned*)(lds + (bufoff) + ldsw + _i * 8192), 16, 0, 0); } while (0)
#define PG8_LDA(dst, b, h) do { _Pragma("unroll") for (int m = 0; m < 4; ++m) dst[m].load(lds + PG8_SA(b, h) + aoff + m * 2048); } while (0)
#define PG8_LDB(dst, b, h) do { _Pragma("unroll") for (int n = 0; n < 2; ++n) dst[n].load(lds + PG8_SB(b, h) + boff + n * 2048); } while (0)
#define PG8_MMA(ai, bj, At, Bt) do { __builtin_amdgcn_s_setprio(1); _Pragma("unroll") for (int m = 0; m < 4; ++m) _Pragma("unroll") for (int n = 0; n < 2; ++n) \
        acc[ai][bj][m][n] = frag_mma(Bt[n], At[m], acc[ai][bj][m][n]); __builtin_amdgcn_s_setprio(0); } while (0)
#define PG8_WAIT_V(n) asm volatile("s_waitcnt vmcnt(" #n ")" ::: "memory")
#define PG8_WAIT_L(n) asm volatile("s_waitcnt lgkmcnt(" #n ")" ::: "memory")
#define PG8_BAR __builtin_amdgcn_s_barrier()
#define PG8_SCHED __builtin_amdgcn_sched_barrier(0)
    Unit cur, nxt; int ui = 0;
    if (!S.next(0, cur)) return;
    f32x4 acc[2][2][4][2];
#pragma unroll
    for (int a = 0; a < 2; ++a)
#pragma unroll
        for (int b = 0; b < 2; ++b)
#pragma unroll
            for (int m = 0; m < 4; ++m)
#pragma unroll
                for (int n = 0; n < 2; ++n) acc[a][b][m][n] = (f32x4){0.f, 0.f, 0.f, 0.f};
    Frag2<F8> At[4], B0[2], B1[2];
    const char* cA = (const char*)g.A + (size_t)cur.pm * tstep; const char* cB = (const char*)g.Bt + (size_t)cur.pn * tstep;
    S.a_ready(cur);
    if constexpr (SP2) {
        PG8_STAGE(PG8_SB(0, 0), cB, voffB); PG8_STAGE(PG8_SB(0, 1), cB + hstep, voffB); PG8_STAGE(PG8_SA(0, 0), cA, voffA); PG8_STAGE(PG8_SA(0, 1), cA + hstep, voffA);
        if (wr == 1) PG8_BAR;
        PG8_WAIT_V(2); PG8_BAR;
        PG8_STAGE(PG8_SB(1, 0), cB + kstep, voffB); PG8_STAGE(PG8_SA(1, 0), cA + kstep, voffA); PG8_STAGE(PG8_SB(1, 1), cB + hstep + kstep, voffB);
        PG8_WAIT_V(6); PG8_BAR;
    } else {
        PG8_STAGE(PG8_SB(0, 0), cB, voffB); PG8_STAGE(PG8_SA(0, 0), cA, voffA); PG8_STAGE(PG8_SB(0, 1), cB + hstep, voffB); PG8_STAGE(PG8_SA(0, 1), cA + hstep, voffA);
        if (wr == 1) PG8_BAR;
        PG8_WAIT_V(4); PG8_BAR;
        PG8_STAGE(PG8_SB(1, 0), cB + kstep, voffB); PG8_STAGE(PG8_SA(1, 0), cA + kstep, voffA); PG8_STAGE(PG8_SB(1, 1), cB + hstep + kstep, voffB);
        PG8_WAIT_V(6); PG8_BAR;
    }
    for (;;) {
        const bool has_next = S.next(ui + 1, nxt);
        const char* nA = has_next ? (const char*)g.A + (size_t)nxt.pm * tstep : cA; const char* nB = has_next ? (const char*)g.Bt + (size_t)nxt.pn * tstep : cB;
        for (int t = 0; t < nt; t += 2) {
            const bool last = (t == nt - 2);
            const char* a1 = cA + (size_t)(t + 1) * kstep;
            const char* a2 = last ? nA : cA + (size_t)(t + 2) * kstep; const char* b2 = last ? nB : cB + (size_t)(t + 2) * kstep;
            const char* a3 = a2 + kstep; const char* b3 = b2 + kstep;
            if (last && has_next) S.a_ready(nxt);
            if constexpr (SP2) {
            PG8_LDB(B0, 0, 0); PG8_LDB(B1, 0, 1); PG8_SCHED; PG8_LDA(At, 0, 0); PG8_STAGE(PG8_SA(1, 1), a1 + hstep, voffA);
            PG8_WAIT_V(8); PG8_WAIT_L(0); PG8_BAR; PG8_MMA(0, 0, At, B0); PG8_MMA(0, 1, At, B1); PG8_BAR; PG8_SCHED;
            PG8_LDA(At, 0, 1); PG8_STAGE(PG8_SB(0, 0), b2, voffB); PG8_STAGE(PG8_SB(0, 1), b2 + hstep, voffB); PG8_STAGE(PG8_SA(0, 0), a2, voffA);
            PG8_WAIT_V(8); PG8_WAIT_L(0); PG8_BAR; PG8_MMA(1, 0, At, B0); PG8_MMA(1, 1, At, B1); PG8_BAR; PG8_SCHED;
            PG8_LDB(B0, 1, 0); PG8_LDB(B1, 1, 1); PG8_SCHED; PG8_LDA(At, 1, 0); PG8_STAGE(PG8_SA(0, 1), a2 + hstep, voffA);
            PG8_WAIT_V(8); PG8_WAIT_L(0); PG8_BAR; PG8_MMA(0, 0, At, B0); PG8_MMA(0, 1, At, B1); PG8_BAR; PG8_SCHED;
            PG8_LDA(At, 1, 1); PG8_STAGE(PG8_SB(1, 0), b3, voffB); PG8_STAGE(PG8_SB(1, 1), b3 + hstep, voffB); PG8_STAGE(PG8_SA(1, 0), a3, voffA);
            PG8_WAIT_V(8); PG8_WAIT_L(0); PG8_BAR; PG8_MMA(1, 0, At, B0); PG8_MMA(1, 1, At, B1); PG8_BAR; PG8_SCHED;
            } else {
            PG8_LDB(B0, 0, 0); PG8_SCHED; PG8_LDA(At, 0, 0); PG8_STAGE(PG8_SA(1, 1), a1 + hstep, voffA);
            PG8_WAIT_L(8); PG8_BAR; PG8_WAIT_L(0); PG8_MMA(0, 0, At, B0); PG8_BAR; PG8_SCHED;
            PG8_LDB(B1, 0, 1); PG8_STAGE(PG8_SB(0, 0), b2, voffB);
            PG8_BAR; PG8_WAIT_L(0); PG8_MMA(0, 1, At, B1); PG8_BAR;
            PG8_LDA(At, 0, 1); PG8_STAGE(PG8_SA(0, 0), a2, voffA);
            PG8_BAR; PG8_WAIT_L(0); PG8_MMA(1, 0, At, B0); PG8_BAR; PG8_SCHED;
            PG8_STAGE(PG8_SB(0, 1), b2 + hstep, voffB);
            PG8_WAIT_V(6); PG8_BAR; PG8_MMA(1, 1, At, B1); PG8_BAR;
            PG8_LDB(B0, 1, 0); PG8_SCHED; PG8_LDA(At, 1, 0); PG8_STAGE(PG8_SA(0, 1), a2 + hstep, voffA);
            PG8_WAIT_L(8); PG8_BAR; PG8_WAIT_L(0); PG8_MMA(0, 0, At, B0); PG8_BAR; PG8_SCHED;
            PG8_LDB(B1, 1, 1); PG8_STAGE(PG8_SB(1, 0), b3, voffB);
            PG8_BAR; PG8_WAIT_L(0); PG8_MMA(0, 1, At, B1); PG8_BAR;
            PG8_LDA(At, 1, 1); PG8_STAGE(PG8_SA(1, 0), a3, voffA);
            PG8_BAR; PG8_WAIT_L(0); PG8_MMA(1, 0, At, B0); PG8_BAR; PG8_SCHED;
            PG8_STAGE(PG8_SB(1, 1), b3 + hstep, voffB);
            PG8_WAIT_V(6); PG8_BAR; PG8_MMA(1, 1, At, B1); PG8_BAR;
            }
        }
        if constexpr (F8) asm volatile("s_nop 15\n\ts_nop 15" ::: "memory");
        if constexpr (ALIGN_EPI) { if (wr == 0) PG8_BAR; }
        if constexpr (!Epi::AFTER_DRAIN) { E(acc, cur, wr, wc, fr, fq); S.done(cur); }
        if (!has_next) break;
#pragma unroll
        for (int a = 0; a < 2; ++a)
#pragma unroll
            for (int b = 0; b < 2; ++b)
#pragma unroll
                for (int m = 0; m < 4; ++m)
#pragma unroll
                    for (int n = 0; n < 2; ++n) acc[a][b][m][n] = (f32x4){0.f, 0.f, 0.f, 0.f};
        cur = nxt; cA = nA; cB = nB; ++ui;
        if constexpr (ALIGN_EPI) { if (wr == 1) PG8_BAR; }
    }
    PG8_WAIT_V(0);
    if constexpr (!ALIGN_EPI) { if (wr == 0) PG8_BAR; }
    PG8_BAR;
    if constexpr (Epi::AFTER_DRAIN) { E.fused(acc, cur, wr, wc, fr, fq, lds, wid, lane); S.done(cur); }
#undef PG8_SA
#undef PG8_SB
#undef PG8_STAGE
#undef PG8_LDA
#undef PG8_LDB
#undef PG8_MMA
#undef PG8_WAIT_V
#undef PG8_WAIT_L
#undef PG8_BAR
#undef PG8_SCHED
}
}

namespace pg8 {
struct EpiZ {
    static constexpr bool PERM = true, AFTER_DRAIN = false;
    bf16_t* Z; float* zs; int ldz; bf16_t* ZH; const float* sa; float sw; bool skip = false;
    __device__ __forceinline__ void operator()(const f32x4 (&acc)[2][2][4][2], const Unit& u, int wr, int wc, int fr, int fq) const {
        if (skip) return;
        asm volatile("" : "+v"(fr), "+v"(fq));
        const int row0 = u.pm * BM + wr * 64 + fr, col0 = u.pn * BM + wc * 32 + 8 * fq;
#pragma unroll
        for (int ai = 0; ai < 2; ++ai)
#pragma unroll
            for (int m = 0; m < 4; ++m) { const int row = row0 + ai * HALF + m * 16; bf16_t* rowp = Z + (size_t)row * ldz + col0; const float rs = sa ? sa[row] * sw : 1.f;
#pragma unroll
                for (int bj = 0; bj < 2; ++bj) { const f32x4 v0 = acc[ai][bj][m][0] * rs, v1 = acc[ai][bj][m][1] * rs;
                    u32x4 w; w.x = cvt_pk_bf16(v0[0], v0[1]); w.y = cvt_pk_bf16(v0[2], v0[3]); w.z = cvt_pk_bf16(v1[0], v1[1]); w.w = cvt_pk_bf16(v1[2], v1[3]);
                    const int col = col0 + bj * HALF, cb = u.pn * BM + bj * HALF;
                    if (cb < 2304 || (cb >= 4352 && cb < 6656)) { const int hidx = cb < 2304 ? (cb >> 7) : 18 + ((cb - 4352) >> 7);
                        epi_store16(ZH + ((size_t)hidx * 8192 + row) * 128 + (col & 127), w); }
                    else epi_store16(rowp + bj * HALF, w);
                    if (col >= 7744 && col < 7808) { float* zp = zs + (size_t)row * 64 + (col - 7744); *(f32x4*)zp = v0; *(f32x4*)(zp + 4) = v1; } } }
    }
};
struct EpiRes {
    static constexpr bool PERM = false, AFTER_DRAIN = false;
    const float* Xin; float* X; const float* gate; int ldc; float s;
    __device__ __forceinline__ void operator()(const f32x4 (&acc)[2][2][4][2], const Unit& u, int wr, int wc, int fr, int fq) const {
        const int row0 = u.pm * BM + wr * 64 + fr, col0 = u.pn * BM + wc * 32 + 4 * fq;
#pragma unroll
        for (int bj = 0; bj < 2; ++bj)
#pragma unroll
            for (int n = 0; n < 2; ++n) { const f32x4 g = *(const f32x4*)(gate + col0 + bj * HALF + n * 16);
#pragma unroll
                for (int ai = 0; ai < 2; ++ai)
#pragma unroll
                    for (int m = 0; m < 4; ++m) { const size_t off = (size_t)(row0 + ai * HALF + m * 16) * ldc + col0 + bj * HALF + n * 16;
                        f32x4 x = *(const f32x4*)(Xin + off); x = x + g * (acc[ai][bj][m][n] * s); epi_store16(X + off, __builtin_bit_cast(u32x4, x)); } }
    }
};
struct OneUnit { Unit u;
    __device__ __forceinline__ bool next(int i, Unit& o) const { if (i) return false; o = u; return true; }
    __device__ __forceinline__ void a_ready(const Unit&) const {}
    __device__ __forceinline__ void done(const Unit&) const {} };
}

constexpr int S = 8192, DM = 2048, DEPTH = 2, NIN = 7782, LDZ = 7936, NWAVES = 8;
constexpr int NMOD = 6 * DM;
constexpr int ZC_FQ = 0, ZC_FK = 768, ZC_FV = 1536, ZC_GQ = 2304, ZC_GK = 2816, ZC_GV = 3328, ZC_GR = 3840;
constexpr int ZC_DQ = 4352, ZC_DK = 5120, ZC_DV = 5888, ZC_IQ = 6656, ZC_IK = 7680, ZC_SM = 7744;
constexpr int ZS_FF = 0, ZS_GA = 16, ZS_IW = 32;
__host__ __device__ constexpr int win_src_col(int n) {
    return n < 2304 ? n : n < 4352 ? 2310 + (n - 2304) : n < 6656 ? 4374 + (n - 4352) : n < 7680 ? 6678 + (n - 6656) : n < 7744 ? 7702 + (n - 7680)
         : n < 7750 ? 2304 + (n - 7744) : n < 7760 ? -1 : n < 7776 ? 4358 + (n - 7760) : n < 7792 ? 7766 + (n - 7776) : -1;
}
constexpr size_t MiB = 1u << 20;
constexpr size_t WS_CTL = 0, CTL_ZERO_BYTES = 1 * MiB;
constexpr size_t WS_MOD = 1 * MiB, WS_MODP = 2 * MiB;
constexpr size_t WS_FCUM = 8 * MiB, WS_DECAY = 9 * MiB, WS_KB = 10 * MiB;
constexpr size_t WS_SU = 9 * MiB + 512 * 1024, WS_SV = 9 * MiB + 768 * 1024;
constexpr size_t WS_EIDX = 12 * MiB, WS_GATE = 16 * MiB, WS_MASK = 20 * MiB, WS_ZS = 28 * MiB;
constexpr size_t WS_WIN = 32 * MiB, WS_WO = 94 * MiB, WS_WQ = 110 * MiB;
constexpr size_t WS_X = 128 * MiB, WS_H = 192 * MiB, WS_MIX = 224 * MiB, WS_Z = 256 * MiB;
constexpr size_t WS_UT = 380 * MiB, WS_ST = 412 * MiB, WS_QG = 428 * MiB, WS_INTRA = 436 * MiB;
constexpr size_t WS_SC = 452 * MiB, WS_QP = 452 * MiB;
constexpr size_t WS_UB = 708 * MiB, WS_VB = 772 * MiB, WS_ZH = 836 * MiB, WS_H8 = 912 * MiB, WS_SA = 928 * MiB, WS_WIN8 = 929 * MiB, WS_WO8 = 961 * MiB, WS_MIX8 = 969 * MiB, WS_END = 985 * MiB;
constexpr int CW_BAR = 4096, CW_Q = 16384, CW_FOXN = 36864, CW_WAMAX = 49152, CW_MIXOVF = 49152 + 16;

constexpr int LDS_BYTES = 163840;
constexpr int MISC_OFF = 163840 - 256;
constexpr int LDS_WORK = MISC_OFF;

#define GAS __attribute__((address_space(1)))
#define LAS __attribute__((address_space(3)))
typedef unsigned short bf16_t;
typedef unsigned u32x4 __attribute__((ext_vector_type(4)));
typedef unsigned u32x2 __attribute__((ext_vector_type(2)));
typedef float f32x4 __attribute__((ext_vector_type(4)));
typedef float f32x16 __attribute__((ext_vector_type(16)));
typedef short bf16x8 __attribute__((ext_vector_type(8)));
typedef __bf16 bf16x2v __attribute__((ext_vector_type(2)));
typedef float f32x2 __attribute__((ext_vector_type(2)));

__device__ __forceinline__ unsigned f2bf(float f) { unsigned u = __builtin_bit_cast(unsigned, f); return (u + 0x7fffu + ((u >> 16) & 1u)) >> 16; }
__device__ __forceinline__ unsigned pk2(float lo, float hi) { return f2bf(lo) | (f2bf(hi) << 16); }
__device__ __forceinline__ float bf2f(unsigned b) { return __builtin_bit_cast(float, b << 16); }
__device__ __forceinline__ float bflo(unsigned w) { return __builtin_bit_cast(float, w << 16); }
__device__ __forceinline__ float bfhi(unsigned w) { return __builtin_bit_cast(float, w & 0xffff0000u); }
__device__ __forceinline__ float wave_sum(float v) {
#pragma unroll
    for (int o = 1; o < 64; o <<= 1) v += __shfl_xor(v, o);
    return v;
}
__device__ __forceinline__ float dot2bf(unsigned a, unsigned b, float acc) { return __builtin_amdgcn_fdot2_f32_bf16(__builtin_bit_cast(bf16x2v, a), __builtin_bit_cast(bf16x2v, b), acc, false); }
__device__ __forceinline__ int crow(int r, int hi) { return (r & 3) + 8 * (r >> 2) + 4 * hi; }
template <int KSTEPS> __device__ __forceinline__ void mma32(f32x16& c, const bf16_t* A, int lda, const bf16_t* B, int ldb, int r32, int hi) {
#pragma unroll
    for (int ks = 0; ks < KSTEPS; ++ks) {
        const bf16x8 a = *(const bf16x8*)(A + (size_t)r32 * lda + ks * 16 + hi * 8);
        const bf16x8 b = *(const bf16x8*)(B + (size_t)r32 * ldb + ks * 16 + hi * 8);
        c = __builtin_amdgcn_mfma_f32_32x32x16_bf16(a, b, c, 0, 0, 0);
    }
}
__device__ __forceinline__ float logsigmoidf(float x) { return fminf(x, 0.f) - 0.6931471805599453f * __builtin_amdgcn_logf(1.f + __builtin_amdgcn_exp2f(-1.4426950408889634f * fabsf(x))); }
__device__ __forceinline__ float siluf(float x) { return x / (1.f + __expf(-x)); }
__device__ __forceinline__ float gelu_tanh(float x) { const float y = 0.7978845608028654f * (x + 0.044715f * x * x * x); const float t = 1.f - 2.f / (1.f + __expf(2.f * y)); return 0.5f * x * (1.f + t); }

#define XB_TMO      128
#define XB_XCNT(j)  (256  + 64 * (j))
#define XB_XSUB(j)  (1280 + 64 * (j))
#define XB_XGEN(j)  (2304 + 64 * (j))
#define XB_TOP      3328
#define XB_TOPGEN   3392
#define XCD_BAR_WORDS 3456
#define XB_SPIN_CAP (1u << 23)

__device__ __forceinline__ unsigned xb_ld(unsigned* p)              { return __hip_atomic_load(p, __ATOMIC_RELAXED, __HIP_MEMORY_SCOPE_AGENT); }
__device__ __forceinline__ unsigned xb_add(unsigned* p, unsigned v) { return __hip_atomic_fetch_add(p, v, __ATOMIC_RELAXED, __HIP_MEMORY_SCOPE_AGENT); }
__device__ __forceinline__ unsigned xb_xcc_id() { return (unsigned)__builtin_amdgcn_s_getreg((3 << 11) | 20) & 0xFu; }
#define XB_SPIN(cond, bar) do { unsigned _sp = 0; while (cond) { __builtin_amdgcn_s_sleep(1); \
    if ((++_sp & 255u) == 0u) { if (xb_ld(&(bar)[XB_TMO])) break; if (_sp > XB_SPIN_CAP) { atomicAdd(&(bar)[XB_TMO], 1u); break; } } } } while (0)

struct XcdBarrier {
    unsigned* bar; unsigned x;
    volatile LAS unsigned* st;
};

__device__ __forceinline__ XcdBarrier xcd_barrier_post(unsigned* bar, volatile LAS unsigned* st) {
    XcdBarrier b; b.bar = bar; b.x = xb_xcc_id(); b.st = st;
    if (threadIdx.x == 0) (void)xb_add(&bar[XB_XCNT(b.x)], 1u);
    return b;
}
__device__ __forceinline__ void xcd_barrier_complete(unsigned* bar, unsigned x, unsigned& nloc, unsigned& nx) {
    const unsigned G = gridDim.x * gridDim.y * gridDim.z;
    unsigned sum, cnt, mine, sp = 0u;
    for (;;) {
        sum = 0u; cnt = 0u; mine = 0u;
#pragma unroll 1
        for (unsigned j = 0; j < 16; ++j) { const unsigned c = xb_ld(&bar[XB_XCNT(j)]); sum += c; cnt += (c > 0u) ? 1u : 0u; mine = (j == x) ? c : mine; }
        if (sum == G) break;
        __builtin_amdgcn_s_sleep(1);
        if ((++sp & 255u) == 0u) { if (xb_ld(&bar[XB_TMO])) break; if (sp > XB_SPIN_CAP) { atomicAdd(&bar[XB_TMO], 1u); break; } }
    }
    nloc = mine > 0u ? mine : 1u; nx = cnt > 0u ? cnt : 1u;
}

__device__ __forceinline__ void xcd_barrier(const XcdBarrier& b) {
    asm volatile("s_waitcnt vmcnt(0)" ::: "memory");
    __syncthreads();
    if (threadIdx.x == 0) {
        unsigned* bar = b.bar;
        __builtin_amdgcn_s_waitcnt(0);
        unsigned nloc = b.st[0], nx = b.st[1];
        if (nloc == 0u) { xcd_barrier_complete(bar, b.x, nloc, nx); b.st[0] = nloc; b.st[1] = nx; }
        const unsigned old = xb_add(&bar[XB_XSUB(b.x)], 1u);
        const unsigned gen = old / nloc;
        if (old + 1u == (gen + 1u) * nloc) {
            __builtin_amdgcn_fence(__ATOMIC_RELEASE, "agent");
            asm volatile("s_waitcnt vmcnt(0)" ::: "memory");
            const unsigned og = xb_add(&bar[XB_TOP], 1u);
            const unsigned tg = og / nx;
            if (og + 1u == (tg + 1u) * nx) xb_add(&bar[XB_TOPGEN], 1u);
            else XB_SPIN(xb_ld(&bar[XB_TOPGEN]) == tg, bar);
            __builtin_amdgcn_fence(__ATOMIC_ACQUIRE, "agent");
            xb_add(&bar[XB_XGEN(b.x)], 1u);
            asm volatile("s_waitcnt vmcnt(0)" ::: "memory");
        } else {
            XB_SPIN(xb_ld(&bar[XB_XGEN(b.x)]) == gen, bar);
            __builtin_amdgcn_fence(__ATOMIC_ACQUIRE, "agent");
            asm volatile("s_waitcnt vmcnt(0)" ::: "memory");
        }
    }
    __syncthreads();
}

namespace att {
using bf16 = __hip_bfloat16;
typedef short bf16x8 __attribute__((ext_vector_type(8)));
typedef short s16x4 __attribute__((ext_vector_type(4)));
typedef float f32x16 __attribute__((ext_vector_type(16)));
typedef float f32x4 __attribute__((ext_vector_type(4)));
typedef unsigned u32x4 __attribute__((ext_vector_type(4)));
constexpr int D = 128, NW = 8, QBLK = 32, KVBLK = 64, QB = NW * QBLK;
constexpr int LDQ = 128, LDO = 2048;
constexpr float SCALE = 0.08838834764831845f;
constexpr float THR = 8.f;
constexpr int SHM_V = KVBLK * D * 2, SHM_K = KVBLK * D * 2;
constexpr int LDS_CORE = 2 * SHM_V + 2 * SHM_K + NW * 64 * 4;
constexpr int LDS_BIAS = LDS_CORE;
constexpr int LDS_Q = LDS_CORE + 512;
constexpr int LDS_FLAG = LDS_Q + NW * 8192;
constexpr int LDS_TOTAL = LDS_FLAG + 16;

#define KSWZ(row, colB) ((row) * 256 + ((colB) ^ (((row) & 7) << 4)))
#define SBAR() __builtin_amdgcn_sched_barrier(0)
__device__ __forceinline__ int v_st(int k, int c) { const int kk = (k & ~0xC) | ((k & 4) << 1) | ((k & 8) >> 1); return ((kk >> 3) * 4 + (c >> 5)) * 512 + ((kk & 7) * 32 + (c & 31)) * 2; }
__device__ __forceinline__ int v_rd_base(int lane) { return ((lane & 3) << 3) | (((lane >> 2) & 3) << 6) | (((lane >> 4) & 1) << 5) | (((lane >> 5) & 1) << 8); }
constexpr int v_rd_off(int d0, int ks, int half) { return d0 * 512 + ks * 4096 + half * 2048; }
__device__ __forceinline__ int crow(int r, int hi) { return (r & 3) + 8 * (r >> 2) + 4 * hi; }
__device__ __forceinline__ unsigned cvtpk(float lo, float hi) { unsigned r; asm volatile("v_cvt_pk_bf16_f32 %0, %1, %2" : "=v"(r) : "v"(lo), "v"(hi)); return r; }
__device__ __forceinline__ bf16x8 load8(const bf16* p) { return *reinterpret_cast<const bf16x8*>(p); }
__device__ __forceinline__ void mask_causal(f32x16& p0, f32x16& p1, int dq) {
    const float NEG = -__builtin_inff();
#pragma unroll
    for (int r = 0; r < 16; ++r) { const int c = (r & 3) + 8 * (r >> 2); if (dq - c < 0) p0[r] = NEG; if (dq - c - 32 < 0) p1[r] = NEG; }
}
__device__ __forceinline__ float keep_or_neginf(float p, unsigned w, int c) {
    const int m = __builtin_amdgcn_sbfe((int)w, c, 1); return __uint_as_float((__float_as_uint(p) & (unsigned)m) | (~(unsigned)m & 0xFF800000u)); }
__device__ __forceinline__ void mask_bits(f32x16& p0, f32x16& p1, unsigned wl, unsigned wh) {
#pragma unroll
    for (int r = 0; r < 16; ++r) { const int c = (r & 3) + 8 * (r >> 2); p0[r] = keep_or_neginf(p0[r], wl, c); p1[r] = keep_or_neginf(p1[r], wh, c); }
}
__device__ __forceinline__ void partialSM(f32x16& p0, f32x16& p1, float& m_reg, float& mn, float& alpha) {
    float pmax = p0[0]; for (int r = 1; r < 16; ++r) pmax = fmaxf(pmax, p0[r]); for (int r = 0; r < 16; ++r) pmax = fmaxf(pmax, p1[r]);
    { auto rr = __builtin_amdgcn_permlane32_swap(__float_as_uint(pmax), __float_as_uint(pmax), false, false);
      pmax = fmaxf(__uint_as_float(rr[0]), __uint_as_float(rr[1])); }
    constexpr float C2 = 1.4426950408889634f * SCALE;
    if (__builtin_expect(__all((pmax - m_reg) * SCALE <= THR), 1)) { mn = m_reg; alpha = 1.f; }
    else { mn = fmaxf(m_reg, pmax); alpha = __builtin_amdgcn_exp2f((m_reg - mn) * C2); m_reg = mn; }
    const float mnL = -mn * C2;
    for (int r = 0; r < 16; ++r) p0[r] = fmaf(p0[r], C2, mnL); for (int r = 0; r < 16; ++r) p1[r] = fmaf(p1[r], C2, mnL);
    for (int r = 0; r < 16; ++r) p0[r] = __builtin_amdgcn_exp2f(p0[r]);
}
__device__ __forceinline__ void finishSM(f32x16& p0, f32x16& p1, float alpha, float& l_reg, bf16x8& pa0, bf16x8& pa1, bf16x8& pa2, bf16x8& pa3) {
    for (int r = 0; r < 16; ++r) p1[r] = __builtin_amdgcn_exp2f(p1[r]);
    float ps = 0; for (int r = 0; r < 16; ++r) ps += p0[r]; for (int r = 0; r < 16; ++r) ps += p1[r];
    { auto rr = __builtin_amdgcn_permlane32_swap(__float_as_uint(ps), __float_as_uint(ps), false, false);
      ps = __uint_as_float(rr[0]) + __uint_as_float(rr[1]); }
    l_reg = l_reg * alpha + ps;
#define PK4(P, B_, OUT) do { unsigned a0 = cvtpk(P[B_+0], P[B_+1]), a1 = cvtpk(P[B_+2], P[B_+3]);                          \
        unsigned b0 = cvtpk(P[B_+4], P[B_+5]), b1 = cvtpk(P[B_+6], P[B_+7]);                                             \
        auto r0 = __builtin_amdgcn_permlane32_swap(a0, b0, false, false); auto r1 = __builtin_amdgcn_permlane32_swap(a1, b1, false, false); \
        u32x4 w = {r0[0], r1[0], r0[1], r1[1]}; OUT = *reinterpret_cast<bf16x8*>(&w); } while (0)
    PK4(p0, 0, pa0); PK4(p0, 8, pa1); PK4(p1, 0, pa2); PK4(p1, 8, pa3);
#undef PK4
}
template <int KB, bool BIAS>
__device__ __forceinline__ void qkt(f32x16& p0, f32x16& p1, const char* K_lds, int r32, int hi, const char* Q_lds, const float* bp) {
    if constexpr (BIAS) {
#pragma unroll
        for (int g = 0; g < 4; ++g) { const f32x4 b0 = *(const f32x4*)(bp + 8 * g), b1 = *(const f32x4*)(bp + 32 + 8 * g);
#pragma unroll
            for (int e = 0; e < 4; ++e) { p0[4 * g + e] = b0[e]; p1[4 * g + e] = b1[e]; } }
    } else { p0 = f32x16{}; p1 = f32x16{}; }
    const char* kb[4];
#pragma unroll
    for (int dd = 0; dd < 4; ++dd) kb[dd] = K_lds + KB * SHM_K + KSWZ(r32, (dd * 16 + hi * 8) * 2);
#if ATT_QPIN
    bf16x8 X0, X1, XQ, Y0, Y1, YQ, Z0, Z1, ZQ;
#define QK_LD(K0_, K1_, KQ_, d) do { const char* a_ = kb[(d) & 3] + ((d) >> 2) * 128; \
        K0_ = *reinterpret_cast<const bf16x8*>(a_); K1_ = *reinterpret_cast<const bf16x8*>(a_ + 32 * 256); KQ_ = *reinterpret_cast<const bf16x8*>(Q_lds + (d) * 1024); } while (0)
#define QK_MM(K0_, K1_, KQ_) do { p0 = __builtin_amdgcn_mfma_f32_32x32x16_bf16(K0_, KQ_, p0, 0, 0, 0); p1 = __builtin_amdgcn_mfma_f32_32x32x16_bf16(K1_, KQ_, p1, 0, 0, 0); } while (0)
    SBAR(); QK_LD(X0, X1, XQ, 0); QK_LD(Y0, Y1, YQ, 1); SBAR();
    QK_LD(Z0, Z1, ZQ, 2); SBAR(); QK_MM(X0, X1, XQ); SBAR();
    QK_LD(X0, X1, XQ, 3); SBAR(); QK_MM(Y0, Y1, YQ); SBAR();
    QK_LD(Y0, Y1, YQ, 4); SBAR(); QK_MM(Z0, Z1, ZQ); SBAR();
    QK_LD(Z0, Z1, ZQ, 5); SBAR(); QK_MM(X0, X1, XQ); SBAR();
    QK_LD(X0, X1, XQ, 6); SBAR(); QK_MM(Y0, Y1, YQ); SBAR();
    QK_LD(Y0, Y1, YQ, 7); SBAR(); QK_MM(Z0, Z1, ZQ); SBAR();
    QK_MM(X0, X1, XQ); SBAR(); QK_MM(Y0, Y1, YQ); SBAR();
#undef QK_LD
#undef QK_MM
#else
#pragma unroll
    for (int d0 = 0; d0 < 8; ++d0) { const char* a = kb[d0 & 3] + (d0 >> 2) * 128;
        const bf16x8 b0 = *reinterpret_cast<const bf16x8*>(a), b1 = *reinterpret_cast<const bf16x8*>(a + 32 * 256), q = *reinterpret_cast<const bf16x8*>(Q_lds + d0 * 1024);
        p0 = __builtin_amdgcn_mfma_f32_32x32x16_bf16(b0, q, p0, 0, 0, 0); p1 = __builtin_amdgcn_mfma_f32_32x32x16_bf16(b1, q, p1, 0, 0, 0); }
#endif
}
#ifndef ATT_QPIN
#define ATT_QPIN 0
#endif
#ifndef ATT_QREG
#define ATT_QREG 0
#endif
template <int KB, bool BIAS>
__device__ __forceinline__ void qkt_r(f32x16& p0, f32x16& p1, const char* K_lds, int r32, int hi, const bf16x8* qr, const float* bp) {
    if constexpr (BIAS) {
#pragma unroll
        for (int g = 0; g < 4; ++g) { const f32x4 b0 = *(const f32x4*)(bp + 8 * g), b1 = *(const f32x4*)(bp + 32 + 8 * g);
#pragma unroll
            for (int e = 0; e < 4; ++e) { p0[4 * g + e] = b0[e]; p1[4 * g + e] = b1[e]; } }
    } else { p0 = f32x16{}; p1 = f32x16{}; }
    const char* kb[4];
#pragma unroll
    for (int dd = 0; dd < 4; ++dd) kb[dd] = K_lds + KB * SHM_K + KSWZ(r32, (dd * 16 + hi * 8) * 2);
#pragma unroll
    for (int d0 = 0; d0 < 8; ++d0) { const char* a = kb[d0 & 3] + (d0 >> 2) * 128;
        bf16x8 b0 = *reinterpret_cast<const bf16x8*>(a);
        bf16x8 b1 = *reinterpret_cast<const bf16x8*>(a + 32 * 256);
        p0 = __builtin_amdgcn_mfma_f32_32x32x16_bf16(b0, qr[d0], p0, 0, 0, 0);
        p1 = __builtin_amdgcn_mfma_f32_32x32x16_bf16(b1, qr[d0], p1, 0, 0, 0); }
}
template <int VB>
__device__ __forceinline__ void pv_tile(f32x16* o, int vb0, bf16x8 pa0, bf16x8 pa1, bf16x8 pa2, bf16x8 pa3) {
#define TRRD(dst, off) asm volatile("ds_read_b64_tr_b16 %0, %1 offset:%2" : "=&v"(dst) : "v"(vb0), "i"(off) : "memory")
#define PV_D0(d0) do { s16x4 l0, l1, l2, l3, h0, h1, h2, h3; constexpr int b_ = VB * SHM_V + v_rd_off(d0, 0, 0); \
        TRRD(l0, b_); TRRD(h0, b_ + 2048); TRRD(l1, b_ + 4096); TRRD(h1, b_ + 6144); TRRD(l2, b_ + 8192); TRRD(h2, b_ + 10240); TRRD(l3, b_ + 12288); TRRD(h3, b_ + 14336); \
        asm volatile("s_waitcnt lgkmcnt(0)" ::: "memory"); SBAR();   \
        o[d0] = __builtin_amdgcn_mfma_f32_32x32x16_bf16(pa0, (bf16x8){l0[0], l0[1], l0[2], l0[3], h0[0], h0[1], h0[2], h0[3]}, o[d0], 0, 0, 0);   \
        o[d0] = __builtin_amdgcn_mfma_f32_32x32x16_bf16(pa1, (bf16x8){l1[0], l1[1], l1[2], l1[3], h1[0], h1[1], h1[2], h1[3]}, o[d0], 0, 0, 0);   \
        o[d0] = __builtin_amdgcn_mfma_f32_32x32x16_bf16(pa2, (bf16x8){l2[0], l2[1], l2[2], l2[3], h2[0], h2[1], h2[2], h2[3]}, o[d0], 0, 0, 0);   \
        o[d0] = __builtin_amdgcn_mfma_f32_32x32x16_bf16(pa3, (bf16x8){l3[0], l3[1], l3[2], l3[3], h3[0], h3[1], h3[2], h3[3]}, o[d0], 0, 0, 0); } while (0)
    PV_D0(0); PV_D0(1); PV_D0(2); PV_D0(3);
#undef PV_D0
#undef TRRD
}

struct BlockRef { const bf16* Q; const bf16* K; const bf16* V; bf16* O; unsigned char* O8; unsigned* ovf; int P0; int kind; int j0; int j1; int part; float* pself; const float* pother; unsigned* pcnt; const float* bias; const unsigned long long* mask; };
struct Seam { bf16x8 qr[8]; bf16x8 st_v0, st_v1, st_k0, st_k1; float st_b; };
#define ROW(p, k0, rr) ((p) + (size_t)((k0) + (rr)) * LDQ + sc)
#define VMW() asm volatile("s_waitcnt vmcnt(0)" ::: "memory")
#define VMWN(n) asm volatile("s_waitcnt vmcnt(%0)" :: "i"(n) : "memory")
#define SLOAD_H(Kp, Vp, Bp, k0) do { S.st_v0 = load8(ROW(Vp, k0, sr)); S.st_v1 = load8(ROW(Vp, k0, 32 + sr));              \
                         S.st_k0 = load8(ROW(Kp, k0, sr)); S.st_k1 = load8(ROW(Kp, k0, 32 + sr)); S.st_b = (Bp)[(k0) + (tid & 63)]; } while (0)
#define SWRITE_HK(bf) do { *(bf16x8*)(K_lds + (bf) * SHM_K + kws) = S.st_k0; *(bf16x8*)(K_lds + (bf) * SHM_K + kws + 32 * 256) = S.st_k1; \
                         if (tid < 64) ((float*)(lds + LDS_BIAS))[(bf) * 64 + tid] = S.st_b; } while (0)
#define SWRITE_HV(bf) do { *(bf16x8*)(V_lds + (bf) * SHM_V + vst0) = S.st_v0; *(bf16x8*)(V_lds + (bf) * SHM_V + vst1) = S.st_v1; } while (0)
#define SWRITE_H(bf) do { SWRITE_HV(bf); SWRITE_HK(bf); } while (0)
__device__ __forceinline__ void attn_prime(const BlockRef& cur, char* lds, Seam& S) {
    int tid = threadIdx.x; asm volatile("" : "+v"(tid));
    const int wid = __builtin_amdgcn_readfirstlane(tid >> 6), lane = tid & 63, r32 = lane & 31, hi = lane >> 5;
    const int sr = tid >> 4, sc = (tid & 15) * 8, kws = KSWZ(sr, sc * 2); char* K_lds = lds + 2 * SHM_V;
#pragma unroll
    for (int d0 = 0; d0 < 8; ++d0) S.qr[d0] = load8(cur.Q + (size_t)(wid * QBLK + r32) * LDQ + d0 * 16 + hi * 8);
    SLOAD_H(cur.K, cur.V, cur.bias, cur.j0 * KVBLK); VMW(); SWRITE_HK(0);
    __syncthreads();
}
template <int KIND> __device__ __forceinline__ void attn_block(const BlockRef& cur, const BlockRef& nxt, char* lds, Seam& S) {
    int tid = threadIdx.x; asm volatile("" : "+v"(tid));
    const int wid = __builtin_amdgcn_readfirstlane(tid >> 6), lane = tid & 63, r32 = lane & 31, hi = lane >> 5;
    const int j_lo = cur.j0, NT = cur.j1 - j_lo;
    const int qlo = cur.P0 + wid * QBLK, qm = qlo + r32 - 4 * hi;
    char* V_lds = lds; char* K_lds = lds + 2 * SHM_V;
    float* ws = (float*)(lds + 2 * SHM_V + 2 * SHM_K) + wid * 64; float* li_l = ws, * al_l = ws + 32;
    const float* biasL = (const float*)(lds + LDS_BIAS);
    constexpr int kind = KIND;
    char* Q_lds = lds + LDS_Q + wid * 8192 + lane * 16;
#if !ATT_QREG
#pragma unroll
    for (int d0 = 0; d0 < 8; ++d0) *(bf16x8*)(Q_lds + d0 * 1024) = S.qr[d0];
#define QKT(KB_, P0_, P1_, BP_) qkt<KB_, KIND == 0>(P0_, P1_, K_lds, r32, hi, Q_lds, BP_)
#else
#define QKT(KB_, P0_, P1_, BP_) qkt_r<KB_, KIND == 0>(P0_, P1_, K_lds, r32, hi, S.qr, BP_)
#endif
    const unsigned long long* mrow = cur.mask + (size_t)(qlo + r32) * 128;
    float m_reg = -1e30f, l_reg = 0; f32x16 o[4] = {};
    const int sr = tid >> 4, sc = (tid & 15) * 8, vst0 = v_st(sr, sc), vst1 = v_st(32 + sr, sc), kws = KSWZ(sr, sc * 2);
    const int vb0 = (int)(uintptr_t)V_lds + v_rd_base(lane);
    const bf16* Kh = cur.K; const bf16* Vh = cur.V;
    unsigned long long mwA = 0ull, mwB = 0ull;
#define RESC(a) do { if (__any((a) < 1.f)) { if (hi == 0) al_l[r32] = (a); asm volatile("s_waitcnt lgkmcnt(0)" ::: "memory");              \
                     for (int d_ = 0; d_ < 4; ++d_) for (int r = 0; r < 16; ++r) o[d_][r] *= al_l[crow(r, hi)]; } } while (0)
#define KBASE(t) ((j_lo + (t)) * KVBLK)
#define LOADMW(MW_, t) do { if constexpr (KIND == 1) MW_ = mrow[j_lo + (t)]; } while (0)
#define BIASP(bf) (biasL + (bf) * 64 + 4 * hi)
#define MASKT(P0_, P1_, MW_, t) do { const int kb_ = KBASE(t);                                                                               \
        if constexpr (KIND == 0) { if (kb_ + KVBLK - 1 > qlo) mask_causal(P0_, P1_, qm - kb_); }                                          \
        else { mask_bits(P0_, P1_, (unsigned)MW_ >> (4 * hi), (unsigned)(MW_ >> 32) >> (4 * hi)); } } while (0)
    constexpr int NQL = 8;
#define SEAM_K0() do { VMWN(NQL); SWRITE_HK(0); SBAR(); } while (0)
    f32x16 pA0, pA1, pB0, pB1; float mnA, mnB, alA, alB; bf16x8 pa0, pa1, pa2, pa3;
    SWRITE_HV(0); SBAR();
    LOADMW(mwA, 0); LOADMW(mwB, 1);
    if (NT > 1) { SLOAD_H(Kh, Vh, cur.bias, KBASE(1)); }
    SBAR(); QKT(0, pA0, pA1, BIASP(0));
    MASKT(pA0, pA1, mwA, 0); partialSM(pA0, pA1, m_reg, mnA, alA);
    if (NT > 1) { VMW(); SWRITE_H(1); }
    __syncthreads();
#define HALF_STEP(PX0, PX1, mnX, alX, PY0, PY1, alY, MWX, MWN, t, KB, VB, SB) do {                                                      \
        SBAR(); LOADMW(MWN, (t) + 1); QKT(KB, PX0, PX1, BIASP(KB));                                                            \
        finishSM(PY0, PY1, alY, l_reg, pa0, pa1, pa2, pa3); SBAR();                                                           \
        if ((t) + 1 < NT) { SLOAD_H(Kh, Vh, cur.bias, KBASE((t) + 1)); SBAR(); }                                                        \
        pv_tile<VB>(o, vb0, pa0, pa1, pa2, pa3); MASKT(PX0, PX1, MWX, (t)); partialSM(PX0, PX1, m_reg, mnX, alX);                  \
        __syncthreads();                                                                                                      \
        if ((t) + 1 < NT) { VMW(); SWRITE_H(SB); }                                                                            \
        RESC(alX); __syncthreads(); } while (0)
    for (int t = 1; t + 1 < NT; t += 2) {
        HALF_STEP(pB0, pB1, mnB, alB, pA0, pA1, alA, mwB, mwA, t, 1, 0, 0);
        HALF_STEP(pA0, pA1, mnA, alA, pB0, pB1, alB, mwA, mwB, t + 1, 0, 1, 1);
    }
    const bool even = (NT & 1) == 0;
    if (even) { SBAR(); QKT(1, pB0, pB1, BIASP(1)); SBAR(); }
    SLOAD_H(nxt.K, nxt.V, nxt.bias, nxt.j0 * KVBLK); SBAR();
#pragma unroll
    for (int d0 = 0; d0 < 8; ++d0) S.qr[d0] = load8(nxt.Q + (size_t)(wid * QBLK + r32) * LDQ + d0 * 16 + hi * 8);
    SBAR();
    finishSM(pA0, pA1, alA, l_reg, pa0, pa1, pa2, pa3); SBAR();
    pv_tile<0>(o, vb0, pa0, pa1, pa2, pa3);
    if (even) { MASKT(pB0, pB1, mwB, NT - 1); partialSM(pB0, pB1, m_reg, mnB, alB); __syncthreads(); RESC(alB);
        finishSM(pB0, pB1, alB, l_reg, pa0, pa1, pa2, pa3); SBAR(); pv_tile<1>(o, vb0, pa0, pa1, pa2, pa3); }
    SBAR(); SEAM_K0();
    bool do_out = true;
    if (cur.part) {
        const __amdgpu_buffer_rsrc_t prs = __builtin_amdgcn_make_buffer_rsrc((void*)cur.pself, 0, (8 * 16 * 256 + 512) * 4, 0x00020000);
        const unsigned pbo = (unsigned)((wid * 16) * 256 + lane * 4) * 4u;
#pragma unroll
        for (int d0 = 0; d0 < 4; ++d0)
#pragma unroll
            for (int g = 0; g < 4; ++g) { const f32x4 v4 = (f32x4){o[d0][4 * g], o[d0][4 * g + 1], o[d0][4 * g + 2], o[d0][4 * g + 3]};
                __builtin_amdgcn_raw_buffer_store_b128(__builtin_bit_cast(u32x4, v4), prs, pbo + (unsigned)((d0 * 4 + g) * 256) * 4u, 0,   16); }
        if (hi == 0) __hip_atomic_store((unsigned long long*)(cur.pself + 8 * 16 * 256 + (wid * 32 + r32) * 2), ((unsigned long long)__float_as_uint(l_reg) << 32) | __float_as_uint(m_reg), __ATOMIC_RELAXED, __HIP_MEMORY_SCOPE_AGENT);
        asm volatile("s_waitcnt vmcnt(0)" ::: "memory");
        __syncthreads();
        if (tid == 0) {
            const unsigned old = __hip_atomic_fetch_add(cur.pcnt, 1u, __ATOMIC_RELAXED, __HIP_MEMORY_SCOPE_AGENT);
            if (old == 1u) { __builtin_amdgcn_fence(__ATOMIC_ACQUIRE, "agent"); asm volatile("s_waitcnt vmcnt(0)" ::: "memory"); }
            *(volatile unsigned*)(lds + LDS_FLAG) = old; }
        __syncthreads();
        do_out = (*(volatile unsigned*)(lds + LDS_FLAG) == 1u);
    }
    if (do_out) {
        if (hi == 0) { li_l[r32] = l_reg; al_l[r32] = m_reg; } asm volatile("s_waitcnt lgkmcnt(0)" ::: "memory");
        constexpr float C2e = 1.4426950408889634f * SCALE;
        if (cur.part) { const float* pmo = cur.pother + 8 * 16 * 256 + (wid * 32) * 2; const float* po = cur.pother + (size_t)(wid * 16) * 256 + lane * 4;
#pragma unroll
            for (int g = 0; g < 4; ++g) { float as_[4], ao_[4], ri_[4];
#pragma unroll
                for (int e = 0; e < 4; ++e) { const int row = crow(4 * g + e, hi); const float m1 = al_l[row], l1 = li_l[row], m2 = pmo[row * 2], l2 = pmo[row * 2 + 1];
                    const float mm = fmaxf(m1, m2); const float a1 = __builtin_amdgcn_exp2f((m1 - mm) * C2e), a2 = __builtin_amdgcn_exp2f((m2 - mm) * C2e);
                    const float ri = __builtin_amdgcn_rcpf(__fadd_rn(__fmul_rn(a1, l1), __fmul_rn(a2, l2))); as_[e] = __fmul_rn(a1, ri); ao_[e] = __fmul_rn(a2, ri); }
#pragma unroll
                for (int d0 = 0; d0 < 4; ++d0) { const f32x4 v = *(const f32x4*)(po + (d0 * 4 + g) * 256);
#pragma unroll
                    for (int e = 0; e < 4; ++e) o[d0][4 * g + e] = __fadd_rn(__fmul_rn(as_[e], o[d0][4 * g + e]), __fmul_rn(ao_[e], v[e])); }
                __builtin_amdgcn_sched_barrier(0); }
        } else {
#pragma unroll
            for (int r = 0; r < 16; ++r) { const float ri = __builtin_amdgcn_rcpf(li_l[crow(r, hi)]);
#pragma unroll
                for (int d0 = 0; d0 < 4; ++d0) o[d0][r] *= ri; }
        }
        int hi_e = hi, r32_e = r32; asm volatile("" : "+v"(hi_e), "+v"(r32_e));
        bf16* Ow = cur.O + (size_t)(wid * QBLK + 4 * hi_e) * LDO + r32_e;
#if WO_FP8
        unsigned char* O8w = cur.O8 + (size_t)(wid * QBLK + 4 * hi_e) * LDO + r32_e; float amx = 0.f;
#endif
#pragma unroll
        for (int r = 0; r < 16; ++r) { const int orow = (r & 3) + 8 * (r >> 2);
#pragma unroll
            for (int d0 = 0; d0 < 4; ++d0) { const float v = o[d0][r];
                const float vn = __shfl_xor(v, 1);
                if ((r32 & 1) == 0) *(unsigned*)(Ow + orow * LDO + d0 * 32) = cvtpk(v, vn);
#if WO_FP8
                amx = fmaxf(amx, fabsf(v));
                const int p8 = __builtin_amdgcn_cvt_pk_fp8_f32(v * MIX_S, vn * MIX_S, 0, false), q8 = __shfl_xor(p8, 2);
                if ((r32 & 3) == 0) *(unsigned*)(O8w + orow * LDO + d0 * 32) = ((unsigned)p8 & 0xffffu) | ((unsigned)q8 << 16);
#endif
            } }
#if WO_FP8
        if (__any(amx * MIX_S > 448.f)) { if (lane == 0) __hip_atomic_fetch_or(cur.ovf, 1u, __ATOMIC_RELAXED, __HIP_MEMORY_SCOPE_AGENT); }
#endif
    }
    __syncthreads();
#undef RESC
#undef KBASE
#undef LOADMW
#undef QKT
#undef BIASP
#undef MASKT
#undef SEAM_K0
#undef HALF_STEP
}
#undef ROW
#undef VMW
#undef VMWN
#undef SLOAD_H
#undef SWRITE_HK
#undef SWRITE_HV
#undef SWRITE_H
#undef KSWZ
#undef SBAR
}

__device__ __forceinline__ int tid_op() { int t = threadIdx.x; asm volatile("" : "+v"(t)); return t; }
#define TID_ tid_op()
#define LANE_ (tid_op() & 63)
struct Frame {
    LAS unsigned char* lds; volatile LAS unsigned* MISC; unsigned* ctl;
    int wave, G, gw, NGW;
    GAS unsigned char* ws;
};
struct Args { const float* in[18]; float* out; unsigned char* ws; int ph_lo, ph_hi; };
enum { I_X = 0, I_C, I_ADA_W, I_ADA_B, I_NORM1_G, I_NORM2_G, I_FINAL_G, I_W_IN, I_FOX_FBIAS, I_GLA_WA2, I_GLA_BA, I_GLA_NORM_G, I_W_OUT, I_PEER_WQ, I_PEER_K1, I_PEER_K2, I_PEER_U, I_PEER_V };
__device__ __forceinline__ const float* inp(int i) { asm volatile("" : "+s"(i)); const __attribute__((address_space(4))) Args* a = (const __attribute__((address_space(4))) Args*)__builtin_amdgcn_kernarg_segment_ptr(); return (const float*)(const GAS float*)a->in[i]; }
__device__ __forceinline__ float* outp() { int i = 0; asm volatile("" : "+s"(i)); const __attribute__((address_space(4))) Args* a = (const __attribute__((address_space(4))) Args*)__builtin_amdgcn_kernarg_segment_ptr(); return (float*)(GAS float*)(&a->out)[i]; }
__device__ __forceinline__ int deq(Frame& F, int q) {
    __syncthreads();
    if (TID_ == 0) F.MISC[0] = __hip_atomic_fetch_add(F.ctl + CW_Q + 64 * q, 1u, __ATOMIC_RELAXED, __HIP_MEMORY_SCOPE_AGENT);
    __syncthreads();
    return __builtin_amdgcn_readfirstlane((int)F.MISC[0]);
}

template <bool MAPPED> __device__ __forceinline__ void transpose_item(const float* W, int K, int N, bf16_t* WT, int nblk, LAS float* scr, int item, int lane) {
    const int kb = item / nblk, nb = item % nblk, k0 = 64 * kb, n0 = 32 * nb;
    const int nsrc = MAPPED ? win_src_col(n0 + (lane & 31)) : n0 + (lane & 31);
#pragma unroll 8
    for (int i = 0; i < 32; ++i) { const int kk = 2 * i + (lane >> 5); scr[kk * 33 + (lane & 31)] = nsrc >= 0 ? W[(size_t)(k0 + kk) * N + nsrc] : 0.f; }
    asm volatile("s_waitcnt lgkmcnt(0)" ::: "memory");
    const int c = lane & 7;
#pragma unroll
    for (int j = 0; j < 4; ++j) { const int n = (lane >> 3) + 8 * j; const LAS float* s = scr + (8 * c) * 33 + n;
        u32x4 o; o.x = pk2(s[0 * 33], s[1 * 33]); o.y = pk2(s[2 * 33], s[3 * 33]); o.z = pk2(s[4 * 33], s[5 * 33]); o.w = pk2(s[6 * 33], s[7 * 33]);
        *(u32x4*)(WT + (size_t)(n0 + n) * K + k0 + 8 * c) = o; }
    asm volatile("s_waitcnt lgkmcnt(0)" ::: "memory");
}
template <bool MAPPED> __device__ __forceinline__ void transpose_item_f8(const float* W, int K, int N, unsigned char* WT, int nblk, LAS float* scr, int item, int lane, float inv) {
    const int kb = item / nblk, nb = item % nblk, k0 = 64 * kb, n0 = 32 * nb;
    const int nsrc = MAPPED ? win_src_col(n0 + (lane & 31)) : n0 + (lane & 31);
#pragma unroll 8
    for (int i = 0; i < 32; ++i) { const int kk = 2 * i + (lane >> 5); scr[kk * 33 + (lane & 31)] = nsrc >= 0 ? W[(size_t)(k0 + kk) * N + nsrc] : 0.f; }
    asm volatile("s_waitcnt lgkmcnt(0)" ::: "memory");
#pragma unroll
    for (int j = 0; j < 2; ++j) { const int idx = lane + 64 * j, n = idx >> 2, c = idx & 3; const LAS float* sp = scr + (16 * c) * 33 + n; u32x4 o;
#pragma unroll
        for (int q = 0; q < 4; ++q) { int w = __builtin_amdgcn_cvt_pk_fp8_f32(sp[(4 * q) * 33] * inv, sp[(4 * q + 1) * 33] * inv, 0, false); w = __builtin_amdgcn_cvt_pk_fp8_f32(sp[(4 * q + 2) * 33] * inv, sp[(4 * q + 3) * 33] * inv, w, true); o[q] = (unsigned)w; }
        *(u32x4*)(WT + (size_t)(n0 + n) * K + k0 + 16 * c) = o; }
    asm volatile("s_waitcnt lgkmcnt(0)" ::: "memory");
}
__device__ __forceinline__ void convert_flat(const float* src, bf16_t* dst, size_t n, int gw, int NGW, int lane) {
    for (size_t i = (size_t)gw * 512 + lane * 8; i < n; i += (size_t)NGW * 512) {
        const f32x4 a = *(const f32x4*)(src + i), b = *(const f32x4*)(src + i + 4);
        u32x4 o; o.x = pk2(a[0], a[1]); o.y = pk2(a[2], a[3]); o.z = pk2(b[0], b[1]); o.w = pk2(b[2], b[3]);
        *(u32x4*)(dst + i) = o; }
}
__device__ __forceinline__ float clamp6(float x) { return fminf(fmaxf(x, -6.f), 6.f); }
__device__ __forceinline__ void convert_row_fp8(const float* src, unsigned* dst, float* scale, int lane) {
    f32x4 v[8]; float am = 0.f, ss = 0.f;
#pragma unroll
    for (int j = 0; j < 8; ++j) { v[j] = *(const f32x4*)(src + 256 * j + 4 * lane); am = fmaxf(am, fmaxf(fmaxf(fabsf(v[j][0]), fabsf(v[j][1])), fmaxf(fabsf(v[j][2]), fabsf(v[j][3]))));
        ss += (v[j][0] * v[j][0] + v[j][1] * v[j][1]) + (v[j][2] * v[j][2] + v[j][3] * v[j][3]); }
#pragma unroll
    for (int o = 1; o < 64; o <<= 1) { am = fmaxf(am, __shfl_xor(am, o)); ss += __shfl_xor(ss, o); }
    const float s6 = fminf(am, 3.f * sqrtf(ss * (1.f / 2048.f)));
    const float sc = s6 > 0.f ? s6 * (1.f / 6.f) : 1.f, inv = s6 > 0.f ? 6.f / s6 : 1.f;
    u32x4 o;
#pragma unroll
    for (int q = 0; q < 4; ++q) { const f32x4 a = v[2 * q], b = v[2 * q + 1]; unsigned w = 0u;
        w = __builtin_amdgcn_cvt_scalef32_pk_fp4_f32(w, clamp6(a[0] * inv), clamp6(a[1] * inv), 1.0f, 0);
        w = __builtin_amdgcn_cvt_scalef32_pk_fp4_f32(w, clamp6(a[2] * inv), clamp6(a[3] * inv), 1.0f, 1);
        w = __builtin_amdgcn_cvt_scalef32_pk_fp4_f32(w, clamp6(b[0] * inv), clamp6(b[1] * inv), 1.0f, 2);
        w = __builtin_amdgcn_cvt_scalef32_pk_fp4_f32(w, clamp6(b[2] * inv), clamp6(b[3] * inv), 1.0f, 3);
        o[q] = w; }
    *(u32x4*)(dst + 4 * lane) = o;
    if (lane == 0) *scale = sc;
}
constexpr int CONV_ITEMS = 16384 / 64;
__device__ __forceinline__ void conv_row_regs(Frame& F, const f32x4 (&v)[8], int tb, int row, int lane) {
    float am = 0.f, ss = 0.f;
#pragma unroll
    for (int j = 0; j < 8; ++j) { am = fmaxf(am, fmaxf(fmaxf(fabsf(v[j][0]), fabsf(v[j][1])), fmaxf(fabsf(v[j][2]), fabsf(v[j][3]))));
        ss += (v[j][0] * v[j][0] + v[j][1] * v[j][1]) + (v[j][2] * v[j][2] + v[j][3] * v[j][3]); }
#pragma unroll
    for (int o = 1; o < 64; o <<= 1) { am = fmaxf(am, __shfl_xor(am, o)); ss += __shfl_xor(ss, o); }
    const float s6 = fminf(am, 3.f * sqrtf(ss * (1.f / 2048.f)));
    const float sc = s6 > 0.f ? s6 * (1.f / 6.f) : 1.f, inv = s6 > 0.f ? 6.f / s6 : 1.f;
    u32x4 o;
#pragma unroll
    for (int q = 0; q < 4; ++q) { const f32x4 a = v[2 * q], b = v[2 * q + 1]; unsigned w = 0u;
        w = __builtin_amdgcn_cvt_scalef32_pk_fp4_f32(w, clamp6(a[0] * inv), clamp6(a[1] * inv), 1.0f, 0);
        w = __builtin_amdgcn_cvt_scalef32_pk_fp4_f32(w, clamp6(a[2] * inv), clamp6(a[3] * inv), 1.0f, 1);
        w = __builtin_amdgcn_cvt_scalef32_pk_fp4_f32(w, clamp6(b[0] * inv), clamp6(b[1] * inv), 1.0f, 2);
        w = __builtin_amdgcn_cvt_scalef32_pk_fp4_f32(w, clamp6(b[2] * inv), clamp6(b[3] * inv), 1.0f, 3);
        o[q] = w; }
    *(u32x4*)((unsigned*)(F.ws + (tb ? WS_VB : WS_UB)) + (size_t)row * (DM / 8) + 4 * lane) = o;
    if (lane == 0) ((float*)(F.ws + (tb ? WS_SV : WS_SU)))[row] = sc;
}
__device__ __forceinline__ void conv_item(Frame& F, int l, int tb, int item) {
    const int lane = LANE_; const int row0 = l * 16384 + item * 64 + F.wave * 8;
    const float* src = (tb ? inp(I_PEER_V) : inp(I_PEER_U)) + (size_t)row0 * DM + 4 * lane;
    f32x4 v[4][8];
#pragma unroll
    for (int r = 0; r < 4; ++r)
#pragma unroll
        for (int j = 0; j < 8; ++j) v[r][j] = __builtin_nontemporal_load((const f32x4*)(src + (size_t)r * DM + 256 * j));
    __builtin_amdgcn_sched_barrier(0);
#pragma unroll
    for (int r = 0; r < 4; ++r) {
        conv_row_regs(F, v[r], tb, row0 + r, lane);
        __builtin_amdgcn_sched_barrier(0);
#pragma unroll
        for (int j = 0; j < 8; ++j) v[r][j] = __builtin_nontemporal_load((const f32x4*)(src + (size_t)(r + 4) * DM + 256 * j));
        __builtin_amdgcn_sched_barrier(0);
    }
#pragma unroll
    for (int r = 0; r < 4; ++r) { conv_row_regs(F, v[r], tb, row0 + 4 + r, lane); __builtin_amdgcn_sched_barrier(0); }
}
__device__ __forceinline__ void p0a_prologue(Frame& F) {
    const int gw = F.gw, NGW = F.NGW, lane = LANE_;
    { float* modp = (float*)(F.ws + WS_MODP);
      for (int it = gw; it < 2 * 48 * 32; it += NGW) { const int l = it / (48 * 32), r = it % (48 * 32), eb = r / 32, dc = r % 32;
          f32x4 acc = {0.f, 0.f, 0.f, 0.f}; const float* wp = inp(I_ADA_W) + ((size_t)l * DM + dc * 64) * NMOD + eb * 256 + lane * 4;
#pragma unroll 16
          for (int rr = 0; rr < 64; ++rr) { const float cv = inp(I_C)[dc * 64 + rr]; const float ca = cv / (1.f + __expf(-cv)); acc = acc + ca * *(const f32x4*)(wp + (size_t)rr * NMOD); }
          *(f32x4*)(modp + ((size_t)(l * 32 + dc)) * NMOD + eb * 256 + lane * 4) = acc; } }
    { LAS float* scr = (LAS float*)(F.lds + F.wave * 8448);
      constexpr int I_IN = 32 * (LDZ / 32), I_SQ = 32 * 64;
      for (int it = gw; it < 2 * (I_IN + 2 * I_SQ); it += NGW) { const int l = it / (I_IN + 2 * I_SQ); int r = it % (I_IN + 2 * I_SQ);
          if (r < I_IN) {
#if WIN_FP8
              if (!((WIN_BF16_TILES >> ((r % (LDZ / 32)) >> 3)) & 1u)) continue;
#endif
              transpose_item<true>(inp(I_W_IN) + (size_t)l * DM * NIN, DM, NIN, (bf16_t*)(F.ws + WS_WIN) + (size_t)l * LDZ * DM, LDZ / 32, scr, r, lane);
              continue; } r -= I_IN;
          if (r < I_SQ) { transpose_item<false>(inp(I_W_OUT) + (size_t)l * DM * DM, DM, DM, (bf16_t*)(F.ws + WS_WO) + (size_t)l * DM * DM, 64, scr, r, lane); continue; } r -= I_SQ;
          transpose_item<false>(inp(I_PEER_WQ) + (size_t)l * DM * DM, DM, DM, (bf16_t*)(F.ws + WS_WQ) + (size_t)l * DM * DM, 64, scr, r, lane); } }
#if !CONV_IN_QUEUES
    for (int r = gw; r < 2 * 2 * 16384; r += NGW) {
        const int tb = r >> 15, row = r & 32767;
        convert_row_fp8((tb ? inp(I_PEER_V) : inp(I_PEER_U)) + (size_t)row * DM, (unsigned*)(F.ws + (tb ? WS_VB : WS_UB)) + (size_t)row * (DM / 8), (float*)(F.ws + (tb ? WS_SV : WS_SU)) + row, lane); }
#endif
#if WIN_FP8
#pragma unroll 1
    for (int l = 0; l < DEPTH; ++l) { const float* w = inp(I_W_IN) + (size_t)l * DM * NIN; float am = 0.f;
        for (size_t i = (size_t)gw * 256 + lane * 4; i < (size_t)DM * NIN; i += (size_t)NGW * 256) { const f32x4 a = *(const f32x4*)(w + i); am = fmaxf(am, fmaxf(fmaxf(fabsf(a[0]), fabsf(a[1])), fmaxf(fabsf(a[2]), fabsf(a[3])))); }
#pragma unroll
        for (int o = 1; o < 64; o <<= 1) am = fmaxf(am, __shfl_xor(am, o));
        if (lane == 0) __hip_atomic_fetch_max(F.ctl + CW_WAMAX + l, __float_as_uint(am), __ATOMIC_RELAXED, __HIP_MEMORY_SCOPE_AGENT); }
#endif
#if WO_FP8
#pragma unroll 1
    for (int l = 0; l < DEPTH; ++l) { const float* w = inp(I_W_OUT) + (size_t)l * DM * DM; float am = 0.f;
        for (size_t i = (size_t)gw * 256 + lane * 4; i < (size_t)DM * DM; i += (size_t)NGW * 256) { const f32x4 a = *(const f32x4*)(w + i); am = fmaxf(am, fmaxf(fmaxf(fabsf(a[0]), fabsf(a[1])), fmaxf(fabsf(a[2]), fabsf(a[3])))); }
#pragma unroll
        for (int o = 1; o < 64; o <<= 1) am = fmaxf(am, __shfl_xor(am, o));
        if (lane == 0) __hip_atomic_fetch_max(F.ctl + CW_WAMAX + 2 + l, __float_as_uint(am), __ATOMIC_RELAXED, __HIP_MEMORY_SCOPE_AGENT); }
#endif
    convert_flat(inp(I_PEER_K1), (bf16_t*)(F.ws + WS_KB), (size_t)2 * 8 * 128 * 128, gw, NGW, lane);
    convert_flat(inp(I_PEER_K2), (bf16_t*)(F.ws + WS_KB) + 2 * 8 * 128 * 128, (size_t)2 * 8 * 128 * 128, gw, NGW, lane);
}
__device__ __forceinline__ void p0b_modreduce(Frame& F) {
    const float* modp = (const float*)(F.ws + WS_MODP); float* mod = (float*)(F.ws + WS_MOD);
    for (int e = blockIdx.x * 512 + TID_; e < 2 * NMOD; e += F.G * 512) { const int l = e / NMOD, cidx = e % NMOD; float s = inp(I_ADA_B)[e];
        float p[32];
#pragma unroll
        for (int dc = 0; dc < 32; ++dc) p[dc] = modp[((size_t)(l * 32 + dc)) * NMOD + cidx];
#pragma unroll
        for (int dc = 0; dc < 32; ++dc) s += p[dc];
        mod[e] = s; }
#if WIN_FP8
    { LAS float* scr = (LAS float*)(F.lds + F.wave * 8448); constexpr int I_IN = 32 * (LDZ / 32); const int lane = LANE_;
      for (int it = F.gw; it < 2 * I_IN; it += F.NGW) { const int l = it / I_IN, r = it % I_IN;
          const float am = __uint_as_float(__hip_atomic_load(F.ctl + CW_WAMAX + l, __ATOMIC_RELAXED, __HIP_MEMORY_SCOPE_AGENT)), inv = am > 0.f ? 448.f / am : 1.f;
          transpose_item_f8<true>(inp(I_W_IN) + (size_t)l * DM * NIN, DM, NIN, (unsigned char*)(F.ws + WS_WIN8) + (size_t)l * LDZ * DM, LDZ / 32, scr, r, lane, inv); } }
#endif
#if WO_FP8
    { LAS float* scr = (LAS float*)(F.lds + F.wave * 8448); const int lane = LANE_;
      for (int it = F.gw; it < 2 * 2048; it += F.NGW) { const int l = it >> 11, r = it & 2047;
          const float am = __uint_as_float(__hip_atomic_load(F.ctl + CW_WAMAX + 2 + l, __ATOMIC_RELAXED, __HIP_MEMORY_SCOPE_AGENT)), inv = am > 0.f ? 448.f / am : 1.f;
          transpose_item_f8<false>(inp(I_W_OUT) + (size_t)l * DM * DM, DM, DM, (unsigned char*)(F.ws + WS_WO8) + (size_t)l * DM * DM, 64, scr, r, lane, inv); } }
#endif
}
__device__ __forceinline__ void store_row_f8(const f32x4 (&y)[8], unsigned char* h8, float* sa, int lane) {
    float am = 0.f;
#pragma unroll
    for (int j = 0; j < 8; ++j) am = fmaxf(am, fmaxf(fmaxf(fabsf(y[j][0]), fabsf(y[j][1])), fmaxf(fabsf(y[j][2]), fabsf(y[j][3]))));
#pragma unroll
    for (int o = 1; o < 64; o <<= 1) am = fmaxf(am, __shfl_xor(am, o));
    const float inv = am > 0.f ? 448.f / am : 1.f;
#pragma unroll
    for (int j = 0; j < 8; ++j) { int w = __builtin_amdgcn_cvt_pk_fp8_f32(y[j][0] * inv, y[j][1] * inv, 0, false); w = __builtin_amdgcn_cvt_pk_fp8_f32(y[j][2] * inv, y[j][3] * inv, w, true); *(unsigned*)(h8 + 256 * j + 4 * lane) = (unsigned)w; }
    if (lane == 0) *sa = am > 0.f ? am * (1.f / 448.f) : 1.f;
}
__device__ __forceinline__ void norm_row_f8(const float* xin, const float* g, const float* sc, const float* sh, unsigned char* h8, float* sa, bf16_t* hout, bool wbf, int lane) {
    asm volatile("" : "+v"(lane));
    f32x4 v[8]; float s = 0.f;
#pragma unroll
    for (int j = 0; j < 8; ++j) { v[j] = *(const f32x4*)(xin + 256 * j + 4 * lane); s += (v[j][0] * v[j][0] + v[j][1] * v[j][1]) + (v[j][2] * v[j][2] + v[j][3] * v[j][3]); }
    const float rstd = rsqrtf(wave_sum(s) * (1.f / DM) + 1e-6f);
#pragma unroll
    for (int j = 0; j < 8; ++j) { const int o = 256 * j + 4 * lane; const f32x4 gg = *(const f32x4*)(g + o), a = *(const f32x4*)(sc + o), b = *(const f32x4*)(sh + o); v[j] = v[j] * rstd * gg * (1.f + a) + b;
        if (wbf) *(u32x2*)(hout + o) = (u32x2){pk2(v[j][0], v[j][1]), pk2(v[j][2], v[j][3])}; }
    store_row_f8(v, h8, sa, lane);
}
__device__ __forceinline__ void norm_row(const float* xin, const float* g, const float* sc, const float* sh, bf16_t* hout, float* xcopy, int lane) {
    asm volatile("" : "+v"(lane));
    f32x4 v[8]; float s = 0.f;
#pragma unroll
    for (int j = 0; j < 8; ++j) { v[j] = *(const f32x4*)(xin + 256 * j + 4 * lane); s += (v[j][0] * v[j][0] + v[j][1] * v[j][1]) + (v[j][2] * v[j][2] + v[j][3] * v[j][3]); }
    const float rstd = rsqrtf(wave_sum(s) * (1.f / DM) + 1e-6f);
#pragma unroll
    for (int j = 0; j < 8; ++j) { const int o = 256 * j + 4 * lane; const f32x4 gg = *(const f32x4*)(g + o), a = *(const f32x4*)(sc + o), b = *(const f32x4*)(sh + o);
        const f32x4 y = v[j] * rstd * gg * (1.f + a) + b;
        u32x2 w; w.x = pk2(y[0], y[1]); w.y = pk2(y[2], y[3]);
#if WT_STORES
        __hip_atomic_store((unsigned long long*)(hout + o), ((unsigned long long)w.y << 32) | w.x, __ATOMIC_RELAXED, __HIP_MEMORY_SCOPE_AGENT);
#else
        *(u32x2*)(hout + o) = w;
#endif
        if (xcopy) *(f32x4*)(xcopy + o) = v[j]; }
}

struct IdxTab { unsigned short v[320]; };
constexpr IdxTab make_idx_tab() { IdxTab t{}; int n = 0;
    for (int sz = 8; sz >= 1; --sz) for (int qb = 127; qb >= 0; --qb) { const int ns = qb / 4 + 1;
        for (int c = 0; c * 8 < ns; ++c) { const int s = ns - 8 * c < 8 ? ns - 8 * c : 8; if (s == sz) t.v[n++] = (unsigned short)(qb * 8 + c); } }
    return t; }
__constant__ const IdxTab IDXTAB = make_idx_tab();
constexpr int N_IDX_ITEMS = 320;

__device__ __forceinline__ float relu_fmac(float a, float c, float w) { float r; asm("v_max_f32_e32 %0, 0, %1" : "=v"(r) : "v"(c)); asm("v_fmac_f32_e32 %0, %1, %2" : "+v"(a) : "v"(r), "v"(w)); return a; }
__device__ __forceinline__ void indexer_item(Frame& F, int item) {
    const int code = __builtin_amdgcn_readfirstlane((int)IDXTAB.v[item]), qb = code >> 3, chunk = code & 7;
    const int nsteps_tot = qb / 4 + 1, s0 = chunk * 8, s1 = (s0 + 8 < nsteps_tot) ? s0 + 8 : nsteps_tot;
    int tid = TID_; asm volatile("" : "+v"(tid));
    const int lane = tid & 63, wid = F.wave, r32 = lane & 31, hi = lane >> 5, qg = wid >> 2, kg = wid & 3;
    const bf16_t* Z = (const bf16_t*)(F.ws + WS_Z); const float* zs = (const float*)(F.ws + WS_ZS); float* SC = (float*)(F.ws + WS_SC);
    LAS unsigned char* iqL = F.lds;
    __syncthreads();
#pragma unroll 4
    for (int i = tid; i < 64 * 128; i += 512) { const int q = i >> 7, ch = i & 127;
        const u32x4 v = *(const u32x4*)(Z + (size_t)(qb * 64 + q) * LDZ + ZC_IQ + ch * 8);
        *(LAS u32x4*)(iqL + q * 2048 + ((ch ^ (q & 15)) << 4)) = v; }
    const int qrow = 32 * qg + r32, tq = qb * 64 + qrow;
    float w[16];
#pragma unroll
    for (int h4 = 0; h4 < 4; ++h4) { const f32x4 t4 = *(const f32x4*)(zs + (size_t)tq * 64 + ZS_IW + 4 * h4);
        w[4 * h4 + 0] = t4[0] * 0.03125f; w[4 * h4 + 1] = t4[1] * 0.03125f; w[4 * h4 + 2] = t4[2] * 0.03125f; w[4 * h4 + 3] = t4[3] * 0.03125f; }
    __syncthreads();
    const int qx = qrow & 15;
    bf16x8 ikf[2][4];
    { const int kb0 = s0 * 256 + kg * 64;
#pragma unroll
      for (int nb = 0; nb < 2; ++nb)
#pragma unroll
        for (int ks = 0; ks < 4; ++ks) ikf[nb][ks] = *(const bf16x8*)(Z + (size_t)(kb0 + 32 * nb + r32) * LDZ + ZC_IK + ks * 16 + hi * 8); }
    for (int st = s0; st < s1; ++st) {
        const int kbase = st * 256 + kg * 64;
        bf16x8 ikn[2][4];
        { const int kb2 = ((st + 1 < s1) ? st + 1 : st) * 256 + kg * 64;
#pragma unroll
          for (int nb = 0; nb < 2; ++nb)
#pragma unroll
            for (int ks = 0; ks < 4; ++ks) ikn[nb][ks] = *(const bf16x8*)(Z + (size_t)(kb2 + 32 * nb + r32) * LDZ + ZC_IK + ks * 16 + hi * 8); }
        int qoff = qrow * 2048; asm volatile("" : "+v"(qoff));
        const LAS unsigned char* qad[2][4];
#pragma unroll
        for (int hb = 0; hb < 2; ++hb)
#pragma unroll
            for (int ks = 0; ks < 4; ++ks) qad[hb][ks] = iqL + qoff + (((hb ^ (qx >> 3)) << 7) | (((ks * 2 + hi) ^ (qx & 7)) << 4));
        f32x16 a0 = {}, a1 = {}, pc0 = {}, pc1 = {};
#pragma unroll
        for (int h = 0; h < 16; ++h) {
            bf16x8 bq[4];
#pragma unroll
            for (int ks = 0; ks < 4; ++ks) bq[ks] = *(const LAS bf16x8*)(qad[h & 1][ks] + (h >> 1) * 256);
            f32x16 c0 = {}, c1 = {};
#pragma unroll
            for (int ks = 0; ks < 4; ++ks) { c0 = __builtin_amdgcn_mfma_f32_32x32x16_bf16(ikf[0][ks], bq[ks], c0, 0, 0, 0); c1 = __builtin_amdgcn_mfma_f32_32x32x16_bf16(ikf[1][ks], bq[ks], c1, 0, 0, 0); }
            __builtin_amdgcn_sched_barrier(0);
            if (h > 0) {
#pragma unroll
                for (int r = 0; r < 16; ++r) { a0[r] = relu_fmac(a0[r], pc0[r], w[h - 1]); a1[r] = relu_fmac(a1[r], pc1[r], w[h - 1]); } }
            pc0 = c0; pc1 = c1;
            __builtin_amdgcn_sched_barrier(0);
        }
        asm volatile("s_nop 15\n\ts_nop 7" : "+v"(pc0), "+v"(pc1));
#pragma unroll
        for (int r = 0; r < 16; ++r) { a0[r] = relu_fmac(a0[r], pc0[r], w[15]); a1[r] = relu_fmac(a1[r], pc1[r], w[15]); }
        float* srow = SC + (size_t)tq * S + kbase + 4 * hi;
#pragma unroll
        for (int g = 0; g < 4; ++g) { *(f32x4*)(srow + 8 * g) = (f32x4){a0[4 * g], a0[4 * g + 1], a0[4 * g + 2], a0[4 * g + 3]};
                                      *(f32x4*)(srow + 32 + 8 * g) = (f32x4){a1[4 * g], a1[4 * g + 1], a1[4 * g + 2], a1[4 * g + 3]}; }
#pragma unroll
        for (int nb = 0; nb < 2; ++nb)
#pragma unroll
            for (int ks = 0; ks < 4; ++ks) ikf[nb][ks] = ikn[nb][ks];
    }
}

constexpr int G1_G = 0, G1_QG = 32768, G1_KG = 50176, G1_KDT = 67584, G1_VT = 86016, G1_AL = 104448;
__device__ __forceinline__ void gla_g1_item(Frame& F, int l, int item) {
    const int n = item >> 2, h = item & 3;
    int tid = TID_; asm volatile("" : "+v"(tid));
    const int lane = tid & 63, wid = F.wave, r32 = lane & 31, hi = lane >> 5;
    const bf16_t* Z = (const bf16_t*)(F.ws + WS_Z); const float* zs = (const float*)(F.ws + WS_ZS);
    LAS float* G = (LAS float*)(F.lds + G1_G);
    LAS bf16_t* QG = (LAS bf16_t*)(F.lds + G1_QG); LAS bf16_t* KG = (LAS bf16_t*)(F.lds + G1_KG);
    LAS bf16_t* KDT = (LAS bf16_t*)(F.lds + G1_KDT); LAS bf16_t* VT = (LAS bf16_t*)(F.lds + G1_VT); LAS bf16_t* AL = (LAS bf16_t*)(F.lds + G1_AL);
    const int t = tid >> 3, dg = tid & 7, d0 = dg * 16; const size_t trow = (size_t)n * 64 + t;
    __syncthreads();
    { float ga[16];
#pragma unroll
      for (int r4 = 0; r4 < 4; ++r4) { const f32x4 v = *(const f32x4*)(zs + trow * 64 + ZS_GA + 4 * r4); ga[4 * r4] = v[0]; ga[4 * r4 + 1] = v[1]; ga[4 * r4 + 2] = v[2]; ga[4 * r4 + 3] = v[3]; }
      const float* wa = inp(I_GLA_WA2) + (size_t)l * 16 * 512 + h * 128 + d0; const float* ba = inp(I_GLA_BA) + (size_t)l * 512 + h * 128 + d0;
#pragma unroll
      for (int i4 = 0; i4 < 4; ++i4) { f32x4 x = *(const f32x4*)(ba + 4 * i4);
#pragma unroll
          for (int r = 0; r < 16; ++r) x = x + ga[r] * *(const f32x4*)(wa + (size_t)r * 512 + 4 * i4);
          f32x4 la; la[0] = logsigmoidf(x[0]) * 0.0625f; la[1] = logsigmoidf(x[1]) * 0.0625f; la[2] = logsigmoidf(x[2]) * 0.0625f; la[3] = logsigmoidf(x[3]) * 0.0625f;
          *(LAS f32x4*)(G + t * 128 + d0 + 4 * i4) = la; } }
    __syncthreads();
    if (tid < 128) { float run = 0.f; for (int tt = 0; tt < 64; ++tt) { run += G[tt * 128 + tid]; G[tt * 128 + tid] = run; } }
    __syncthreads();
    { const bf16_t* zr = Z + trow * LDZ + h * 128 + d0;
      unsigned qv[8], kv[8], vv[8];
      { const u32x4 a = *(const u32x4*)(zr + ZC_GQ), b = *(const u32x4*)(zr + ZC_GQ + 8); qv[0] = a.x; qv[1] = a.y; qv[2] = a.z; qv[3] = a.w; qv[4] = b.x; qv[5] = b.y; qv[6] = b.z; qv[7] = b.w; }
      { const u32x4 a = *(const u32x4*)(zr + ZC_GK), b = *(const u32x4*)(zr + ZC_GK + 8); kv[0] = a.x; kv[1] = a.y; kv[2] = a.z; kv[3] = a.w; kv[4] = b.x; kv[5] = b.y; kv[6] = b.z; kv[7] = b.w; }
      { const u32x4 a = *(const u32x4*)(zr + ZC_GV), b = *(const u32x4*)(zr + ZC_GV + 8); vv[0] = a.x; vv[1] = a.y; vv[2] = a.z; vv[3] = a.w; vv[4] = b.x; vv[5] = b.y; vv[6] = b.z; vv[7] = b.w; }
      unsigned qgp[8];
#pragma unroll
      for (int i2 = 0; i2 < 8; ++i2) { float qg2[2];
#pragma unroll
          for (int e = 0; e < 2; ++e) { const int d = d0 + 2 * i2 + e; const float g = G[t * 128 + d], gl = G[63 * 128 + d];
              const float q = e ? bfhi(qv[i2]) : bflo(qv[i2]), k = e ? bfhi(kv[i2]) : bflo(kv[i2]), v = e ? bfhi(vv[i2]) : bflo(vv[i2]);
              const float qg = q * 0.08838834764831845f * __expf(g), kg = k * __expf(-g), kd = k * __expf(gl - g);
              qg2[e] = qg; KG[t * 136 + d] = (bf16_t)f2bf(kg); KDT[d * 72 + t] = (bf16_t)f2bf(kd); VT[d * 72 + t] = (bf16_t)f2bf(v);
              if (t == 63) ((float*)(F.ws + WS_DECAY))[((size_t)n * 4 + h) * 128 + d] = __expf(gl); }
          qgp[i2] = pk2(qg2[0], qg2[1]); *(LAS unsigned*)(QG + t * 136 + d0 + 2 * i2) = qgp[i2]; }
      bf16_t* qgo = (bf16_t*)(F.ws + WS_QG) + trow * 512 + h * 128 + d0;
      *(u32x4*)qgo = (u32x4){qgp[0], qgp[1], qgp[2], qgp[3]}; *(u32x4*)(qgo + 8) = (u32x4){qgp[4], qgp[5], qgp[6], qgp[7]}; }
    __syncthreads();
    if (wid < 4) { const int ti = wid >> 1, tj = wid & 1; f32x16 c = {};
        mma32<8>(c, (const bf16_t*)QG + ti * 32 * 136, 136, (const bf16_t*)KG + tj * 32 * 136, 136, r32, hi);
#pragma unroll
        for (int r = 0; r < 16; ++r) { const int tt = 32 * ti + crow(r, hi), ss = 32 * tj + r32; AL[tt * 72 + ss] = (bf16_t)f2bf(ss <= tt ? c[r] : 0.f); } }
    { float* UT = (float*)(F.ws + WS_UT) + ((size_t)n * 4 + h) * 128 * 128;
#pragma unroll 1
      for (int q = 0; q < 2; ++q) { const int id = wid + 8 * q, dvb = id >> 2, dkb = id & 3; f32x16 c = {};
          mma32<4>(c, (const bf16_t*)VT + dvb * 32 * 72, 72, (const bf16_t*)KDT + dkb * 32 * 72, 72, r32, hi);
          float* up = UT + (size_t)(32 * dvb + 4 * hi) * 128 + 32 * dkb + r32;
#pragma unroll
          for (int r = 0; r < 16; ++r) up[((r & 3) + 8 * (r >> 2)) * 128] = c[r]; } }
    __syncthreads();
    { const int ti = wid >> 2, tj = wid & 3; f32x16 c = {};
      mma32<4>(c, (const bf16_t*)AL + ti * 32 * 72, 72, (const bf16_t*)VT + tj * 32 * 72, 72, r32, hi);
      float* ip = (float*)(F.ws + WS_INTRA) + ((size_t)n * 64 + 32 * ti + 4 * hi) * 512 + h * 128 + 32 * tj + r32;
#pragma unroll
      for (int r = 0; r < 16; ++r) ip[((r & 3) + 8 * (r >> 2)) * 512] = c[r]; }
}
__device__ __forceinline__ void fox_cumsum_item(Frame& F, int l) {
    if (F.wave >= 6) return;
    int lane = LANE_; asm volatile("" : "+v"(lane)); const int hh = F.wave; const float* zs = (const float*)(F.ws + WS_ZS); const float fb = inp(I_FOX_FBIAS)[l * 6 + hh];
    float s = 0.f;
    for (int i = 0; i < 128; ++i) s += logsigmoidf(zs[(size_t)(lane * 128 + i) * 64 + ZS_FF + hh] + fb);
    float incl = s;
#pragma unroll
    for (int o = 1; o < 64; o <<= 1) { const float v = __shfl_up(incl, o); if (lane >= o) incl += v; }
    float run = incl - s; float* nF = (float*)(F.ws + WS_FCUM) + (size_t)hh * S;
    for (int i = 0; i < 128; ++i) { run += logsigmoidf(zs[(size_t)(lane * 128 + i) * 64 + ZS_FF + hh] + fb); nF[lane * 128 + i] = -11.313708498984761f * run; }
}
__device__ __forceinline__ void fox_norm_item(Frame& F, int l, int item) {
    int tid = TID_; asm volatile("" : "+v"(tid));
    const int row = item * 128 + (tid >> 2), part = tid & 3; const bf16_t* zr = (const bf16_t*)(F.ws + WS_ZH) + (size_t)row * 128 + part * 32;
    float qmx = 0.f, kmx = 0.f;
#pragma unroll 2
    for (int hd = 0; hd < 6; ++hd) {
        float sq = 0.f, sk = 0.f;
#pragma unroll
        for (int c = 0; c < 4; ++c) { const u32x4 a = *(const u32x4*)(zr + (size_t)hd * S * 128 + c * 8), b = *(const u32x4*)(zr + (size_t)(6 + hd) * S * 128 + c * 8);
            sq += bflo(a.x) * bflo(a.x) + bfhi(a.x) * bfhi(a.x) + bflo(a.y) * bflo(a.y) + bfhi(a.y) * bfhi(a.y) + bflo(a.z) * bflo(a.z) + bfhi(a.z) * bfhi(a.z) + bflo(a.w) * bflo(a.w) + bfhi(a.w) * bfhi(a.w);
            sk += bflo(b.x) * bflo(b.x) + bfhi(b.x) * bfhi(b.x) + bflo(b.y) * bflo(b.y) + bfhi(b.y) * bfhi(b.y) + bflo(b.z) * bflo(b.z) + bfhi(b.z) * bfhi(b.z) + bflo(b.w) * bflo(b.w) + bfhi(b.w) * bfhi(b.w); }
        sq += __shfl_xor(sq, 1); sq += __shfl_xor(sq, 2); sk += __shfl_xor(sk, 1); sk += __shfl_xor(sk, 2);
        qmx = fmaxf(qmx, sq); kmx = fmaxf(kmx, sk); }
#pragma unroll
    for (int o = 4; o < 64; o <<= 1) { qmx = fmaxf(qmx, __shfl_xor(qmx, o)); kmx = fmaxf(kmx, __shfl_xor(kmx, o)); }
    if ((tid & 63) == 0) { atomicMax(F.ctl + CW_FOXN + 2 * l, __float_as_uint(sqrtf(qmx) * 1.001f)); atomicMax(F.ctl + CW_FOXN + 2 * l + 1, __float_as_uint(sqrtf(kmx) * 1.001f)); }
}

#define SEL_K 256
__device__ __forceinline__ void sel_scan(LAS unsigned* hist, int lane, unsigned k, unsigned& bin, unsigned& rank, unsigned& cnt_at) {
    unsigned s = 0;
#pragma unroll
    for (int q = 0; q < 8; ++q) { const u32x4 v = *(const LAS u32x4*)(hist + 32 * lane + 4 * q); s += (v.x + v.y) + (v.z + v.w); }
    unsigned incl = s;
#pragma unroll
    for (int o = 1; o < 64; o <<= 1) { const unsigned v = __shfl_up(incl, o); if (lane >= o) incl += v; }
    const unsigned total = __shfl(incl, 63);
    const unsigned above = total - incl;
    const bool mine = (above < k) && (above + s >= k);
    const unsigned long long bal = __ballot(mine);
    const int src = bal ? (int)__builtin_ctzll(bal) : 0;
    const unsigned run0 = __shfl(above, src);
    const unsigned cb = hist[32 * src + (lane & 31)];
    unsigned suf = cb;
#pragma unroll
    for (int o = 1; o < 32; o <<= 1) { const unsigned v = __shfl_down(suf, o, 32); if ((lane & 31) + o < 32) suf += v; }
    const unsigned abv = run0 + suf - cb;
    const bool hit = (abv < k) && (abv + cb >= k);
    const unsigned long long hb = __ballot(hit) & 0xFFFFFFFFull;
    const int bsel = hb ? (int)__builtin_ctzll(hb) : 0;
    bin = (unsigned)(32 * src + bsel); rank = k - __shfl(abv, bsel); cnt_at = __shfl(cb, bsel);
}
__device__ __forceinline__ void select_row(const float* srow, int t, unsigned long long* mout, LAS unsigned* hist, int lane) {
    asm volatile("" : "+v"(lane));
    const int n = t + 1;
    if (n <= SEL_K) {
#pragma unroll
        for (int q = 0; q < 2; ++q) { const int wI = lane + 64 * q, lo = 64 * wI;
            const unsigned long long bits = (n >= lo + 64) ? ~0ull : (n > lo ? ((1ull << (n - lo)) - 1ull) : 0ull); mout[wI] = bits; }
        return;
    }
    unsigned key[128];
#pragma unroll
    for (int ch = 0; ch < 4; ++ch) {
        if (ch * 2048 < n) {
#pragma unroll
            for (int j = 32 * ch; j < 32 * ch + 32; ++j) { const int idx = 64 * j + lane;
                const unsigned u = __float_as_uint(srow[idx]); const unsigned kx = u ^ ((unsigned)((int)u >> 31) | 0x80000000u);
                key[j] = idx < n ? kx : 0u; }
        } else {
#pragma unroll
            for (int j = 32 * ch; j < 32 * ch + 32; ++j) key[j] = 0u;
        }
    }
    unsigned prefix = 0, k = SEL_K, cnt_at = 0;
#pragma unroll
    for (int pass = 0; pass < 3; ++pass) {
        const int shift = pass == 0 ? 21 : pass == 1 ? 10 : 0; const unsigned dmask = pass == 2 ? 0x3FFu : 0x7FFu;
        const int pshift = pass == 0 ? 31 : pass == 1 ? 21 : 10;
#pragma unroll
        for (int q = 0; q < 8; ++q) *(LAS u32x4*)(hist + 32 * lane + 4 * q) = (u32x4){0u, 0u, 0u, 0u};
        asm volatile("s_waitcnt lgkmcnt(0)" ::: "memory");
        if (pass == 0) {
#pragma unroll
            for (int g8 = 0; g8 < 16; ++g8) {
                if (g8 * 512 < n) {
#pragma unroll
                    for (int j = 8 * g8; j < 8 * g8 + 8; ++j) __hip_atomic_fetch_add(hist + (key[j] >> 21), 1u, __ATOMIC_RELAXED, __HIP_MEMORY_SCOPE_WORKGROUP);
                }
            }
        } else {
#pragma unroll
            for (int ch = 0; ch < 4; ++ch) {
                if (ch * 2048 < n) {
#pragma unroll
                    for (int j = 32 * ch; j < 32 * ch + 32; ++j) { const unsigned kk = key[j];
                        const bool ok = (kk != 0u) && ((kk >> pshift) == prefix);
                        if (ok) __hip_atomic_fetch_add(hist + ((kk >> shift) & dmask), 1u, __ATOMIC_RELAXED, __HIP_MEMORY_SCOPE_WORKGROUP); }
                }
            }
        }
        asm volatile("s_waitcnt lgkmcnt(0)" ::: "memory");
        unsigned bin, rank;
        sel_scan(hist, lane, k, bin, rank, cnt_at);
        prefix = (pass == 0) ? bin : ((prefix << (pass == 1 ? 11 : 10)) | bin);
        k = rank;
    }
    const unsigned T = prefix;
    unsigned need = k;
    int m0l = 0, m0h = 0, m1l = 0, m1h = 0;
    if (need == cnt_at) {
#pragma unroll
        for (int ch = 0; ch < 4; ++ch) {
            if (ch * 2048 < n) {
#pragma unroll
                for (int j = 32 * ch; j < 32 * ch + 32; ++j) { const unsigned long long m = __ballot(key[j] >= T); const int lo_ = __builtin_amdgcn_readfirstlane((int)(unsigned)m), hi_ = __builtin_amdgcn_readfirstlane((int)(unsigned)(m >> 32));
                    if (j < 64) asm volatile("s_nop 4\n\tv_writelane_b32 %0, %2, %4\n\tv_writelane_b32 %1, %3, %4\n\ts_nop 1" : "+v"(m0l), "+v"(m0h) : "s"(lo_), "s"(hi_), "i"(j & 63));
                    else asm volatile("s_nop 4\n\tv_writelane_b32 %0, %2, %4\n\tv_writelane_b32 %1, %3, %4\n\ts_nop 1" : "+v"(m1l), "+v"(m1h) : "s"(lo_), "s"(hi_), "i"(j & 63)); }
            }
        }
    } else {
#pragma unroll 1
        for (int ch = 0; ch < 4; ++ch) {
            if (ch * 2048 < n) {
#pragma unroll
                for (int jj = 0; jj < 32; ++jj) { const unsigned kk = ch == 0 ? key[jj] : ch == 1 ? key[32 + jj] : ch == 2 ? key[64 + jj] : key[96 + jj]; const int j = 32 * ch + jj;
                    const unsigned long long beq = __ballot(kk == T);
                    const unsigned before = __builtin_amdgcn_mbcnt_hi((unsigned)(beq >> 32), __builtin_amdgcn_mbcnt_lo((unsigned)beq, 0u));
                    const unsigned long long m = __ballot((kk > T) || ((kk == T) && (before < need)));
                    const unsigned c = (unsigned)__builtin_popcountll(beq); need -= (c < need ? c : need);
                    if (j < 64) { if (lane == j) { m0l = (int)(unsigned)m; m0h = (int)(unsigned)(m >> 32); } } else { if (lane == j - 64) { m1l = (int)(unsigned)m; m1h = (int)(unsigned)(m >> 32); } } }
            }
        }
    }
    const unsigned long long m0 = ((unsigned long long)(unsigned)m0h << 32) | (unsigned)m0l, m1 = ((unsigned long long)(unsigned)m1h << 32) | (unsigned)m1l;
    mout[lane] = m0; mout[lane + 64] = m1;
}
__device__ __forceinline__ void phase_select(Frame& F, int sel_ctr_base) {
    int tid_ = TID_; asm volatile("" : "+v"(tid_));
    if (tid_ < 256) {
        const float* UT = (const float*)(F.ws + WS_UT); const float* DEC = (const float*)(F.ws + WS_DECAY); bf16_t* ST = (bf16_t*)(F.ws + WS_ST);
        for (int e = blockIdx.x * 256 + tid_; e < 4 * 128 * 128; e += F.G * 256) { const int h = e >> 14, dk = e & 127; const int off = e & 16383;
            float s = 0.f;
#pragma unroll 1
            for (int n0 = 0; n0 < 128; n0 += 32) { float u_[32], d_[32];
#pragma unroll
                for (int i = 0; i < 32; ++i) { const size_t base = ((size_t)(n0 + i) * 4 + h) * 16384 + off; u_[i] = UT[base]; d_[i] = DEC[((size_t)(n0 + i) * 4 + h) * 128 + dk]; }
#pragma unroll
                for (int i = 0; i < 32; ++i) { const size_t base = ((size_t)(n0 + i) * 4 + h) * 16384 + off; ST[base] = (bf16_t)f2bf(s); s = fmaf(d_[i], s, u_[i]); } } }
    }
    const float* SC = (const float*)(F.ws + WS_SC); unsigned long long* MK = (unsigned long long*)(F.ws + WS_MASK);
    LAS unsigned* hist = (LAS unsigned*)(F.lds + F.wave * 8192);
    const int ppb = (S / 2 + F.G - 1) / F.G, pbeg = blockIdx.x * ppb, pend = (pbeg + ppb < S / 2) ? pbeg + ppb : S / 2;
    LAS unsigned* ctr = (LAS unsigned*)&F.MISC[16];
#pragma unroll 1
    for (;;) {
        unsigned got = 0; if (LANE_ == 0) got = __hip_atomic_fetch_add(ctr, 1u, __ATOMIC_RELAXED, __HIP_MEMORY_SCOPE_WORKGROUP);
        const int p = pbeg + (int)(__builtin_amdgcn_readfirstlane((int)got) - sel_ctr_base);
        if (p >= pend) break;
#pragma unroll 1
        for (int sd = 0; sd < 2; ++sd) { const int t = sd ? S - 1 - p : p;
            for (int rr_ = 0; rr_ < REP_SEL; ++rr_) select_row(SC + (size_t)t * S, t, MK + (size_t)t * 128, hist, LANE_); }
    }
}

struct AttTab { unsigned short v[288]; };
constexpr AttTab make_att_tab() { AttTab t{}; int n = 0;
    for (int sz = 64; sz >= 1; --sz) for (int qb = 31; qb >= 0; --qb) { const int nt = 4 * (qb + 1);
        if (qb >= 16) { if (nt / 2 == sz) for (int hd = 0; hd < 6; ++hd) { t.v[n++] = (unsigned short)(qb | hd << 5 | 1 << 8); t.v[n++] = (unsigned short)(qb | hd << 5 | 2 << 8); } }
        else if (nt == sz) for (int hd = 0; hd < 6; ++hd) t.v[n++] = (unsigned short)(qb | hd << 5); }
    return t; }
__constant__ const AttTab ATTTAB = make_att_tab();
constexpr int N_DSA_ITEMS = 288, N_ATT_ITEMS = N_DSA_ITEMS + 192;
constexpr size_t WS_PART = WS_SC + 64 * MiB;
constexpr int PART_FLOATS = 8 * 16 * 256 + 512, CW_SPLIT = 40960;
__device__ __forceinline__ att::BlockRef att_ref(Frame& F, int l_, int item) {
    int kind, qb, hd, mode = 0;
    if (item < N_DSA_ITEMS) { const int c = __builtin_amdgcn_readfirstlane((int)ATTTAB.v[item]); kind = 1; qb = c & 31; hd = (c >> 5) & 7; mode = c >> 8; }
    else { const int j = item - N_DSA_ITEMS; kind = 0; qb = 31 - j / 6; hd = j % 6; }
    const att::bf16* ZH = (const att::bf16*)(F.ws + WS_ZH); att::bf16* MIX = (att::bf16*)(F.ws + WS_MIX);
    att::BlockRef b;
    const int hb = kind ? 18 : 0;
    b.Q = ZH + ((size_t)(hb + hd) * S + qb * 256) * 128; b.K = ZH + (size_t)(hb + 6 + hd) * S * 128; b.V = ZH + (size_t)(hb + 12 + hd) * S * 128;
    b.O = MIX + (size_t)(qb * 256) * DM + (kind ? 1280 : 0) + hd * 128;
    b.O8 = (unsigned char*)(F.ws + WS_MIX8) + (size_t)(qb * 256) * DM + (kind ? 1280 : 0) + hd * 128; b.ovf = F.ctl + CW_MIXOVF + l_;
    b.P0 = qb * 256; b.kind = kind;
    b.bias = (const float*)(F.ws + WS_FCUM) + (size_t)hd * S;
    b.mask = (const unsigned long long*)(F.ws + WS_MASK);
    const int nt = 4 * (qb + 1);
    b.j0 = (mode == 2) ? nt / 2 : 0; b.j1 = (mode == 1) ? nt / 2 : nt; b.part = mode != 0;
    { const int slot = ((qb & 15) * 6 + hd) * 2; float* pbase = (float*)(F.ws + WS_PART);
      b.pself = pbase + (size_t)(slot + (mode == 2 ? 1 : 0)) * PART_FLOATS; b.pother = pbase + (size_t)(slot + (mode == 2 ? 0 : 1)) * PART_FLOATS;
      b.pcnt = F.ctl + CW_SPLIT + l_ * 128 + (qb & 15) * 6 + hd; }
    if (kind == 0) {
        const unsigned* nm = (const unsigned*)(F.ctl + CW_FOXN + 2 * l_);
        const float qm = __uint_as_float(__hip_atomic_load(nm, __ATOMIC_RELAXED, __HIP_MEMORY_SCOPE_AGENT)), km = __uint_as_float(__hip_atomic_load(nm + 1, __ATOMIC_RELAXED, __HIP_MEMORY_SCOPE_AGENT));
        const float thr = (30.f + 2.f * 0.08838834764831845f * qm * km) * 11.313708498984761f;
        const float nf0 = b.bias[qb * 256];
        int cnt = 0;
#pragma unroll
        for (int q2 = 0; q2 < 2; ++q2) { const int j = (TID_ & 63) + 64 * q2; const bool skip = (64 * j + 63 < qb * 256) && (nf0 - b.bias[64 * j + 63] > thr);
            cnt += __builtin_popcountll(__ballot(skip)); }
        b.j0 = __builtin_amdgcn_readfirstlane(cnt);
    }
    b.mask = (const unsigned long long*)(F.ws + WS_MASK);
    return b;
}
__device__ __forceinline__ void gla_g3_item(Frame& F, int l, int item) {
    const int n = item >> 2, h = item & 3;
    int tid = TID_; asm volatile("" : "+v"(tid));
    const int lane = tid & 63, wid = F.wave, r32 = lane & 31, hi = lane >> 5;
    LAS float* OL = (LAS float*)F.lds;
    __syncthreads();
    { const int ti = wid >> 2, tj = wid & 3; f32x16 c = {};
      const bf16_t* A = (const bf16_t*)(F.ws + WS_QG) + ((size_t)n * 64 + ti * 32) * 512 + h * 128;
      const bf16_t* B = (const bf16_t*)(F.ws + WS_ST) + (((size_t)n * 4 + h) * 128 + tj * 32) * 128;
      mma32<8>(c, A, 512, B, 128, r32, hi);
      const float* ip = (const float*)(F.ws + WS_INTRA) + ((size_t)n * 64 + 32 * ti + 4 * hi) * 512 + h * 128 + 32 * tj + r32;
#pragma unroll
      for (int r = 0; r < 16; ++r) { const int rr = (r & 3) + 8 * (r >> 2); OL[(32 * ti + 4 * hi + rr) * 132 + 32 * tj + r32] = c[r] + ip[rr * 512]; } }
    __syncthreads();
    { const int t = tid >> 3, e0 = (tid & 7) * 16; const size_t trow = (size_t)n * 64 + t;
      float o[16]; float ss = 0.f;
#pragma unroll
      for (int i4 = 0; i4 < 4; ++i4) { const f32x4 v = *(const LAS f32x4*)(OL + t * 132 + e0 + 4 * i4); o[4 * i4] = v[0]; o[4 * i4 + 1] = v[1]; o[4 * i4 + 2] = v[2]; o[4 * i4 + 3] = v[3];
          ss += (v[0] * v[0] + v[1] * v[1]) + (v[2] * v[2] + v[3] * v[3]); }
      ss += __shfl_xor(ss, 1); ss += __shfl_xor(ss, 2); ss += __shfl_xor(ss, 4);
      const float rstd = rsqrtf(ss * (1.f / 128.f) + 1e-6f);
      const bf16_t* gr = (const bf16_t*)(F.ws + WS_Z) + trow * LDZ + ZC_GR + h * 128 + e0; const float* gn = inp(I_GLA_NORM_G) + (size_t)l * 128 + e0;
      const u32x4 ga = *(const u32x4*)gr, gb = *(const u32x4*)(gr + 8); const unsigned gw_[8] = {ga.x, ga.y, ga.z, ga.w, gb.x, gb.y, gb.z, gb.w};
      unsigned pk[8];
#pragma unroll
      for (int i2 = 0; i2 < 8; ++i2) { const float y0 = o[2 * i2] * rstd * gn[2 * i2] * siluf(bflo(gw_[i2])), y1 = o[2 * i2 + 1] * rstd * gn[2 * i2 + 1] * siluf(bfhi(gw_[i2])); pk[i2] = pk2(y0, y1); }
      bf16_t* mo = (bf16_t*)(F.ws + WS_MIX) + trow * DM + 768 + h * 128 + e0;
      *(u32x4*)mo = (u32x4){pk[0], pk[1], pk[2], pk[3]}; *(u32x4*)(mo + 8) = (u32x4){pk[4], pk[5], pk[6], pk[7]};
#if WO_FP8
      { u32x4 q8; float amx = 0.f;
#pragma unroll
        for (int i4 = 0; i4 < 4; ++i4) { const float a0 = bflo(pk[2 * i4]), a1 = bfhi(pk[2 * i4]), a2 = bflo(pk[2 * i4 + 1]), a3 = bfhi(pk[2 * i4 + 1]);
            amx = fmaxf(amx, fmaxf(fmaxf(fabsf(a0), fabsf(a1)), fmaxf(fabsf(a2), fabsf(a3))));
            int w = __builtin_amdgcn_cvt_pk_fp8_f32(a0 * MIX_S, a1 * MIX_S, 0, false); w = __builtin_amdgcn_cvt_pk_fp8_f32(a2 * MIX_S, a3 * MIX_S, w, true); q8[i4] = (unsigned)w; }
        *(u32x4*)((unsigned char*)(F.ws + WS_MIX8) + trow * DM + 768 + h * 128 + e0) = q8;
        if (__any(amx * MIX_S > 448.f)) { if ((tid & 63) == 0) __hip_atomic_fetch_or(F.ctl + CW_MIXOVF + l, 1u, __ATOMIC_RELAXED, __HIP_MEMORY_SCOPE_AGENT); } }
#endif
    }
}
template <int KIND> __device__ __forceinline__ void attn_run(Frame& F, int l_, int q, int& cur_i, int end) {
    if (cur_i >= end) return;
    att::Seam Sm; att::BlockRef cur = att_ref(F, l_, cur_i);
    att::attn_prime(cur, (char*)F.lds, Sm);
#pragma unroll 1
    for (;;) {
        const int nxt_i = deq(F, q); const bool has = nxt_i < end;
        const att::BlockRef nxt = has ? att_ref(F, l_, nxt_i) : cur;
        att::attn_block<KIND>(cur, nxt, (char*)F.lds, Sm);
#if REP_FOX > 1
        if (KIND == 0) for (int rr_ = 1; rr_ < REP_FOX; ++rr_) { att::attn_prime(cur, (char*)F.lds, Sm); att::attn_block<KIND>(cur, nxt, (char*)F.lds, Sm); }
#endif
        cur_i = nxt_i;
        if (!has) break;
        cur = nxt;
    }
}
__device__ __forceinline__ void phase_attn(Frame& F, int l, int q) {
    int cur_i = deq(F, q);
    attn_run<1>(F, l, q, cur_i, N_DSA_ITEMS);
    attn_run<0>(F, l, q, cur_i, N_ATT_ITEMS);
#pragma unroll 1
    while (cur_i < N_ATT_ITEMS + 512) { for (int rr_ = 0; rr_ < REP_G3; ++rr_) gla_g3_item(F, l, cur_i - N_ATT_ITEMS); cur_i = deq(F, q); }
#if CONV_IN_QUEUES
#pragma unroll 1
    while (cur_i < N_ATT_ITEMS + 512 + CONV_ITEMS) { conv_item(F, l, 1, cur_i - (N_ATT_ITEMS + 512)); cur_i = deq(F, q); }
#endif
}

__device__ __forceinline__ void ce_d(unsigned& a, unsigned& b) { const unsigned mx = a > b ? a : b, mn = a > b ? b : a; a = mx; b = mn; }
template <int N, int OFF> __device__ __forceinline__ void sort16_desc(unsigned (&a)[N]) {
#pragma unroll
    for (int k = 2; k <= 16; k <<= 1)
#pragma unroll
        for (int j = k >> 1; j > 0; j >>= 1)
#pragma unroll
            for (int i = 0; i < 16; ++i) { const int l = i ^ j; if (l > i) { if ((i & k) == 0) ce_d(a[OFF + i], a[OFF + l]); else ce_d(a[OFF + l], a[OFF + i]); } }
}
template <int N, int OA, int OB> __device__ __forceinline__ void merge16_desc(unsigned (&a)[N]) {
#pragma unroll
    for (int i = 0; i < 16; ++i) { const unsigned x = a[OA + i], y = a[OB + 15 - i]; a[OA + i] = x > y ? x : y; }
#pragma unroll
    for (int j = 8; j > 0; j >>= 1)
#pragma unroll
        for (int i = 0; i < 16; ++i) { const int l = i ^ j; if (l > i) ce_d(a[OA + i], a[OA + l]); }
}
__device__ __forceinline__ void ce2_d(float& va, unsigned& pa, float& vb, unsigned& pb) {
    const bool sw = vb > va; const float nva = sw ? vb : va, nvb = sw ? va : vb; const unsigned npa = sw ? pb : pa, npb = sw ? pa : pb; va = nva; vb = nvb; pa = npa; pb = npb; }
template <int OFF> __device__ __forceinline__ void sort16v_desc(float (&v)[32], unsigned (&p)[32]) {
#pragma unroll
    for (int k = 2; k <= 16; k <<= 1)
#pragma unroll
        for (int j = k >> 1; j > 0; j >>= 1)
#pragma unroll
            for (int i = 0; i < 16; ++i) { const int l = i ^ j; if (l > i) { if ((i & k) == 0) ce2_d(v[OFF + i], p[OFF + i], v[OFF + l], p[OFF + l]); else ce2_d(v[OFF + l], p[OFF + l], v[OFF + i], p[OFF + i]); } }
}
__device__ __forceinline__ void merge16v_desc(float (&v)[32], unsigned (&p)[32]) {
#pragma unroll
    for (int i = 0; i < 16; ++i) { const bool sw = v[31 - i] > v[i]; v[i] = sw ? v[31 - i] : v[i]; p[i] = sw ? p[31 - i] : p[i]; }
#pragma unroll
    for (int j = 8; j > 0; j >>= 1)
#pragma unroll
        for (int i = 0; i < 16; ++i) { const int l = i ^ j; if (l > i) ce2_d(v[i], p[i], v[l], p[l]); }
}
__device__ __forceinline__ void peer_half_top16(const bf16_t* kb, const bf16_t* qp, int r32, int hi, unsigned (&top)[16]) {
    unsigned key[64];
    bf16x8 qf[8];
#pragma unroll
    for (int ks = 0; ks < 8; ++ks) qf[ks] = *(const bf16x8*)(qp + (size_t)r32 * 2048 + ks * 16 + hi * 8);
#pragma unroll
    for (int nb = 0; nb < 4; ++nb) { f32x16 c = {};
        __builtin_amdgcn_sched_barrier(0);
#pragma unroll
        for (int ks = 0; ks < 8; ++ks) { const bf16x8 a = *(const bf16x8*)(kb + (size_t)(nb * 32 + r32) * 128 + ks * 16 + hi * 8); c = __builtin_amdgcn_mfma_f32_32x32x16_bf16(a, qf[ks], c, 0, 0, 0); }
#pragma unroll
        for (int r = 0; r < 16; ++r) { const unsigned u = __float_as_uint(c[r]); const unsigned sk = u ^ ((u >> 31) ? 0xFFFFFFFFu : 0x80000000u);
            key[nb * 16 + r] = (sk & ~127u) | (unsigned)(127 - (32 * nb + crow(r, hi))); } }
    __builtin_amdgcn_sched_barrier(0);
    sort16_desc<64, 0>(key); sort16_desc<64, 16>(key); sort16_desc<64, 32>(key); sort16_desc<64, 48>(key);
    merge16_desc<64, 0, 16>(key); merge16_desc<64, 32, 48>(key); merge16_desc<64, 0, 32>(key);
#pragma unroll
    for (int i = 0; i < 16; ++i) key[16 + i] = (unsigned)__shfl_xor((int)key[i], 32);
    merge16_desc<64, 0, 16>(key);
#pragma unroll
    for (int i = 0; i < 16; ++i) top[i] = key[i];
}
__device__ __forceinline__ float unkey(unsigned k) { const unsigned u = k & ~127u; return __uint_as_float((u & 0x80000000u) ? (u ^ 0x80000000u) : ~u); }
__device__ __forceinline__ void peer_topk_item(Frame& F, int l, int item) {
    int lane = LANE_; asm volatile("" : "+v"(lane));
    const int tb = item >> 3, h = item & 7, r32 = lane & 31, hi = lane >> 5;
    const bf16_t* QP = (const bf16_t*)(F.ws + WS_QP) + (size_t)(tb * 32) * DM + h * 256;
    const bf16_t* K1 = (const bf16_t*)(F.ws + WS_KB) + ((size_t)l * 8 + h) * 128 * 128; const bf16_t* K2 = K1 + 2 * 8 * 128 * 128;
    unsigned t1[16], t2[16];
    peer_half_top16(K1, QP, r32, hi, t1);
    __builtin_amdgcn_sched_barrier(0);
    peer_half_top16(K2, QP + 128, r32, hi, t2);
    __builtin_amdgcn_sched_barrier(0);
    float v1[16], v2[16]; unsigned i1[16], i2[16];
#pragma unroll
    for (int i = 0; i < 16; ++i) { v1[i] = unkey(t1[i]); v2[i] = unkey(t2[i]); i1[i] = 127u - (t1[i] & 127u); i2[i] = 127u - (t2[i] & 127u); }
    float cv[32]; unsigned cp[32];
    { const float va_ = v1[0] + v2[0], vb_ = v1[0] + v2[1]; const unsigned pa_ = (i1[0] << 7) | i2[0], pb_ = (i1[0] << 7) | i2[1]; cv[0] = hi ? vb_ : va_; cp[0] = hi ? pb_ : pa_; }
    { const float va_ = v1[0] + v2[2], vb_ = v1[0] + v2[3]; const unsigned pa_ = (i1[0] << 7) | i2[2], pb_ = (i1[0] << 7) | i2[3]; cv[1] = hi ? vb_ : va_; cp[1] = hi ? pb_ : pa_; }
    { const float va_ = v1[0] + v2[4], vb_ = v1[0] + v2[5]; const unsigned pa_ = (i1[0] << 7) | i2[4], pb_ = (i1[0] << 7) | i2[5]; cv[2] = hi ? vb_ : va_; cp[2] = hi ? pb_ : pa_; }
    { const float va_ = v1[0] + v2[6], vb_ = v1[0] + v2[7]; const unsigned pa_ = (i1[0] << 7) | i2[6], pb_ = (i1[0] << 7) | i2[7]; cv[3] = hi ? vb_ : va_; cp[3] = hi ? pb_ : pa_; }
    { const float va_ = v1[0] + v2[8], vb_ = v1[0] + v2[9]; const unsigned pa_ = (i1[0] << 7) | i2[8], pb_ = (i1[0] << 7) | i2[9]; cv[4] = hi ? vb_ : va_; cp[4] = hi ? pb_ : pa_; }
    { const float va_ = v1[0] + v2[10], vb_ = v1[0] + v2[11]; const unsigned pa_ = (i1[0] << 7) | i2[10], pb_ = (i1[0] << 7) | i2[11]; cv[5] = hi ? vb_ : va_; cp[5] = hi ? pb_ : pa_; }
    { const float va_ = v1[0] + v2[12], vb_ = v1[0] + v2[13]; const unsigned pa_ = (i1[0] << 7) | i2[12], pb_ = (i1[0] << 7) | i2[13]; cv[6] = hi ? vb_ : va_; cp[6] = hi ? pb_ : pa_; }
    { const float va_ = v1[0] + v2[14], vb_ = v1[0] + v2[15]; const unsigned pa_ = (i1[0] << 7) | i2[14], pb_ = (i1[0] << 7) | i2[15]; cv[7] = hi ? vb_ : va_; cp[7] = hi ? pb_ : pa_; }
    { const float va_ = v1[1] + v2[0], vb_ = v1[1] + v2[1]; const unsigned pa_ = (i1[1] << 7) | i2[0], pb_ = (i1[1] << 7) | i2[1]; cv[8] = hi ? vb_ : va_; cp[8] = hi ? pb_ : pa_; }
    { const float va_ = v1[1] + v2[2], vb_ = v1[1] + v2[3]; const unsigned pa_ = (i1[1] << 7) | i2[2], pb_ = (i1[1] << 7) | i2[3]; cv[9] = hi ? vb_ : va_; cp[9] = hi ? pb_ : pa_; }
    { const float va_ = v1[1] + v2[4], vb_ = v1[1] + v2[5]; const unsigned pa_ = (i1[1] << 7) | i2[4], pb_ = (i1[1] << 7) | i2[5]; cv[10] = hi ? vb_ : va_; cp[10] = hi ? pb_ : pa_; }
    { const float va_ = v1[1] + v2[6], vb_ = v1[1] + v2[7]; const unsigned pa_ = (i1[1] << 7) | i2[6], pb_ = (i1[1] << 7) | i2[7]; cv[11] = hi ? vb_ : va_; cp[11] = hi ? pb_ : pa_; }
    { const float va_ = v1[2] + v2[0], vb_ = v1[2] + v2[1]; const unsigned pa_ = (i1[2] << 7) | i2[0], pb_ = (i1[2] << 7) | i2[1]; cv[12] = hi ? vb_ : va_; cp[12] = hi ? pb_ : pa_; }
    { const float va_ = v1[2] + v2[2], vb_ = v1[2] + v2[3]; const unsigned pa_ = (i1[2] << 7) | i2[2], pb_ = (i1[2] << 7) | i2[3]; cv[13] = hi ? vb_ : va_; cp[13] = hi ? pb_ : pa_; }
    { const float va_ = v1[2] + v2[4], vb_ = v1[3] + v2[0]; const unsigned pa_ = (i1[2] << 7) | i2[4], pb_ = (i1[3] << 7) | i2[0]; cv[14] = hi ? vb_ : va_; cp[14] = hi ? pb_ : pa_; }
    { const float va_ = v1[3] + v2[1], vb_ = v1[3] + v2[2]; const unsigned pa_ = (i1[3] << 7) | i2[1], pb_ = (i1[3] << 7) | i2[2]; cv[15] = hi ? vb_ : va_; cp[15] = hi ? pb_ : pa_; }
    { const float va_ = v1[3] + v2[3], vb_ = v1[4] + v2[0]; const unsigned pa_ = (i1[3] << 7) | i2[3], pb_ = (i1[4] << 7) | i2[0]; cv[16] = hi ? vb_ : va_; cp[16] = hi ? pb_ : pa_; }
    { const float va_ = v1[4] + v2[1], vb_ = v1[4] + v2[2]; const unsigned pa_ = (i1[4] << 7) | i2[1], pb_ = (i1[4] << 7) | i2[2]; cv[17] = hi ? vb_ : va_; cp[17] = hi ? pb_ : pa_; }
    { const float va_ = v1[5] + v2[0], vb_ = v1[5] + v2[1]; const unsigned pa_ = (i1[5] << 7) | i2[0], pb_ = (i1[5] << 7) | i2[1]; cv[18] = hi ? vb_ : va_; cp[18] = hi ? pb_ : pa_; }
    { const float va_ = v1[6] + v2[0], vb_ = v1[6] + v2[1]; const unsigned pa_ = (i1[6] << 7) | i2[0], pb_ = (i1[6] << 7) | i2[1]; cv[19] = hi ? vb_ : va_; cp[19] = hi ? pb_ : pa_; }
    { const float va_ = v1[7] + v2[0], vb_ = v1[7] + v2[1]; const unsigned pa_ = (i1[7] << 7) | i2[0], pb_ = (i1[7] << 7) | i2[1]; cv[20] = hi ? vb_ : va_; cp[20] = hi ? pb_ : pa_; }
    { const float va_ = v1[8] + v2[0], vb_ = v1[9] + v2[0]; const unsigned pa_ = (i1[8] << 7) | i2[0], pb_ = (i1[9] << 7) | i2[0]; cv[21] = hi ? vb_ : va_; cp[21] = hi ? pb_ : pa_; }
    { const float va_ = v1[10] + v2[0], vb_ = v1[11] + v2[0]; const unsigned pa_ = (i1[10] << 7) | i2[0], pb_ = (i1[11] << 7) | i2[0]; cv[22] = hi ? vb_ : va_; cp[22] = hi ? pb_ : pa_; }
    { const float va_ = v1[12] + v2[0], vb_ = v1[13] + v2[0]; const unsigned pa_ = (i1[12] << 7) | i2[0], pb_ = (i1[13] << 7) | i2[0]; cv[23] = hi ? vb_ : va_; cp[23] = hi ? pb_ : pa_; }
    { const float va_ = v1[14] + v2[0], vb_ = v1[15] + v2[0]; const unsigned pa_ = (i1[14] << 7) | i2[0], pb_ = (i1[15] << 7) | i2[0]; cv[24] = hi ? vb_ : va_; cp[24] = hi ? pb_ : pa_; }
#pragma unroll
    for (int s = 25; s < 32; ++s) { cv[s] = -__builtin_inff(); cp[s] = 0u; }
    __builtin_amdgcn_sched_barrier(0);
    sort16v_desc<0>(cv, cp); sort16v_desc<16>(cv, cp); merge16v_desc(cv, cp);
#pragma unroll
    for (int i = 0; i < 16; ++i) { cv[16 + i] = __shfl_xor(cv[i], 32); cp[16 + i] = (unsigned)__shfl_xor((int)cp[i], 32); }
#pragma unroll
    for (int i = 0; i < 16; ++i) { const float a = cv[i], b = cv[16 + i]; const unsigned pa = cp[i], pb = cp[16 + i]; cv[i] = hi ? b : a; cv[16 + i] = hi ? a : b; cp[i] = hi ? pb : pa; cp[16 + i] = hi ? pa : pb; }
    merge16v_desc(cv, cp);
    float e[16]; float sum = 0.f;
#pragma unroll
    for (int i = 0; i < 16; ++i) { e[i] = __expf(cv[i] - cv[0]); sum += e[i]; }
    const float inv = 1.f / sum;
    if (hi == 0) { const size_t o = ((size_t)(tb * 32 + r32) * 8 + h) * 16; int* EI = (int*)(F.ws + WS_EIDX) + o; float* GT = (float*)(F.ws + WS_GATE) + o;
#pragma unroll
        for (int q = 0; q < 4; ++q) { *(u32x4*)(EI + 4 * q) = (u32x4){cp[4 * q], cp[4 * q + 1], cp[4 * q + 2], cp[4 * q + 3]};
                                      *(f32x4*)(GT + 4 * q) = (f32x4){e[4 * q] * inv, e[4 * q + 1] * inv, e[4 * q + 2] * inv, e[4 * q + 3] * inv}; } }
}
typedef __bf16 bf2_t __attribute__((ext_vector_type(2)));
__device__ __forceinline__ float dot32_fp4_bf(const u32x4 u, const unsigned (&hp)[16], float a) {
#define D8_(W, Q) { a = __builtin_amdgcn_fdot2_f32_bf16(__builtin_amdgcn_cvt_scalef32_pk_bf16_fp4((W), 1.0f, 0), __builtin_bit_cast(bf2_t, hp[4 * (Q) + 0]), a, false); \
        a = __builtin_amdgcn_fdot2_f32_bf16(__builtin_amdgcn_cvt_scalef32_pk_bf16_fp4((W), 1.0f, 1), __builtin_bit_cast(bf2_t, hp[4 * (Q) + 1]), a, false); \
        a = __builtin_amdgcn_fdot2_f32_bf16(__builtin_amdgcn_cvt_scalef32_pk_bf16_fp4((W), 1.0f, 2), __builtin_bit_cast(bf2_t, hp[4 * (Q) + 2]), a, false); \
        a = __builtin_amdgcn_fdot2_f32_bf16(__builtin_amdgcn_cvt_scalef32_pk_bf16_fp4((W), 1.0f, 3), __builtin_bit_cast(bf2_t, hp[4 * (Q) + 3]), a, false); }
    D8_(u.x, 0) D8_(u.y, 1) D8_(u.z, 2) D8_(u.w, 3)
#undef D8_
    return a;
}
__device__ __forceinline__ void axpy32_fp4(const u32x4 v, float w, f32x2 (&ac)[16]) {
    const f32x2 w2 = {w, w};
#define A8_(W, Q) { ac[4 * (Q) + 0] = __builtin_elementwise_fma(w2, __builtin_amdgcn_cvt_scalef32_pk_f32_fp4((W), 1.0f, 0), ac[4 * (Q) + 0]); \
        ac[4 * (Q) + 1] = __builtin_elementwise_fma(w2, __builtin_amdgcn_cvt_scalef32_pk_f32_fp4((W), 1.0f, 1), ac[4 * (Q) + 1]); \
        ac[4 * (Q) + 2] = __builtin_elementwise_fma(w2, __builtin_amdgcn_cvt_scalef32_pk_f32_fp4((W), 1.0f, 2), ac[4 * (Q) + 2]); \
        ac[4 * (Q) + 3] = __builtin_elementwise_fma(w2, __builtin_amdgcn_cvt_scalef32_pk_f32_fp4((W), 1.0f, 3), ac[4 * (Q) + 3]); }
    A8_(v.x, 0) A8_(v.y, 1) A8_(v.z, 2) A8_(v.w, 3)
#undef A8_
}
__device__ __forceinline__ void peer_finish_token(Frame& F, int l, int t, int lane, f32x2 (&acc)[16]) {
    float* xr = (float*)(F.ws + WS_X) + (size_t)t * DM + lane * 4; const float* mod = (const float*)(F.ws + WS_MOD) + (size_t)l * NMOD;
    float ss = 0.f;
#pragma unroll
    for (int j = 0; j < 8; ++j) { const f32x4 xa = *(const f32x4*)(xr + 256 * j), ga = *(const f32x4*)(mod + 5 * DM + 256 * j + lane * 4);
        const float y0 = xa[0] + ga[0] * acc[2 * j][0], y1 = xa[1] + ga[1] * acc[2 * j][1], y2 = xa[2] + ga[2] * acc[2 * j + 1][0], y3 = xa[3] + ga[3] * acc[2 * j + 1][1];
        acc[2 * j] = (f32x2){y0, y1}; acc[2 * j + 1] = (f32x2){y2, y3}; ss += (y0 * y0 + y1 * y1) + (y2 * y2 + y3 * y3); }
    const float rstd = rsqrtf(wave_sum(ss) * (1.f / DM) + 1e-6f);
    if (l + 1 < DEPTH) {
        const float* g = inp(I_NORM1_G) + (size_t)(l + 1) * DM + lane * 4; const float* mod2 = (const float*)(F.ws + WS_MOD) + (size_t)(l + 1) * NMOD + lane * 4;
#if WIN_FP8
        f32x4 y[8];
#pragma unroll
        for (int j = 0; j < 8; ++j) { const int o = 256 * j;
            const f32x4 xv = {acc[2 * j][0], acc[2 * j][1], acc[2 * j + 1][0], acc[2 * j + 1][1]}; *(f32x4*)(xr + o) = xv;
            const f32x4 g0 = *(const f32x4*)(g + o), s0 = *(const f32x4*)(mod2 + DM + o), h0 = *(const f32x4*)(mod2 + o);
            y[j] = xv * rstd * g0 * (1.f + s0) + h0;
            if (WIN_BF16_TILES) *(u32x2*)((bf16_t*)(F.ws + WS_H) + (size_t)t * DM + lane * 4 + o) = (u32x2){pk2(y[j][0], y[j][1]), pk2(y[j][2], y[j][3])}; }
        store_row_f8(y, (unsigned char*)(F.ws + WS_H8) + (size_t)t * DM, (float*)(F.ws + WS_SA) + t, lane);
#else
        bf16_t* ho = (bf16_t*)(F.ws + WS_H) + (size_t)t * DM + lane * 4;
#pragma unroll
        for (int j = 0; j < 8; ++j) { const int o = 256 * j;
            *(f32x4*)(xr + o) = (f32x4){acc[2 * j][0], acc[2 * j][1], acc[2 * j + 1][0], acc[2 * j + 1][1]};
            const f32x4 g0 = *(const f32x4*)(g + o), s0 = *(const f32x4*)(mod2 + DM + o), h0 = *(const f32x4*)(mod2 + o);
            const float y0 = acc[2 * j][0] * rstd * g0[0] * (1.f + s0[0]) + h0[0], y1 = acc[2 * j][1] * rstd * g0[1] * (1.f + s0[1]) + h0[1];
            const float y2 = acc[2 * j + 1][0] * rstd * g0[2] * (1.f + s0[2]) + h0[2], y3 = acc[2 * j + 1][1] * rstd * g0[3] * (1.f + s0[3]) + h0[3];
            *(u32x2*)(ho + o) = (u32x2){pk2(y0, y1), pk2(y2, y3)}; }
#endif
    } else {
        float* orow = outp() + (size_t)t * DM + lane * 4; const float* fg = inp(I_FINAL_G) + lane * 4;
#pragma unroll
        for (int j = 0; j < 8; ++j) { const int o = 256 * j; const f32x4 g0 = *(const f32x4*)(fg + o);
            *(f32x4*)(orow + o) = (f32x4){acc[2 * j][0] * rstd * g0[0], acc[2 * j][1] * rstd * g0[1], acc[2 * j + 1][0] * rstd * g0[2], acc[2 * j + 1][1] * rstd * g0[3]}; }
    }
}
template <int NTK, bool PROBE = false> __device__ __forceinline__ void peer_gather_group(Frame& F, int l, int t0, int tstride) {
    int lane = LANE_; asm volatile("" : "+v"(lane));
    const unsigned char* UB = (const unsigned char*)(F.ws + WS_UB) + (size_t)l * 16384 * 1024; const unsigned char* VB = (const unsigned char*)(F.ws + WS_VB) + (size_t)l * 16384 * 1024;
    const float* SU = (const float*)(F.ws + WS_SU) + (size_t)l * 16384; const float* SV = (const float*)(F.ws + WS_SV) + (size_t)l * 16384;
    LAS int* sl = (LAS int*)(F.lds + F.wave * 4096);
    int e_lo[NTK], e_hi[NTK];
#pragma unroll
    for (int tk = 0; tk < NTK; ++tk) {
        const int t = t0 + tk * tstride;
        const int* EI = (const int*)(F.ws + WS_EIDX) + (size_t)t * 128; const float* GT = (const float*)(F.ws + WS_GATE) + (size_t)t * 128;
        const int a_lo = EI[lane], a_hi = EI[lane + 64]; const float g_lo = GT[lane], g_hi = GT[lane + 64];
        const unsigned k_lo = (unsigned)a_lo * 128u + (unsigned)lane, k_hi = (unsigned)a_hi * 128u + 64u + (unsigned)lane; int r_lo = 0, r_hi = 0;
#pragma unroll 8
        for (int j = 0; j < 64; ++j) { const unsigned a = (unsigned)__builtin_amdgcn_readlane((int)k_lo, j), b = (unsigned)__builtin_amdgcn_readlane((int)k_hi, j);
            r_lo += (a < k_lo ? 1 : 0) + (b < k_lo ? 1 : 0); r_hi += (a < k_hi ? 1 : 0) + (b < k_hi ? 1 : 0); }
        LAS int* se = sl + tk * 256; LAS float* sg = (LAS float*)(se + 128);
        se[r_lo] = a_lo; se[r_hi] = a_hi; sg[r_lo] = g_lo; sg[r_hi] = g_hi;
    }
    asm volatile("s_waitcnt lgkmcnt(0)" ::: "memory");
#pragma unroll
    for (int tk = 0; tk < NTK; ++tk) { e_lo[tk] = sl[tk * 256 + lane]; e_hi[tk] = sl[tk * 256 + 64 + lane]; }
    unsigned hr[NTK][16];
#pragma unroll
    for (int tk = 0; tk < NTK; ++tk) { const bf16_t* hp = (const bf16_t*)(F.ws + WS_H) + (size_t)(t0 + tk * tstride) * DM + lane * 4;
#pragma unroll
        for (int j = 0; j < 8; ++j) { const u32x2 a = *(const u32x2*)(hp + 256 * j); hr[tk][2 * j] = a.x; hr[tk][2 * j + 1] = a.y; } }
    float w_lo[NTK], w_hi[NTK];
#pragma unroll
    for (int b = 0; b < 2; ++b) {
        float tot_sel[NTK];
#pragma unroll
        for (int tk = 0; tk < NTK; ++tk) tot_sel[tk] = 0.f;
#pragma unroll 1
        for (int kb = 0; kb < 8; ++kb) {
            u32x4 ua[NTK][8];
#pragma unroll
            for (int tk = 0; tk < NTK; ++tk) { const int eb = b ? e_hi[tk] : e_lo[tk];
#pragma unroll
                for (int j = 0; j < 8; ++j) { const int e = __builtin_amdgcn_readlane(eb, kb * 8 + j) & (PROBE ? 255 : -1); ua[tk][j] = *(const u32x4*)(UB + (size_t)e * 1024 + lane * 16); } }
            __builtin_amdgcn_sched_barrier(0);
#pragma unroll
            for (int tk = 0; tk < NTK; ++tk) {
                float p[8];
#pragma unroll
                for (int j = 0; j < 8; ++j) { p[j] = dot32_fp4_bf(ua[tk][j], hr[tk], 0.f); __builtin_amdgcn_sched_barrier(0); }
                float q[4], r[2], z;
#pragma unroll
                for (int j = 0; j < 4; ++j) { const float s_ = (lane & 32) ? p[j] : p[j + 4], k_ = (lane & 32) ? p[j + 4] : p[j]; q[j] = k_ + __shfl_xor(s_, 32); }
#pragma unroll
                for (int j = 0; j < 2; ++j) { const float s_ = (lane & 16) ? q[j] : q[j + 2], k_ = (lane & 16) ? q[j + 2] : q[j]; r[j] = k_ + __shfl_xor(s_, 16); }
                { const float s_ = (lane & 8) ? r[0] : r[1], k_ = (lane & 8) ? r[1] : r[0]; z = k_ + __shfl_xor(s_, 8); }
                z += __shfl_xor(z, 4); z += __shfl_xor(z, 2); z += __shfl_xor(z, 1);
                const float mine = __shfl(z, (lane & 7) << 3);
                if ((lane >> 3) == kb) tot_sel[tk] = mine;
                __builtin_amdgcn_sched_barrier(0);
            }
        }
#pragma unroll
        for (int tk = 0; tk < NTK; ++tk) { const int e = b ? e_hi[tk] : e_lo[tk]; const float g = ((const LAS float*)(sl + tk * 256 + 128))[lane + 64 * b];
            const float a = gelu_tanh(tot_sel[tk] * SU[e]); float w = g * a * SV[e];
            if (PROBE) { float z_ = 0.f; asm volatile("" : "+v"(z_)); w *= z_; }
            if (b) w_hi[tk] = w; else w_lo[tk] = w; }
    }
    __builtin_amdgcn_sched_barrier(0);
    f32x2 acc[NTK][16];
#pragma unroll
    for (int tk = 0; tk < NTK; ++tk)
#pragma unroll
        for (int i = 0; i < 16; ++i) acc[tk][i] = (f32x2){0.f, 0.f};
    __builtin_amdgcn_sched_barrier(0);
#pragma unroll
    for (int b = 0; b < 2; ++b) {
#pragma unroll 1
        for (int kb = 0; kb < 8; ++kb) {
            u32x4 va[NTK][8];
#pragma unroll
            for (int tk = 0; tk < NTK; ++tk) { const int eb = b ? e_hi[tk] : e_lo[tk];
#pragma unroll
                for (int j = 0; j < 8; ++j) { const int e = __builtin_amdgcn_readlane(eb, kb * 8 + j) & (PROBE ? 255 : -1); va[tk][j] = *(const u32x4*)(VB + (size_t)e * 1024 + lane * 16); } }
            __builtin_amdgcn_sched_barrier(0);
#pragma unroll
            for (int tk = 0; tk < NTK; ++tk) { const float wb = b ? w_hi[tk] : w_lo[tk];
#pragma unroll
                for (int j = 0; j < 8; ++j) { const float wj = __builtin_bit_cast(float, __builtin_amdgcn_readlane(__builtin_bit_cast(int, wb), kb * 8 + j)); axpy32_fp4(va[tk][j], wj, acc[tk]); __builtin_amdgcn_sched_barrier(0); } }
        }
    }
    if (PROBE) {
        float sum = 0.f;
#pragma unroll
        for (int tk = 0; tk < NTK; ++tk)
#pragma unroll
            for (int i = 0; i < 16; ++i) sum += acc[tk][i][0] + acc[tk][i][1];
        if (sum == 123456.f) ((float*)(F.ws + WS_MODP))[lane] = sum;
        return; }
#pragma unroll
    for (int tk = 0; tk < NTK; ++tk) peer_finish_token(F, l, t0 + tk * tstride, lane, acc[tk]);
}

#if DIAG
#ifndef DIAG_AMP
#define DIAG_AMP 1.0f
#endif
constexpr int CW_DG = 32768;
__device__ __constant__ const int DG_ROWS[16] = {0, 5, 63, 64, 255, 256, 257, 1000, 2047, 2048, 4095, 4096, 5000, 8000, 8190, 8191};
__device__ __forceinline__ float fp8f(unsigned char b) { return __builtin_amdgcn_cvt_pk_f32_fp8((int)b, false)[0]; }
__device__ __forceinline__ void dg_add(Frame& F, int k, float d2, float r2) {
    d2 = wave_sum(d2); r2 = wave_sum(r2);
    if (LANE_ == 0) { atomicAdd((float*)(F.ctl + CW_DG) + 2 * k, d2); atomicAdd((float*)(F.ctl + CW_DG) + 2 * k + 1, r2); }
}
__device__ __forceinline__ void dg_attn(Frame& F, int kind, int ri, int hd) {
    LAS float* L = (LAS float*)F.lds;
    const int lane = LANE_, t = DG_ROWS[ri];
    const bf16_t* Z = (const bf16_t*)(F.ws + WS_Z); const float* nF = (const float*)(F.ws + WS_FCUM) + (size_t)hd * S;
    const unsigned long long* MK = (const unsigned long long*)(F.ws + WS_MASK) + (size_t)t * 128;
    const bf16_t* ZH = (const bf16_t*)(F.ws + WS_ZH); const int hb = kind ? 18 : 0;
    const bf16_t* Qp = ZH + (size_t)(hb + hd) * S * 128; const bf16_t* Kp = ZH + (size_t)(hb + 6 + hd) * S * 128; const bf16_t* Vp = ZH + (size_t)(hb + 12 + hd) * S * 128;
    float mx = -3.0e38f; int cnt = 0, bad = 0;
    for (int j = lane; j < S; j += 64) {
        float lg = -3.0e38f; bool on = j <= t;
        if (kind) { const bool bit = (MK[j >> 6] >> (j & 63)) & 1ull; if (bit) { ++cnt; if (j > t) ++bad; } on = on && bit; }
        if (on) { float a = 0.f; for (int d = 0; d < 128; ++d) a += bf2f(Qp[(size_t)t * 128 + d]) * bf2f(Kp[(size_t)j * 128 + d]);
            lg = a * 0.08838834764831845f; if (!kind) lg += (nF[j] - nF[t]) * 0.08838834764831845f; }
        L[j] = lg; mx = fmaxf(mx, lg); }
#pragma unroll
    for (int o = 1; o < 64; o <<= 1) mx = fmaxf(mx, __shfl_xor(mx, o));
    float sm = 0.f;
    for (int j = lane; j < S; j += 64) { const float p = L[j] > -1.0e38f ? __expf(L[j] - mx) : 0.f; L[j] = p; sm += p; }
    sm = wave_sum(sm);
    asm volatile("s_waitcnt lgkmcnt(0)" ::: "memory");
    float o0 = 0.f, o1 = 0.f;
    for (int j = 0; j <= t; ++j) { const float p = L[j]; if (p != 0.f) { o0 += p * bf2f(Vp[(size_t)j * 128 + lane]); o1 += p * bf2f(Vp[(size_t)j * 128 + 64 + lane]); } }
    o0 /= sm; o1 /= sm;
    const bf16_t* MX = (const bf16_t*)(F.ws + WS_MIX) + (size_t)t * DM + (kind ? 1280 : 0) + hd * 128;
    const float m0 = bf2f(MX[lane]), m1 = bf2f(MX[64 + lane]);
    dg_add(F, kind, (m0 - o0) * (m0 - o0) + (m1 - o1) * (m1 - o1), o0 * o0 + o1 * o1);
    if (kind) { const int want = (t + 1 < 256) ? t + 1 : 256; cnt = (int)wave_sum((float)cnt); bad = (int)wave_sum((float)bad);
        if (hd == 0) dg_add(F, 2, (lane == 0) ? (float)((cnt - want) * (cnt - want) + bad) : 0.f, (lane == 0) ? (float)(want * want) : 0.f); }
}
__device__ __forceinline__ void dg_gla(Frame& F, int l, int h, int dv0) {
    const int tid = TID_, dk = tid & 127, dvs = tid >> 7, dv = dv0 + dvs;
    const bf16_t* Z = (const bf16_t*)(F.ws + WS_Z); const float* zs = (const float*)(F.ws + WS_ZS);
    LAS float* red = (LAS float*)F.lds;
    const float* wa = inp(I_GLA_WA2) + (size_t)l * 16 * 512 + h * 128 + dk; const float ba = inp(I_GLA_BA)[(size_t)l * 512 + h * 128 + dk];
    float st = 0.f; int ri = 0;
    for (int t = 0; t < S; ++t) {
        float x = ba; for (int r = 0; r < 16; ++r) x += zs[(size_t)t * 64 + ZS_GA + r] * wa[(size_t)r * 512];
        const float la = logsigmoidf(x) * 0.0625f;
        const float k = bf2f(Z[(size_t)t * LDZ + ZC_GK + h * 128 + dk]), v = bf2f(Z[(size_t)t * LDZ + ZC_GV + h * 128 + dv]);
        st = __expf(la) * st + k * v;
        if (ri < 16 && t == DG_ROWS[ri]) {
            const float q = bf2f(Z[(size_t)t * LDZ + ZC_GQ + h * 128 + dk]) * 0.08838834764831845f;
            __syncthreads(); red[tid] = q * st; __syncthreads();
            if (dk == 0) { float o = 0.f; for (int i = 0; i < 128; ++i) o += red[dvs * 128 + i]; ((float*)(F.ws + WS_UT))[((size_t)ri * 4 + h) * 128 + dv] = o; }
            ++ri; }
    }
}
__device__ __forceinline__ void dg_gla_cmp(Frame& F, int l, int ri, int h) {
    const int lane = LANE_, t = DG_ROWS[ri]; const float* go = (const float*)(F.ws + WS_UT) + ((size_t)ri * 4 + h) * 128;
    const float a0 = go[lane], a1 = go[64 + lane]; const float rstd = rsqrtf(wave_sum(a0 * a0 + a1 * a1) * (1.f / 128.f) + 1e-6f);
    const bf16_t* Z = (const bf16_t*)(F.ws + WS_Z) + (size_t)t * LDZ + ZC_GR + h * 128; const float* gn = inp(I_GLA_NORM_G) + (size_t)l * 128;
    const float y0 = a0 * rstd * gn[lane] * siluf(bf2f(Z[lane])), y1 = a1 * rstd * gn[64 + lane] * siluf(bf2f(Z[64 + lane]));
    const bf16_t* MX = (const bf16_t*)(F.ws + WS_MIX) + (size_t)t * DM + 768 + h * 128; const float m0 = bf2f(MX[lane]), m1 = bf2f(MX[64 + lane]);
    dg_add(F, 3, (m0 - y0) * (m0 - y0) + (m1 - y1) * (m1 - y1), y0 * y0 + y1 * y1);
}
__device__ __forceinline__ void dg_topk(Frame& F, int l, int ri, int h) {
    LAS float* L = (LAS float*)F.lds;
    const int lane = LANE_, t = DG_ROWS[ri];
    const bf16_t* QP = (const bf16_t*)(F.ws + WS_QP) + (size_t)t * DM + h * 256; const bf16_t* K1 = (const bf16_t*)(F.ws + WS_KB) + ((size_t)l * 8 + h) * 128 * 128; const bf16_t* K2 = K1 + 2 * 8 * 128 * 128;
    for (int half = 0; half < 2; ++half) for (int n = lane; n < 128; n += 64) { float a = 0.f; const bf16_t* K = half ? K2 : K1;
        for (int d = 0; d < 128; ++d) a += bf2f(QP[half * 128 + d]) * bf2f(K[(size_t)n * 128 + d]); L[half * 128 + n] = a; }
    asm volatile("s_waitcnt lgkmcnt(0)" ::: "memory");
    for (int half = 0; half < 2; ++half) for (int n = lane; n < 128; n += 64) { const float v = L[half * 128 + n]; int rk = 0;
        for (int m = 0; m < 128; ++m) { const float u = L[half * 128 + m]; rk += (u > v || (u == v && m < n)) ? 1 : 0; }
        if (rk < 16) { L[256 + half * 16 + rk] = v; L[288 + half * 16 + rk] = (float)n; } }
    asm volatile("s_waitcnt lgkmcnt(0)" ::: "memory");
    for (int c = lane; c < 256; c += 64) L[320 + c] = L[256 + (c >> 4)] + L[272 + (c & 15)];
    asm volatile("s_waitcnt lgkmcnt(0)" ::: "memory");
    for (int c = lane; c < 256; c += 64) { const float v = L[320 + c]; int rk = 0;
        for (int m = 0; m < 256; ++m) { const float u = L[320 + m]; rk += (u > v || (u == v && m < c)) ? 1 : 0; }
        if (rk < 16) { L[576 + rk] = v; L[592 + rk] = L[288 + (c >> 4)] * 128.f + L[304 + (c & 15)]; } }
    asm volatile("s_waitcnt lgkmcnt(0)" ::: "memory");
    const int* EI = (const int*)(F.ws + WS_EIDX) + ((size_t)t * 8 + h) * 16; const float* GT = (const float*)(F.ws + WS_GATE) + ((size_t)t * 8 + h) * 16;
    float d2 = 0.f, r2 = 0.f;
    if (lane < 16) { float sm = 0.f; for (int i = 0; i < 16; ++i) sm += __expf(L[576 + i] - L[576]); const float g = __expf(L[576 + lane] - L[576]) / sm; const int e = (int)L[592 + lane];
        float gk = 0.f; for (int i = 0; i < 16; ++i) if (EI[i] == e) gk = GT[i];
        d2 = (gk - g) * (gk - g); r2 = g * g; }
    dg_add(F, 4, d2, r2);
}
__device__ __forceinline__ void dg_gather(Frame& F, int l, int ri) {
    const int lane = LANE_, t = DG_ROWS[ri];
    const int* EI = (const int*)(F.ws + WS_EIDX) + (size_t)t * 128; const float* GT = (const float*)(F.ws + WS_GATE) + (size_t)t * 128;
    const unsigned char* UB = (const unsigned char*)(F.ws + WS_UB) + (size_t)l * 16384 * 2048; const unsigned char* VB = (const unsigned char*)(F.ws + WS_VB) + (size_t)l * 16384 * 2048;
    const float* SU = (const float*)(F.ws + WS_SU) + (size_t)l * 16384; const float* SV = (const float*)(F.ws + WS_SV) + (size_t)l * 16384;
    const bf16_t* H = (const bf16_t*)(F.ws + WS_H) + (size_t)t * DM; const float* X = (const float*)(F.ws + WS_X) + (size_t)t * DM; const float* mod = (const float*)(F.ws + WS_MOD) + (size_t)l * NMOD;
    float acc[32];
    for (int i = 0; i < 32; ++i) acc[i] = 0.f;
    for (int k = 0; k < 128; ++k) { const int e = EI[k]; float a = 0.f;
        for (int i = 0; i < 32; ++i) a += bf2f(H[lane + 64 * i]) * fp8f(UB[(size_t)e * 2048 + lane + 64 * i]);
        a = wave_sum(a) * SU[e]; const float w = GT[k] * gelu_tanh(a) * SV[e];
        for (int i = 0; i < 32; ++i) acc[i] += w * fp8f(VB[(size_t)e * 2048 + lane + 64 * i]); }
    float ss = 0.f;
    for (int i = 0; i < 32; ++i) { acc[i] = X[lane + 64 * i] + mod[5 * DM + lane + 64 * i] * acc[i]; ss += acc[i] * acc[i]; }
    const float rstd = rsqrtf(wave_sum(ss) * (1.f / DM) + 1e-6f); float d2 = 0.f, r2 = 0.f;
    for (int i = 0; i < 32; ++i) { const float y = acc[i] * rstd * inp(I_FINAL_G)[lane + 64 * i], o = outp()[(size_t)t * DM + lane + 64 * i]; d2 += (o - y) * (o - y); r2 += y * y; }
    dg_add(F, 5, d2, r2);
}
__device__ __forceinline__ void dg_gemm(Frame& F, int l, int ri) {
    const int lane = LANE_, t = DG_ROWS[ri]; const bf16_t* H = (const bf16_t*)(F.ws + WS_H) + (size_t)t * DM; const bf16_t* W = (const bf16_t*)(F.ws + WS_WQ) + (size_t)l * DM * DM;
    float d2 = 0.f, r2 = 0.f;
    for (int c = lane; c < DM; c += 64 * 7) { float a = 0.f; for (int k = 0; k < DM; ++k) a += bf2f(H[k]) * bf2f(W[(size_t)c * DM + k]);
        const float o = bf2f(((const bf16_t*)(F.ws + WS_QP))[(size_t)t * DM + c]); d2 += (o - a) * (o - a); r2 += a * a; }
    dg_add(F, 6, d2, r2);
}
__device__ __forceinline__ void dg_index(Frame& F, int ri) {
    LAS float* L = (LAS float*)F.lds + 16384;
    const int lane = LANE_, t = DG_ROWS[ri];
    const bf16_t* Z = (const bf16_t*)(F.ws + WS_Z); const float* zs = (const float*)(F.ws + WS_ZS);
    const unsigned long long* MK = (const unsigned long long*)(F.ws + WS_MASK) + (size_t)t * 128;
    for (int j = lane; j <= t; j += 64) { float sc = 0.f;
        for (int h = 0; h < 16; ++h) { float a = 0.f; for (int d = 0; d < 64; ++d) a += bf2f(Z[(size_t)t * LDZ + ZC_IQ + h * 64 + d]) * bf2f(Z[(size_t)j * LDZ + ZC_IK + d]);
            sc += fmaxf(a, 0.f) * (zs[(size_t)t * 64 + ZS_IW + h] * 0.03125f); }
        L[j] = sc; }
    asm volatile("s_waitcnt lgkmcnt(0)" ::: "memory");
    int mism = 0; const int want = (t + 1 < 256) ? t + 1 : 256;
    for (int j = lane; j <= t; j += 64) { const float v = L[j]; int rk = 0;
        for (int m = 0; m <= t; ++m) { const float u = L[m]; rk += (u > v || (u == v && m < j)) ? 1 : 0; }
        const bool sel = rk < 256, bit = (MK[j >> 6] >> (j & 63)) & 1ull; mism += (sel != bit) ? 1 : 0; }
    mism = (int)wave_sum((float)mism);
    dg_add(F, 7, (lane == 0) ? (float)(mism * mism) : 0.f, (lane == 0) ? (float)(4 * want * want) : 0.f);
}
__device__ __forceinline__ void diag_phase(Frame& F, XcdBarrier& bar) {
    const int l = DEPTH - 1, b = blockIdx.x;
    xcd_barrier(bar);
    if (b < 128) { dg_gla(F, l, b >> 5, (b & 31) * 4); }
    else { const int i0 = b - 128;
        if (F.wave == 0) for (int it = i0; it < 16 * 6 * 2 + 16 * 8; it += 128) {
            if (it < 192) dg_attn(F, it / 96, (it % 96) / 6, it % 6); else dg_topk(F, l, (it - 192) >> 3, (it - 192) & 7); }
        if (F.wave == 1) for (int it = i0; it < 32; it += 128) { if (it < 16) dg_gather(F, l, it); else dg_gemm(F, l, it - 16); }
        if (F.wave == 2) for (int it = i0; it < 16; it += 128) dg_index(F, it); }
    xcd_barrier(bar);
    if (b < 8 && F.wave < 8) { const int it = b * 8 + F.wave; dg_gla_cmp(F, l, it >> 2, it & 3); }
    xcd_barrier(bar);
    const float* DG = (const float*)(F.ctl + CW_DG); float worst = 0.f;
    for (int k = 0; k < 8; ++k) if ((DIAG >> k) & 1) { const float d2 = __hip_atomic_load(DG + 2 * k, __ATOMIC_RELAXED, __HIP_MEMORY_SCOPE_AGENT), r2 = __hip_atomic_load(DG + 2 * k + 1, __ATOMIC_RELAXED, __HIP_MEMORY_SCOPE_AGENT);
        worst = fmaxf(worst, sqrtf(d2 / fmaxf(r2, 1e-30f))); }
    const float sc = 1.f + DIAG_AMP * worst; float* O = outp();
    for (size_t i = (size_t)b * 512 + TID_; i < (size_t)S * DM; i += (size_t)F.G * 512) O[i] *= sc;
}
#endif

constexpr int PG_ITEMS = 256 + 32 * 31, PG_LAG = 2, CW_PANEL = 45056;
struct PgTab { unsigned short v[PG_ITEMS]; };
constexpr PgTab make_pg_tab() { PgTab t{}; int n = 0;
    for (int r = 0; r < 32 + PG_LAG; ++r) { int np = (r < 32) ? 8 : 0, ng = (r >= PG_LAG) ? 31 : 0, ip = 0, ig = 0;
        for (int k = 0; ip < np || ig < ng; ++k) { const bool wantp = (k % 5 == 0);
            if ((wantp && ip < np) || ig >= ng) { t.v[n++] = (unsigned short)(r * 8 + ip); ++ip; }
            else { t.v[n++] = (unsigned short)(0x8000 | ((r - PG_LAG) << 5) | ig); ++ig; } } }
    return t; }
__constant__ const PgTab PGTAB = make_pg_tab();
constexpr int PH_PRO = 3, PH_PER_LAYER = 8, N_PHASES = PH_PRO + DEPTH * PH_PER_LAYER;

#ifndef LB_T
#define LB_T (NWAVES * 64)
#endif
__global__ void __launch_bounds__(LB_T, 1) mega_fwd(Args args) {
    extern __shared__ __attribute__((aligned(16))) unsigned char lds_raw[];
    Frame F;
    F.lds = (LAS unsigned char*)lds_raw; F.MISC = (volatile LAS unsigned*)(F.lds + MISC_OFF);
    F.wave = __builtin_amdgcn_readfirstlane(TID_ >> 6);
    F.G = gridDim.x; F.gw = blockIdx.x * NWAVES + F.wave; F.NGW = F.G * NWAVES;
    F.ws = (GAS unsigned char*)args.ws; F.ctl = (unsigned*)(F.ws + WS_CTL);
    if (TID_ < 64) F.MISC[TID_] = 0u;
    __syncthreads();
    const int lo = args.ph_lo, hi = args.ph_hi;
    XcdBarrier bar; bar.bar = (unsigned*)F.ctl + CW_BAR; bar.x = 0; bar.st = nullptr;
    if (hi - lo > 1) bar = xcd_barrier_post((unsigned*)F.ctl + CW_BAR, F.MISC + 8);
#define IN(k) (lo <= (k) && (k) < hi)
#if REPEAT_N > 1
#define REPS(k) (((k) == REPEAT_PHASE) ? REPEAT_N : 1)
#define REPBAR() xcd_barrier(bar)
#else
#define REPS(k) 1
#define REPBAR() do {} while (0)
#endif
#define SEAM(k) do { if (IN(k) && IN((k) + 1)) xcd_barrier(bar); } while (0)

    if (IN(0)) for (int rep_ = 0; rep_ < REPS(0); ++rep_) { if (rep_) REPBAR();
#if EN_PRO
 p0a_prologue(F);
#endif
 } SEAM(0);
    if (IN(1)) for (int rep_ = 0; rep_ < REPS(1); ++rep_) { if (rep_) REPBAR(); p0b_modreduce(F); } SEAM(1);
    if (IN(2)) for (int rep_ = 0; rep_ < REPS(2); ++rep_) { if (rep_) REPBAR(); const float* mod = (const float*)(F.ws + WS_MOD);
#if WIN_FP8
        for (int m = F.gw; m < S; m += F.NGW) norm_row_f8(inp(I_X) + (size_t)m * DM, inp(I_NORM1_G), mod + DM, mod, (unsigned char*)(F.ws + WS_H8) + (size_t)m * DM, (float*)(F.ws + WS_SA) + m, (bf16_t*)(F.ws + WS_H) + (size_t)m * DM, WIN_BF16_TILES != 0, LANE_); } SEAM(2);
#else
        for (int m = F.gw; m < S; m += F.NGW) norm_row(inp(I_X) + (size_t)m * DM, inp(I_NORM1_G), mod + DM, mod, (bf16_t*)(F.ws + WS_H) + (size_t)m * DM, nullptr, LANE_); } SEAM(2);
#endif

#pragma unroll 1
    for (int l = 0; l < DEPTH; ++l) {
        { F.wave = __builtin_amdgcn_readfirstlane(TID_ >> 6);
          int b_ = blockIdx.x; asm volatile("" : "+s"(b_)); F.gw = b_ * NWAVES + F.wave; }
        { GAS unsigned char* wsl = (GAS unsigned char*)args.ws; asm volatile("" : "+s"(wsl)); F.ws = wsl; }
        const int pb = PH_PRO + l * PH_PER_LAYER; const float* mod = (const float*)(F.ws + WS_MOD) + (size_t)l * NMOD;
        if (IN(pb + 0) && !(FUSE_PG && l > 0)) for (int rep_ = 0; rep_ < REPS(pb + 0); ++rep_) { if (rep_) REPBAR();
            pg8::StaticOrder So; So.init(S, LDZ, F.G, (int)blockIdx.x);
#if EN_GEMM
#if WIN_FP8
            constexpr unsigned MB = WIN_BF16_TILES & 0x7fffffffu, M8 = ~MB & 0x7fffffffu; constexpr int NB = __builtin_popcount(MB), N8T = 31 - NB;
            int G_ = F.G, c_ = blockIdx.x; asm volatile("" : "+s"(G_), "+s"(c_));
            { pg8::Gemm gb{(const bf16_t*)(F.ws + WS_H), (const bf16_t*)(F.ws + WS_WIN) + (size_t)l * LDZ * DM, S, LDZ, DM};
              pg8::EpiZ Eb{(bf16_t*)(F.ws + WS_Z), (float*)(F.ws + WS_ZS), LDZ, (bf16_t*)(F.ws + WS_ZH), nullptr, 1.f};
              pg8::SubsetOrder Sb; Sb.o.init(S, NB * 256, G_, c_); Sb.mask = MB;
              pg8::gemm_phase<pg8::EpiZ, pg8::SubsetOrder, true, true>(F.lds, gb, Sb, Eb); }
            if (N8T > 0) {
            pg8::Gemm g{(const bf16_t*)(F.ws + WS_H8), (const bf16_t*)(F.ws + WS_WIN8 + (size_t)l * LDZ * DM), S, LDZ, DM / 2};
            const float wam = __uint_as_float(__hip_atomic_load(F.ctl + CW_WAMAX + l, __ATOMIC_RELAXED, __HIP_MEMORY_SCOPE_AGENT));
            pg8::EpiZ E{(bf16_t*)(F.ws + WS_Z), (float*)(F.ws + WS_ZS), LDZ, (bf16_t*)(F.ws + WS_ZH), (const float*)(F.ws + WS_SA), wam > 0.f ? wam * (1.f / 448.f) : 1.f};
#if EPI_PROBE
            E.skip = (rep_ == 0) && (REPS(pb + 0) > 1);
#endif
            pg8::SplitOrder So2; So2.o.init(S, N8T * 256, G_, c_); So2.mask = M8;
            const int r0 = (32 * NB) % G_, ok8 = (r0 % 8 == 0) && ((G_ - r0) % 8 == 0);
            So2.nlight = ok8 ? r0 : 0; So2.kheavy = (32 * N8T + 2 * So2.nlight + G_ - 1) / G_; So2.klight = So2.kheavy - 2;
            pg8::gemm_phase<pg8::EpiZ, pg8::SplitOrder, true, true, true>(F.lds, g, So2, E); }
#else
            pg8::Gemm g{(const bf16_t*)(F.ws + WS_H), (const bf16_t*)(F.ws + WS_WIN) + (size_t)l * LDZ * DM, S, LDZ, DM};
            pg8::EpiZ E{(bf16_t*)(F.ws + WS_Z), (float*)(F.ws + WS_ZS), LDZ, (bf16_t*)(F.ws + WS_ZH), nullptr, 1.f};
            pg8::gemm_phase<pg8::EpiZ, pg8::StaticOrder, true, true>(F.lds, g, So, E);
#endif
#endif
 } if (!(FUSE_PG && l > 0)) SEAM(pb + 0);
        if (IN(pb + 1)) for (int rep_ = 0; rep_ < REPS(pb + 1); ++rep_) { if (rep_) REPBAR(); const int q = 2 * l + 8 * rep_;
            for (int it = deq(F, q); it < N_IDX_ITEMS + 513 + 64 + (CONV_IN_QUEUES ? CONV_ITEMS : 0); it = deq(F, q)) {
                if (it == 0) fox_cumsum_item(F, l);
                else if (it <= 512) {
#if EN_G1
 for (int rr_ = 0; rr_ < REP_G1; ++rr_) gla_g1_item(F, l, it - 1);
#endif
 } else if (it <= 512 + N_IDX_ITEMS) {
#if EN_IDX
 for (int rr_ = 0; rr_ < REP_IDX; ++rr_) indexer_item(F, it - 513);
#endif
 } else if (it < N_IDX_ITEMS + 513 + 64) fox_norm_item(F, l, it - (N_IDX_ITEMS + 513));
                else conv_item(F, l, 0, it - (N_IDX_ITEMS + 513 + 64)); } } SEAM(pb + 1);
        if (IN(pb + 2)) for (int rep_ = 0; rep_ < REPS(pb + 2); ++rep_) { if (rep_) REPBAR();
#if EN_SEL
 phase_select(F, l * (((S / 2 + F.G - 1) / F.G) + NWAVES));
#endif
 } SEAM(pb + 2);
        if (IN(pb + 3)) for (int rep_ = 0; rep_ < REPS(pb + 3); ++rep_) { if (rep_) REPBAR();
#if EN_ATT
 phase_attn(F, l, 2 * l + 1 + 8 * rep_);
#endif
 } SEAM(pb + 3);
        if (IN(pb + 4)) for (int rep_ = 0; rep_ < REPS(pb + 4); ++rep_) { if (rep_) REPBAR();
            pg8::StaticOrder So; So.init(S, DM, F.G, (int)blockIdx.x);
            const float* xin = l == 0 ? inp(I_X) : (const float*)(F.ws + WS_X);
#if EN_GEMM
#if WO_FP8
            const unsigned ovf = __builtin_amdgcn_readfirstlane(__hip_atomic_load(F.ctl + CW_MIXOVF + l, __ATOMIC_RELAXED, __HIP_MEMORY_SCOPE_AGENT));
            if (ovf == 0u) {
                const float wam = __uint_as_float(__hip_atomic_load(F.ctl + CW_WAMAX + 2 + l, __ATOMIC_RELAXED, __HIP_MEMORY_SCOPE_AGENT));
                pg8::Gemm g{(const bf16_t*)(F.ws + WS_MIX8), (const bf16_t*)(F.ws + WS_WO8 + (size_t)l * DM * DM), S, DM, DM / 2};
                pg8::EpiRes E{xin, (float*)(F.ws + WS_X), mod + 2 * DM, DM, (wam > 0.f ? wam * (1.f / 448.f) : 1.f) * (1.f / MIX_S)};
                pg8::gemm_phase<pg8::EpiRes, pg8::StaticOrder, true, true, true>(F.lds, g, So, E);
            } else
#endif
            { pg8::Gemm g{(const bf16_t*)(F.ws + WS_MIX), (const bf16_t*)(F.ws + WS_WO) + (size_t)l * DM * DM, S, DM, DM};
              pg8::EpiRes E{xin, (float*)(F.ws + WS_X), mod + 2 * DM, DM, 1.f};
              pg8::gemm_phase<pg8::EpiRes, pg8::StaticOrder, true, true>(F.lds, g, So, E); }
#endif
 } SEAM(pb + 4);
        if (IN(pb + 5)) for (int rep_ = 0; rep_ < REPS(pb + 5); ++rep_) { if (rep_) REPBAR(); for (int m = F.gw; m < S; m += F.NGW) norm_row((const float*)(F.ws + WS_X) + (size_t)m * DM, inp(I_NORM2_G) + (size_t)l * DM, mod + 4 * DM, mod + 3 * DM, (bf16_t*)(F.ws + WS_H) + (size_t)m * DM, nullptr, LANE_); } SEAM(pb + 5);
        if (IN(pb + 6)) for (int rep_ = 0; rep_ < REPS(pb + 6); ++rep_) { if (rep_) REPBAR(); pg8::Gemm g{(const bf16_t*)(F.ws + WS_H), (const bf16_t*)(F.ws + WS_WQ) + (size_t)l * DM * DM, S, DM, DM};
            pg8::StaticOrder So; So.init(S, DM, F.G, (int)blockIdx.x); pg8::EpiBf16<0> E{(bf16_t*)(F.ws + WS_QP), DM, nullptr, 0, 0, 1.f};
#if EN_GEMM
            pg8::gemm_phase<pg8::EpiBf16<0>, pg8::StaticOrder, true, true>(F.lds, g, So, E);
#endif
 } SEAM(pb + 6);
        if (IN(pb + 7)) for (int rep_ = 0; rep_ < REPS(pb + 7); ++rep_) { if (rep_) REPBAR();
#if EN_TOPK && EN_GATHER
            if (FUSE_PG && l + 1 < DEPTH) {
                const int q = 4 + l;
                for (int it = deq(F, q); it < PG_ITEMS; it = deq(F, q)) {
                    const int code = __builtin_amdgcn_readfirstlane((int)PGTAB.v[it]);
                    if (!(code & 0x8000)) { const int tb = code;
                        peer_topk_item(F, l, tb * 8 + F.wave);
                        asm volatile("s_waitcnt vmcnt(0)" ::: "memory"); __syncthreads();
                        peer_gather_group<2>(F, l, tb * 32 + F.wave * 4, 1);
                        peer_gather_group<2>(F, l, tb * 32 + F.wave * 4 + 2, 1);
                        asm volatile("s_waitcnt vmcnt(0)" ::: "memory"); __syncthreads();
                        if (TID_ == 0) { __builtin_amdgcn_fence(__ATOMIC_RELEASE, "agent"); asm volatile("s_waitcnt vmcnt(0)" ::: "memory");
                            __hip_atomic_fetch_add(F.ctl + CW_PANEL + 64 * l + (tb >> 3), 1u, __ATOMIC_RELAXED, __HIP_MEMORY_SCOPE_AGENT); }
                    } else { const int pm = (code & 0x7fff) >> 5, pn = code & 31;
                        if (TID_ == 0) { unsigned sp = 0;
                            while (__hip_atomic_load(F.ctl + CW_PANEL + 64 * l + pm, __ATOMIC_RELAXED, __HIP_MEMORY_SCOPE_AGENT) < 8u) { __builtin_amdgcn_s_sleep(8); if (++sp > (1u << 24)) break; }
                            __builtin_amdgcn_fence(__ATOMIC_ACQUIRE, "agent"); asm volatile("s_waitcnt vmcnt(0)" ::: "memory"); }
                        __syncthreads();
                        pg8::Gemm g{(const bf16_t*)(F.ws + WS_H), (const bf16_t*)(F.ws + WS_WIN) + (size_t)(l + 1) * LDZ * DM, S, LDZ, DM};
                        pg8::OneUnit So{{pm, pn}}; pg8::EpiZ E{(bf16_t*)(F.ws + WS_Z), (float*)(F.ws + WS_ZS), LDZ, (bf16_t*)(F.ws + WS_ZH)};
                        pg8::gemm_phase<pg8::EpiZ, pg8::OneUnit, true, true>(F.lds, g, So, E);
                    }
                }
            } else
            for (int tb = blockIdx.x; tb < S / 32; tb += F.G) {
                peer_topk_item(F, l, tb * 8 + F.wave);
                asm volatile("s_waitcnt vmcnt(0)" ::: "memory"); __syncthreads();
#if GATHER_PROBE
                peer_gather_group<2, true>(F, l, tb * 32 + F.wave * 4, 1);
                peer_gather_group<2, true>(F, l, tb * 32 + F.wave * 4 + 2, 1);
#endif
                peer_gather_group<2>(F, l, tb * 32 + F.wave * 4, 1);
                peer_gather_group<2>(F, l, tb * 32 + F.wave * 4 + 2, 1);
                __syncthreads(); }
#endif
        } SEAM(pb + 7);
    }
#if DIAG
    diag_phase(F, bar);
#endif
#undef IN
#undef SEAM
}

extern "C" void kernel_launch(void* const* d_in, const int* in_sizes, int n_in, void* d_out, int out_size, void* d_ws, size_t ws_size, hipStream_t stream) {
    static int grid = 0;
    if (grid == 0) {
        if (n_in != 18 || out_size != S * DM || ws_size < WS_END) { fprintf(stderr, "kernel_launch: unexpected shapes (n_in %d out %d ws %zu)\n", n_in, out_size, ws_size); grid = -1; return; }
        int dev = 0, cus = 0, per_cu = 0;
        if (hipGetDevice(&dev) != hipSuccess || hipDeviceGetAttribute(&cus, hipDeviceAttributeMultiprocessorCount, dev) != hipSuccess) { grid = -1; return; }
        if (hipFuncSetAttribute((const void*)mega_fwd, hipFuncAttributeMaxDynamicSharedMemorySize, LDS_BYTES) != hipSuccess) { fprintf(stderr, "kernel_launch: hipFuncSetAttribute failed\n"); grid = -1; return; }
        if (hipOccupancyMaxActiveBlocksPerMultiprocessor(&per_cu, (const void*)mega_fwd, NWAVES * 64, LDS_BYTES) != hipSuccess || per_cu < 1) { fprintf(stderr, "kernel_launch: occupancy query says %d blocks per CU\n", per_cu); (void)hipGetLastError(); }
        grid = cus;
    }
    if (grid < 0) return;
    (void)in_sizes;
    if (hipMemsetAsync((char*)d_ws + WS_CTL, 0, CTL_ZERO_BYTES, stream) != hipSuccess) { fprintf(stderr, "kernel_launch: memset failed\n"); return; }
    Args a{};
    for (int i = 0; i < 18; ++i) a.in[i] = (const float*)d_in[i];
    a.out = (float*)d_out; a.ws = (unsigned char*)d_ws;
#if MK_MULTI
    for (int ph = 0; ph < N_PHASES; ++ph) { a.ph_lo = ph; a.ph_hi = ph + 1; hipLaunchKernelGGL(mega_fwd, dim3(grid), dim3(NWAVES * 64), LDS_BYTES, stream, a); }
#else
    a.ph_lo = 0; a.ph_hi = N_PHASES;
#if MK_COOP
    void* kargs[] = {(void*)&a};
    hipError_t e = hipLaunchCooperativeKernel((const void*)mega_fwd, dim3(grid), dim3(NWAVES * 64), kargs, LDS_BYTES, stream);
    if (e != hipSuccess) fprintf(stderr, "kernel_launch: cooperative launch failed: %s (grid %d)\n", hipGetErrorString(e), grid);
#else
    hipLaunchKernelGGL(mega_fwd, dim3(grid), dim3(NWAVES * 64), LDS_BYTES, stream, a);
#endif
#endif
}
```

```cpp
#include <hip/hip_runtime.h>
#include <hip/hip_bf16.h>
#include <hip/hip_cooperative_groups.h>
#include <cstdio>
#include <cstdint>
#include <cmath>

#ifndef MK_MULTI
#define MK_MULTI 0
#endif

#ifndef EN_ALL
#define EN_ALL 1
#endif
#ifndef EN_PRO
#define EN_PRO EN_ALL
#endif
#ifndef EN_GEMM
#define EN_GEMM EN_ALL
#endif
#ifndef EN_IDX
#define EN_IDX EN_ALL
#endif
#ifndef EN_G1
#define EN_G1 EN_ALL
#endif
#ifndef EN_SEL
#define EN_SEL EN_ALL
#endif
#ifndef EN_ATT
#define EN_ATT EN_ALL
#endif
#ifndef EN_TOPK
#define EN_TOPK EN_ALL
#endif
#ifndef EN_GATHER
#define EN_GATHER EN_ALL
#endif
#ifndef DIAG
#define DIAG 0
#endif
#ifndef REPEAT_N
#define REPEAT_N 1
#define REPEAT_PHASE -1
#endif
#ifndef REP_IDX
#define REP_IDX 1
#endif
#ifndef REP_G1
#define REP_G1 1
#endif
#ifndef REP_SEL
#define REP_SEL 1
#endif
#ifndef MK_COOP
#define MK_COOP 1
#endif
#ifndef WT_STORES
#define WT_STORES 0
#endif
#ifndef REP_G3
#define REP_G3 1
#endif
#ifndef FUSE_PG
#define FUSE_PG 0
#endif
#ifndef REP_FOX
#define REP_FOX 1
#endif
#ifndef WIN_FP8
#define WIN_FP8 1
#endif
#ifndef WIN_BF16_TILES
#define WIN_BF16_TILES 0x00000000u
#endif
#ifndef GATHER_PROBE
#define GATHER_PROBE 0
#endif
#ifndef CONV_IN_QUEUES
#define CONV_IN_QUEUES 1
#endif
#ifndef EPI_PROBE
#define EPI_PROBE 0
#endif
#ifndef WT_EPI
#define WT_EPI 0
#endif
#ifndef WO_FP8
#define WO_FP8 0
#endif
#define MIX_S 8.0f
#ifndef TOPK_PROBE
#define TOPK_PROBE 0
#endif
#ifndef CONV_SHADOW
#define CONV_SHADOW 0
#endif
#ifndef PEER_U_MFMA
#define PEER_U_MFMA 0
#endif
#ifndef PEER_NIBSWAP
#define PEER_NIBSWAP 0
#endif
#ifndef PEER_U_CHECK
#define PEER_U_CHECK 0
#endif
#ifndef PROBE_FQ
#define PROBE_FQ 0
#endif
#ifndef PROBE_T
#define PROBE_T 0
#endif
#ifndef PEER_U_INT4
#define PEER_U_INT4 1
#endif
#ifndef PEER_SWEEP_ALIGN
#define PEER_SWEEP_ALIGN 0
#endif
#ifndef PEER_PIPE
#define PEER_PIPE 0
#endif
#ifndef ATT_STATIC_PRIO
#define ATT_STATIC_PRIO 1
#endif
#ifndef STAGGER_PROBE
#define STAGGER_PROBE 0
#endif
#ifndef ATT_QPIN
#define ATT_QPIN 0
#endif

namespace pg8 {
#define PG8_LAS __attribute__((address_space(3)))
typedef unsigned short bf16_t;
typedef short bf16x8 __attribute__((ext_vector_type(8)));
typedef float f32x4 __attribute__((ext_vector_type(4)));
typedef unsigned u32x4 __attribute__((ext_vector_type(4)));
typedef int i32x4 __attribute__((ext_vector_type(4)));
constexpr int BM = 256, BK = 64, HALF = 128, HTB = HALF * BK * 2  , STAGE_BYTES = 8 * HTB, NXCD = 8, WGM = 8;

__host__ __device__ __forceinline__ int lds_byte(int r, int c) { const int st = (r >> 4) * 2 + (c >> 5), rr = r & 15, cc = c & 31, ob = rr * 64 + cc * 2; return st * 1024 + (ob ^ (((ob >> 9) & 1) << 5)); }
__host__ __device__ __forceinline__ void stage_rc(int b, int& R, int& C) { const int st = b / 1024, sb = b % 1024, swz = sb ^ (((sb >> 9) & 1) << 5); R = (st >> 1) * 16 + swz / 64; C = (st & 1) * 32 + (swz % 64) / 2; }
__host__ __device__ __forceinline__ int perm32(int rho) { const int n = rho >> 4, i = rho & 15; return 8 * (i >> 2) + 4 * n + (i & 3); }

struct Unit { int pm, pn; };
struct Gemm { const bf16_t* A; const bf16_t* Bt; int M, N, K; };

struct StaticOrder {
    int nM, nN, nwg, G, c;
    __host__ __device__ void init(int M, int N, int G_, int c_) { nM = M / BM; nN = N / BM; nwg = nM * nN; G = G_; c = c_; }
    __host__ __device__ bool next(int i, Unit& u) const { const long L = (long)i * G + c; if (L >= nwg) return false; map((int)L, u); return true; }
    __host__ __device__ void map(int L, Unit& u) const {
        int wgid = L; { const int q = nwg / NXCD, r = nwg % NXCD, xcd = wgid % NXCD, off = wgid / NXCD; wgid = (xcd < r ? xcd * (q + 1) : r * (q + 1) + (xcd - r) * q) + off; }
        const int nig = WGM * nN, gid = wgid / nig, fm = gid * WGM, gsz = (nM - fm) < WGM ? (nM - fm) : WGM;
        u.pm = fm + ((wgid % nig) % gsz); u.pn = (wgid % nig) / gsz;
    }
    __device__ __forceinline__ void a_ready(const Unit&) const {}
    __device__ __forceinline__ void done(const Unit&) const {}
};

__host__ __device__ __forceinline__ int kth_tile(unsigned mask, int k) { int t = 0; for (;; ++t) if ((mask >> t) & 1u) { if (k == 0) break; --k; } return t; }
struct SubsetOrder { StaticOrder o; unsigned mask;
    __host__ __device__ bool next(int i, Unit& u) const { if (!o.next(i, u)) return false; u.pn = kth_tile(mask, u.pn); return true; }
    __device__ __forceinline__ void a_ready(const Unit&) const {}
    __device__ __forceinline__ void done(const Unit&) const {} };
struct SplitOrder {
    StaticOrder o; unsigned mask; int nlight, klight, kheavy;
    __host__ __device__ bool next(int i, Unit& u) const {
        const int nh = o.G - nlight; int L;
        if (o.c >= nlight) { if (i >= kheavy) return false; L = i * nh + (o.c - nlight); } else { if (i >= klight) return false; L = kheavy * nh + i * nlight + o.c; }
        if (L >= o.nwg) return false; o.map(L, u); u.pn = kth_tile(mask, u.pn); return true; }
    __device__ __forceinline__ void a_ready(const Unit&) const {}
    __device__ __forceinline__ void done(const Unit&) const {}
};
struct MaybeUnit { Unit u; bool has;
    __device__ __forceinline__ bool next(int i, Unit& o) const { if (i || !has) return false; o = u; return true; }
    __device__ __forceinline__ void a_ready(const Unit&) const {}
    __device__ __forceinline__ void done(const Unit&) const {} };

__device__ __forceinline__ void epi_store16(void* p, u32x4 v) {
#if WT_EPI
    asm volatile("global_store_dwordx4 %0, %1, off sc0 sc1" :: "v"(p), "v"(v) : "memory");
#else
    *(u32x4*)p = v;
#endif
}
__device__ __forceinline__ unsigned cvt_pk_bf16(float lo, float hi) { unsigned r; asm volatile("v_cvt_pk_bf16_f32 %0, %1, %2" : "=v"(r) : "v"(lo), "v"(hi)); return r; }
typedef float f32x2 __attribute__((ext_vector_type(2)));
__device__ __forceinline__ f32x2 gelu_pk(f32x2 v) {
    const f32x2 av = __builtin_elementwise_abs(v), d = av * 0.2316418882f + 1.0f;
    f32x2 t; t.x = __builtin_amdgcn_rcpf(d.x); t.y = __builtin_amdgcn_rcpf(d.y);
    f32x2 q = t * 0.5307027145f + (-0.7265760135f); q = q * t + 0.7107068705f; q = q * t + (-0.142248368f); q = q * t + 0.127414796f; q = q * t;
    const f32x2 s = (v * v) * (-0.72134752044f);
    f32x2 e; e.x = __builtin_amdgcn_exp2f(s.x); e.y = __builtin_amdgcn_exp2f(s.y);
    const f32x2 m = v * (q * e), r = v - m;
    f32x2 o; o.x = v.x < 0.f ? m.x : r.x; o.y = v.y < 0.f ? m.y : r.y; return o;
}

template <int ACT  > struct EpiBf16 {
    static constexpr bool PERM = true, AFTER_DRAIN = false; static_assert(ACT == 0 || ACT == 1, "EpiBf16: ACT is 0 (none) or 1 (gelu_pk)");
    bf16_t* O; int ldc; const float* bias; int split_cols; size_t split_stride; float scale0;
    __device__ __forceinline__ void operator()(const f32x4 (&acc)[2][2][4][2], const Unit& u, int wr, int wc, int fr, int fq) const {
        const int row0 = u.pm * BM + wr * 64 + fr; int colt = u.pn * BM; bf16_t* base = O;
        float sc = 1.f; if (split_cols) { const int t = colt / split_cols; base += (size_t)t * split_stride; colt -= t * split_cols; if (t == 0) sc = scale0; }
        const int col0 = colt + wc * 32 + 8 * fq, bcol0 = u.pn * BM + wc * 32 + 8 * fq;
        f32x4 bv[2][2];
#pragma unroll
        for (int bj = 0; bj < 2; ++bj)
#pragma unroll
            for (int n = 0; n < 2; ++n) bv[bj][n] = bias ? *(const f32x4*)(bias + bcol0 + bj * HALF + 4 * n) : (f32x4){0.f, 0.f, 0.f, 0.f};
#pragma unroll
        for (int ai = 0; ai < 2; ++ai)
#pragma unroll
            for (int m = 0; m < 4; ++m) { bf16_t* rowp = base + (size_t)(row0 + ai * HALF + m * 16) * ldc + col0;
#pragma unroll
                for (int bj = 0; bj < 2; ++bj) { f32x4 v0 = acc[ai][bj][m][0] + bv[bj][0], v1 = acc[ai][bj][m][1] + bv[bj][1];
                    if (ACT == 1) { f32x2 a = gelu_pk((f32x2){v0[0], v0[1]}), b = gelu_pk((f32x2){v0[2], v0[3]}), c = gelu_pk((f32x2){v1[0], v1[1]}), d = gelu_pk((f32x2){v1[2], v1[3]});
                        v0 = (f32x4){a.x, a.y, b.x, b.y}; v1 = (f32x4){c.x, c.y, d.x, d.y}; }
                    v0 = v0 * sc; v1 = v1 * sc; u32x4 w; w.x = cvt_pk_bf16(v0[0], v0[1]); w.y = cvt_pk_bf16(v0[2], v0[3]); w.z = cvt_pk_bf16(v1[0], v1[1]); w.w = cvt_pk_bf16(v1[2], v1[3]);
                    epi_store16(rowp + bj * HALF, w); } }
    }
};

typedef int i32x8 __attribute__((ext_vector_type(8)));
template <bool F8> struct Frag2;
template <> struct Frag2<false> { bf16x8 k[2];
    __device__ __forceinline__ void load(const PG8_LAS unsigned char* p) { k[0] = *(const PG8_LAS bf16x8*)p; k[1] = *(const PG8_LAS bf16x8*)(p + 1024); } };
template <> struct Frag2<true> { i32x8 v;
    __device__ __forceinline__ void load(const PG8_LAS unsigned char* p) { const i32x4 a = *(const PG8_LAS i32x4*)p, b = *(const PG8_LAS i32x4*)(p + 1024); v = __builtin_shufflevector(a, b, 0, 1, 2, 3, 4, 5, 6, 7); } };
__device__ __forceinline__ f32x4 frag_mma(const Frag2<false>& b, const Frag2<false>& a, f32x4 c) { c = __builtin_amdgcn_mfma_f32_16x16x32_bf16(b.k[0], a.k[0], c, 0, 0, 0); return __builtin_amdgcn_mfma_f32_16x16x32_bf16(b.k[1], a.k[1], c, 0, 0, 0); }
__device__ __forceinline__ f32x4 frag_mma(const Frag2<true>& b, const Frag2<true>& a, f32x4 c) { asm volatile("v_mfma_f32_16x16x128_f8f6f4 %0, %1, %2, %0" : "+v"(c) : "v"(b.v), "v"(a.v)); return c; }
template <class Epi, class Sched, bool ALIGN_EPI = false, bool SP2 = false, bool F8 = false>
__device__ __forceinline__ void gemm_phase(PG8_LAS unsigned char* lds, const Gemm g, const Sched& S, const Epi& E) {
    int tid = threadIdx.x; asm volatile("" : "+v"(tid));
    const int wid = __builtin_amdgcn_readfirstlane(tid >> 6), lane = tid & 63, wr = wid >> 2, wc = wid & 3, fr = lane & 15, fq = lane >> 4;
    const int K = g.K, nt = K / BK;
    unsigned voffA[2], voffB[2];
#pragma unroll
    for (int i = 0; i < 2; ++i) { int R, C; stage_rc(tid * 16 + i * 8192, R, C); const int Rb = Epi::PERM ? ((R & ~31) + perm32(R & 31)) : R;
        voffA[i] = (unsigned)(R * K + C) * 2u; voffB[i] = (unsigned)(Rb * K + C) * 2u; }
    const size_t kstep = (size_t)(BK * 2);
    const size_t hstep = (size_t)HALF * K * 2;
    const size_t tstep = 2 * hstep;
    const unsigned ldsw = (unsigned)wid * 1024u;
    const int aoff = lds_byte(wr * 64 + fr, fq * 8), boff = lds_byte(wc * 32 + fr, fq * 8);
#define PG8_SA(b, h) (((b) * 2 + (h)) * HTB)
#define PG8_SB(b, h) ((4 + (b) * 2 + (h)) * HTB)
#define PG8_STAGE(bufoff, gbase, voff) do { _Pragma("unroll") for (int _i = 0; _i < 2; ++_i) \
        __builtin_amdgcn_global_load_lds((const unsigned*)((const char*)(gbase) + (voff)[_i]), (PG8_LAS unsigned*)(lds + (bufoff) + ldsw + _i * 8192), 16, 0, 0); } while (0)
#define PG8_LDA(dst, b, h) do { _Pragma("unroll") for (int m = 0; m < 4; ++m) dst[m].load(lds + PG8_SA(b, h) + aoff + m * 2048); } while (0)
#define PG8_LDB(dst, b, h) do { _Pragma("unroll") for (int n = 0; n < 2; ++n) dst[n].load(lds + PG8_SB(b, h) + boff + n * 2048); } while (0)
#define PG8_MMA(ai, bj, At, Bt) do { __builtin_amdgcn_s_setprio(1); _Pragma("unroll") for (int m = 0; m < 4; ++m) _Pragma("unroll") for (int n = 0; n < 2; ++n) \
        acc[ai][bj][m][n] = frag_mma(Bt[n], At[m], acc[ai][bj][m][n]); __builtin_amdgcn_s_setprio(0); } while (0)
#define PG8_WAIT_V(n) asm volatile("s_waitcnt vmcnt(" #n ")" ::: "memory")
#define PG8_WAIT_L(n) asm volatile("s_waitcnt lgkmcnt(" #n ")" ::: "memory")
#define PG8_BAR __builtin_amdgcn_s_barrier()
#define PG8_SCHED __builtin_amdgcn_sched_barrier(0)
    Unit cur, nxt; int ui = 0;
    if (!S.next(0, cur)) return;
    f32x4 acc[2][2][4][2];
#pragma unroll
    for (int a = 0; a < 2; ++a)
#pragma unroll
        for (int b = 0; b < 2; ++b)
#pragma unroll
            for (int m = 0; m < 4; ++m)
#pragma unroll
                for (int n = 0; n < 2; ++n) acc[a][b][m][n] = (f32x4){0.f, 0.f, 0.f, 0.f};
    Frag2<F8> At[4], B0[2], B1[2];
    const char* cA = (const char*)g.A + (size_t)cur.pm * tstep; const char* cB = (const char*)g.Bt + (size_t)cur.pn * tstep;
    S.a_ready(cur);
    if constexpr (SP2) {
        PG8_STAGE(PG8_SB(0, 0), cB, voffB); PG8_STAGE(PG8_SB(0, 1), cB + hstep, voffB); PG8_STAGE(PG8_SA(0, 0), cA, voffA); PG8_STAGE(PG8_SA(0, 1), cA + hstep, voffA);
        if (wr == 1) PG8_BAR;
        PG8_WAIT_V(2); PG8_BAR;
        PG8_STAGE(PG8_SB(1, 0), cB + kstep, voffB); PG8_STAGE(PG8_SA(1, 0), cA + kstep, voffA); PG8_STAGE(PG8_SB(1, 1), cB + hstep + kstep, voffB);
        PG8_WAIT_V(6); PG8_BAR;
    } else {
        PG8_STAGE(PG8_SB(0, 0), cB, voffB); PG8_STAGE(PG8_SA(0, 0), cA, voffA); PG8_STAGE(PG8_SB(0, 1), cB + hstep, voffB); PG8_STAGE(PG8_SA(0, 1), cA + hstep, voffA);
        if (wr == 1) PG8_BAR;
        PG8_WAIT_V(4); PG8_BAR;
        PG8_STAGE(PG8_SB(1, 0), cB + kstep, voffB); PG8_STAGE(PG8_SA(1, 0), cA + kstep, voffA); PG8_STAGE(PG8_SB(1, 1), cB + hstep + kstep, voffB);
        PG8_WAIT_V(6); PG8_BAR;
    }
    for (;;) {
        const bool has_next = S.next(ui + 1, nxt);
        const char* nA = has_next ? (const char*)g.A + (size_t)nxt.pm * tstep : cA; const char* nB = has_next ? (const char*)g.Bt + (size_t)nxt.pn * tstep : cB;
        for (int t = 0; t < nt; t += 2) {
            const bool last = (t == nt - 2);
            const char* a1 = cA + (size_t)(t + 1) * kstep;
            const char* a2 = last ? nA : cA + (size_t)(t + 2) * kstep; const char* b2 = last ? nB : cB + (size_t)(t + 2) * kstep;
            const char* a3 = a2 + kstep; const char* b3 = b2 + kstep;
            if (last && has_next) S.a_ready(nxt);
            if constexpr (SP2) {
            PG8_LDB(B0, 0, 0); PG8_LDB(B1, 0, 1); PG8_SCHED; PG8_LDA(At, 0, 0); PG8_STAGE(PG8_SA(1, 1), a1 + hstep, voffA);
            PG8_WAIT_V(8); PG8_WAIT_L(0); PG8_BAR; PG8_MMA(0, 0, At, B0); PG8_MMA(0, 1, At, B1); PG8_BAR; PG8_SCHED;
            PG8_LDA(At, 0, 1); PG8_STAGE(PG8_SB(0, 0), b2, voffB); PG8_STAGE(PG8_SB(0, 1), b2 + hstep, voffB); PG8_STAGE(PG8_SA(0, 0), a2, voffA);
            PG8_WAIT_V(8); PG8_WAIT_L(0); PG8_BAR; PG8_MMA(1, 0, At, B0); PG8_MMA(1, 1, At, B1); PG8_BAR; PG8_SCHED;
            PG8_LDB(B0, 1, 0); PG8_LDB(B1, 1, 1); PG8_SCHED; PG8_LDA(At, 1, 0); PG8_STAGE(PG8_SA(0, 1), a2 + hstep, voffA);
            PG8_WAIT_V(8); PG8_WAIT_L(0); PG8_BAR; PG8_MMA(0, 0, At, B0); PG8_MMA(0, 1, At, B1); PG8_BAR; PG8_SCHED;
            PG8_LDA(At, 1, 1); PG8_STAGE(PG8_SB(1, 0), b3, voffB); PG8_STAGE(PG8_SB(1, 1), b3 + hstep, voffB); PG8_STAGE(PG8_SA(1, 0), a3, voffA);
            PG8_WAIT_V(8); PG8_WAIT_L(0); PG8_BAR; PG8_MMA(1, 0, At, B0); PG8_MMA(1, 1, At, B1); PG8_BAR; PG8_SCHED;
            } else {
            PG8_LDB(B0, 0, 0); PG8_SCHED; PG8_LDA(At, 0, 0); PG8_STAGE(PG8_SA(1, 1), a1 + hstep, voffA);
            PG8_WAIT_L(8); PG8_BAR; PG8_WAIT_L(0); PG8_MMA(0, 0, At, B0); PG8_BAR; PG8_SCHED;
            PG8_LDB(B1, 0, 1); PG8_STAGE(PG8_SB(0, 0), b2, voffB);
            PG8_BAR; PG8_WAIT_L(0); PG8_MMA(0, 1, At, B1); PG8_BAR;
            PG8_LDA(At, 0, 1); PG8_STAGE(PG8_SA(0, 0), a2, voffA);
            PG8_BAR; PG8_WAIT_L(0); PG8_MMA(1, 0, At, B0); PG8_BAR; PG8_SCHED;
            PG8_STAGE(PG8_SB(0, 1), b2 + hstep, voffB);
            PG8_WAIT_V(6); PG8_BAR; PG8_MMA(1, 1, At, B1); PG8_BAR;
            PG8_LDB(B0, 1, 0); PG8_SCHED; PG8_LDA(At, 1, 0); PG8_STAGE(PG8_SA(0, 1), a2 + hstep, voffA);
            PG8_WAIT_L(8); PG8_BAR; PG8_WAIT_L(0); PG8_MMA(0, 0, At, B0); PG8_BAR; PG8_SCHED;
            PG8_LDB(B1, 1, 1); PG8_STAGE(PG8_SB(1, 0), b3, voffB);
            PG8_BAR; PG8_WAIT_L(0); PG8_MMA(0, 1, At, B1); PG8_BAR;
            PG8_LDA(At, 1, 1); PG8_STAGE(PG8_SA(1, 0), a3, voffA);
            PG8_BAR; PG8_WAIT_L(0); PG8_MMA(1, 0, At, B0); PG8_BAR; PG8_SCHED;
            PG8_STAGE(PG8_SB(1, 1), b3 + hstep, voffB);
            PG8_WAIT_V(6); PG8_BAR; PG8_MMA(1, 1, At, B1); PG8_BAR;
            }
        }
        if constexpr (F8) asm volatile("s_nop 15\n\ts_nop 15" ::: "memory");
        if constexpr (ALIGN_EPI) { if (wr == 0) PG8_BAR; }
        if constexpr (!Epi::AFTER_DRAIN) { E(acc, cur, wr, wc, fr, fq); S.done(cur); }
        if (!has_next) break;
#pragma unroll
        for (int a = 0; a < 2; ++a)
#pragma unroll
            for (int b = 0; b < 2; ++b)
#pragma unroll
                for (int m = 0; m < 4; ++m)
#pragma unroll
                    for (int n = 0; n < 2; ++n) acc[a][b][m][n] = (f32x4){0.f, 0.f, 0.f, 0.f};
        cur = nxt; cA = nA; cB = nB; ++ui;
        if constexpr (ALIGN_EPI) { if (wr == 1) PG8_BAR; }
    }
    PG8_WAIT_V(0);
    if constexpr (!ALIGN_EPI) { if (wr == 0) PG8_BAR; }
    PG8_BAR;
    if constexpr (Epi::AFTER_DRAIN) { E.fused(acc, cur, wr, wc, fr, fq, lds, wid, lane); S.done(cur); }
#undef PG8_SA
#undef PG8_SB
#undef PG8_STAGE
#undef PG8_LDA
#undef PG8_LDB
#undef PG8_MMA
#undef PG8_WAIT_V
#undef PG8_WAIT_L
#undef PG8_BAR
#undef PG8_SCHED
}
}

namespace pg8 {
struct EpiZ {
    static constexpr bool PERM = true, AFTER_DRAIN = false;
    bf16_t* Z; float* zs; int ldz; bf16_t* ZH; const float* sa; float sw; bool skip = false;
    __device__ __forceinline__ void operator()(const f32x4 (&acc)[2][2][4][2], const Unit& u, int wr, int wc, int fr, int fq) const {
        if (skip) return;
        asm volatile("" : "+v"(fr), "+v"(fq));
        const int row0 = u.pm * BM + wr * 64 + fr, col0 = u.pn * BM + wc * 32 + 8 * fq;
        float rsv[2][4];
#pragma unroll
        for (int ai = 0; ai < 2; ++ai)
#pragma unroll
            for (int m = 0; m < 4; ++m) rsv[ai][m] = sa ? sa[row0 + ai * HALF + m * 16] : 1.f;
        __builtin_amdgcn_sched_barrier(0);
#pragma unroll
        for (int ai = 0; ai < 2; ++ai)
#pragma unroll
            for (int m = 0; m < 4; ++m) rsv[ai][m] *= sa ? sw : 1.f;
        __builtin_amdgcn_sched_barrier(0);
#pragma unroll
        for (int ai = 0; ai < 2; ++ai)
#pragma unroll
            for (int m = 0; m < 4; ++m) { const int row = row0 + ai * HALF + m * 16; bf16_t* rowp = Z + (size_t)row * ldz + col0; const float rs = rsv[ai][m];
#pragma unroll
                for (int bj = 0; bj < 2; ++bj) { const f32x4 v0 = acc[ai][bj][m][0] * rs, v1 = acc[ai][bj][m][1] * rs;
                    u32x4 w; w.x = cvt_pk_bf16(v0[0], v0[1]); w.y = cvt_pk_bf16(v0[2], v0[3]); w.z = cvt_pk_bf16(v1[0], v1[1]); w.w = cvt_pk_bf16(v1[2], v1[3]);
                    const int col = col0 + bj * HALF, cb = u.pn * BM + bj * HALF;
                    if (cb < 2304 || (cb >= 4352 && cb < 6656)) { const int hidx = cb < 2304 ? (cb >> 7) : 18 + ((cb - 4352) >> 7);
                        epi_store16(ZH + ((size_t)hidx * 8192 + row) * 128 + (col & 127), w); }
                    else epi_store16(rowp + bj * HALF, w);
                    if (col >= 7744 && col < 7808) { float* zp = zs + (size_t)row * 64 + (col - 7744); *(f32x4*)zp = v0; *(f32x4*)(zp + 4) = v1; } } }
    }
};
struct EpiRes {
    static constexpr bool PERM = false, AFTER_DRAIN = false;
    const float* Xin; float* X; const float* gate; int ldc; float s;
    __device__ __forceinline__ void operator()(const f32x4 (&acc)[2][2][4][2], const Unit& u, int wr, int wc, int fr, int fq) const {
        const int row0 = u.pm * BM + wr * 64 + fr, col0 = u.pn * BM + wc * 32 + 4 * fq;
        f32x4 g[4], xa[8];
#pragma unroll
        for (int q = 0; q < 4; ++q) g[q] = *(const f32x4*)(gate + col0 + (q >> 1) * HALF + (q & 1) * 16);
#define ER_OFF(Q, I) ((size_t)(row0 + ((I) >> 2) * HALF + ((I) & 3) * 16) * ldc + col0 + ((Q) >> 1) * HALF + ((Q) & 1) * 16)
#define ER_LOAD(XB, Q) do { _Pragma("unroll") for (int i = 0; i < 8; ++i) XB[i] = *(const f32x4*)(Xin + ER_OFF(Q, i)); } while (0)
#define ER_STORE(XB, Q) do { _Pragma("unroll") for (int i = 0; i < 8; ++i) { const f32x4 x = XB[i] + g[Q] * (acc[i >> 2][(Q) >> 1][i & 3][(Q) & 1] * s); epi_store16(X + ER_OFF(Q, i), __builtin_bit_cast(u32x4, x)); } } while (0)
#pragma unroll
        for (int q = 0; q < 4; ++q) { ER_LOAD(xa, q); __builtin_amdgcn_sched_barrier(0); ER_STORE(xa, q); __builtin_amdgcn_sched_barrier(0); }
#undef ER_OFF
#undef ER_LOAD
#undef ER_STORE
    }
};
struct OneUnit { Unit u;
    __device__ __forceinline__ bool next(int i, Unit& o) const { if (i) return false; o = u; return true; }
    __device__ __forceinline__ void a_ready(const Unit&) const {}
    __device__ __forceinline__ void done(const Unit&) const {} };
}

constexpr int S = 8192, DM = 2048, DEPTH = 2, NIN = 7782, LDZ = 7936, NWAVES = 8;
constexpr int NMOD = 6 * DM;
constexpr int ZC_FQ = 0, ZC_FK = 768, ZC_FV = 1536, ZC_GQ = 2304, ZC_GK = 2816, ZC_GV = 3328, ZC_GR = 3840;
constexpr int ZC_DQ = 4352, ZC_DK = 5120, ZC_DV = 5888, ZC_IQ = 6656, ZC_IK = 7680, ZC_SM = 7744;
constexpr int ZS_FF = 0, ZS_GA = 16, ZS_IW = 32;
__host__ __device__ constexpr int win_src_col(int n) {
    return n < 2304 ? n : n < 4352 ? 2310 + (n - 2304) : n < 6656 ? 4374 + (n - 4352) : n < 7680 ? 6678 + (n - 6656) : n < 7744 ? 7702 + (n - 7680)
         : n < 7750 ? 2304 + (n - 7744) : n < 7760 ? -1 : n < 7776 ? 4358 + (n - 7760) : n < 7792 ? 7766 + (n - 7776) : -1;
}
constexpr size_t MiB = 1u << 20;
constexpr size_t WS_CTL = 0, CTL_ZERO_BYTES = 1 * MiB;
constexpr size_t WS_MOD = 1 * MiB, WS_MODP = 2 * MiB;
constexpr size_t WS_FCUM = 8 * MiB, WS_DECAY = 9 * MiB, WS_KB = 10 * MiB;
constexpr size_t WS_SU = 9 * MiB + 512 * 1024, WS_SV = 9 * MiB + 768 * 1024;
constexpr size_t WS_EIDX = 12 * MiB, WS_GATE = 16 * MiB, WS_MASK = 20 * MiB, WS_ZS = 28 * MiB;
constexpr size_t WS_WIN = 32 * MiB, WS_WO = 94 * MiB, WS_WQ = 110 * MiB;
constexpr size_t WS_X = 128 * MiB, WS_H = 192 * MiB, WS_MIX = 224 * MiB, WS_Z = 256 * MiB;
constexpr size_t WS_UT = 380 * MiB, WS_ST = 412 * MiB, WS_QG = 428 * MiB, WS_INTRA = 436 * MiB;
constexpr size_t WS_SC = 452 * MiB, WS_QP = 452 * MiB;
constexpr size_t WS_UB = 708 * MiB, WS_VB = 772 * MiB, WS_ZH = 836 * MiB, WS_H8 = 912 * MiB, WS_SA = 928 * MiB, WS_WIN8 = 929 * MiB, WS_WO8 = 961 * MiB, WS_MIX8 = 969 * MiB, WS_END = 985 * MiB;
constexpr int CW_BAR = 4096, CW_Q = 16384, CW_FOXN = 36864, CW_WAMAX = 49152, CW_MIXOVF = 49152 + 16;

constexpr int LDS_BYTES = 163840;
constexpr int MISC_OFF = 163840 - 256;
constexpr int LDS_WORK = MISC_OFF;

#define GAS __attribute__((address_space(1)))
#define LAS __attribute__((address_space(3)))
typedef unsigned short bf16_t;
typedef unsigned u32x4 __attribute__((ext_vector_type(4)));
typedef unsigned u32x2 __attribute__((ext_vector_type(2)));
typedef float f32x4 __attribute__((ext_vector_type(4)));
typedef float f32x16 __attribute__((ext_vector_type(16)));
typedef short bf16x8 __attribute__((ext_vector_type(8)));
typedef __bf16 bf16x2v __attribute__((ext_vector_type(2)));
typedef float f32x2 __attribute__((ext_vector_type(2)));

__device__ __forceinline__ unsigned f2bf(float f) { unsigned u = __builtin_bit_cast(unsigned, f); return (u + 0x7fffu + ((u >> 16) & 1u)) >> 16; }
__device__ __forceinline__ unsigned pk2(float lo, float hi) { return f2bf(lo) | (f2bf(hi) << 16); }
__device__ __forceinline__ float bf2f(unsigned b) { return __builtin_bit_cast(float, b << 16); }
__device__ __forceinline__ float bflo(unsigned w) { return __builtin_bit_cast(float, w << 16); }
__device__ __forceinline__ float bfhi(unsigned w) { return __builtin_bit_cast(float, w & 0xffff0000u); }
__device__ __forceinline__ float wave_sum(float v) {
#pragma unroll
    for (int o = 1; o < 64; o <<= 1) v += __shfl_xor(v, o);
    return v;
}
__device__ __forceinline__ float dot2bf(unsigned a, unsigned b, float acc) { return __builtin_amdgcn_fdot2_f32_bf16(__builtin_bit_cast(bf16x2v, a), __builtin_bit_cast(bf16x2v, b), acc, false); }
__device__ __forceinline__ int crow(int r, int hi) { return (r & 3) + 8 * (r >> 2) + 4 * hi; }
template <int KSTEPS> __device__ __forceinline__ void mma32(f32x16& c, const bf16_t* A, int lda, const bf16_t* B, int ldb, int r32, int hi) {
    bf16x8 a[KSTEPS], b[KSTEPS];
#pragma unroll
    for (int ks = 0; ks < KSTEPS; ++ks) { a[ks] = *(const bf16x8*)(A + (size_t)r32 * lda + ks * 16 + hi * 8); b[ks] = *(const bf16x8*)(B + (size_t)r32 * ldb + ks * 16 + hi * 8); }
    __builtin_amdgcn_sched_barrier(0);
#pragma unroll
    for (int ks = 0; ks < KSTEPS; ++ks) c = __builtin_amdgcn_mfma_f32_32x32x16_bf16(a[ks], b[ks], c, 0, 0, 0);
}
__device__ __forceinline__ float logsigmoidf(float x) { return fminf(x, 0.f) - 0.6931471805599453f * __builtin_amdgcn_logf(1.f + __builtin_amdgcn_exp2f(-1.4426950408889634f * fabsf(x))); }
__device__ __forceinline__ float siluf(float x) { return x / (1.f + __expf(-x)); }
__device__ __forceinline__ float gelu_tanh(float x) { const float y = 0.7978845608028654f * (x + 0.044715f * x * x * x); const float t = 1.f - 2.f / (1.f + __expf(2.f * y)); return 0.5f * x * (1.f + t); }

#define XB_TMO      128
#define XB_XCNT(j)  (256  + 64 * (j))
#define XB_XSUB(j)  (1280 + 64 * (j))
#define XB_XGEN(j)  (2304 + 64 * (j))
#define XB_TOP      3328
#define XB_TOPGEN   3392
#define XCD_BAR_WORDS 3456
#define XB_SPIN_CAP (1u << 23)

__device__ __forceinline__ unsigned xb_ld(unsigned* p)              { return __hip_atomic_load(p, __ATOMIC_RELAXED, __HIP_MEMORY_SCOPE_AGENT); }
__device__ __forceinline__ unsigned xb_add(unsigned* p, unsigned v) { return __hip_atomic_fetch_add(p, v, __ATOMIC_RELAXED, __HIP_MEMORY_SCOPE_AGENT); }
__device__ __forceinline__ unsigned xb_xcc_id() { return (unsigned)__builtin_amdgcn_s_getreg((3 << 11) | 20) & 0xFu; }
#define XB_SPIN(cond, bar) do { unsigned _sp = 0; while (cond) { __builtin_amdgcn_s_sleep(1); \
    if ((++_sp & 255u) == 0u) { if (xb_ld(&(bar)[XB_TMO])) break; if (_sp > XB_SPIN_CAP) { atomicAdd(&(bar)[XB_TMO], 1u); break; } } } } while (0)

struct XcdBarrier {
    unsigned* bar; unsigned x;
    volatile LAS unsigned* st;
};

__device__ __forceinline__ XcdBarrier xcd_barrier_post(unsigned* bar, volatile LAS unsigned* st) {
    XcdBarrier b; b.bar = bar; b.x = xb_xcc_id(); b.st = st;
    if (threadIdx.x == 0) (void)xb_add(&bar[XB_XCNT(b.x)], 1u);
    return b;
}
__device__ __forceinline__ void xcd_barrier_complete(unsigned* bar, unsigned x, unsigned& nloc, unsigned& nx) {
    const unsigned G = gridDim.x * gridDim.y * gridDim.z;
    unsigned sum, cnt, mine, sp = 0u;
    for (;;) {
        sum = 0u; cnt = 0u; mine = 0u;
#pragma unroll 1
        for (unsigned j = 0; j < 16; ++j) { const unsigned c = xb_ld(&bar[XB_XCNT(j)]); sum += c; cnt += (c > 0u) ? 1u : 0u; mine = (j == x) ? c : mine; }
        if (sum == G) break;
        __builtin_amdgcn_s_sleep(1);
        if ((++sp & 255u) == 0u) { if (xb_ld(&bar[XB_TMO])) break; if (sp > XB_SPIN_CAP) { atomicAdd(&bar[XB_TMO], 1u); break; } }
    }
    nloc = mine > 0u ? mine : 1u; nx = cnt > 0u ? cnt : 1u;
}

__device__ __forceinline__ void xcd_barrier(const XcdBarrier& b) {
    asm volatile("s_waitcnt vmcnt(0)" ::: "memory");
    __syncthreads();
    if (threadIdx.x == 0) {
        unsigned* bar = b.bar;
        __builtin_amdgcn_s_waitcnt(0);
        unsigned nloc = b.st[0], nx = b.st[1];
        if (nloc == 0u) { xcd_barrier_complete(bar, b.x, nloc, nx); b.st[0] = nloc; b.st[1] = nx; }
        const unsigned old = xb_add(&bar[XB_XSUB(b.x)], 1u);
        const unsigned gen = old / nloc;
        if (old + 1u == (gen + 1u) * nloc) {
            __builtin_amdgcn_fence(__ATOMIC_RELEASE, "agent");
            asm volatile("s_waitcnt vmcnt(0)" ::: "memory");
            const unsigned og = xb_add(&bar[XB_TOP], 1u);
            const unsigned tg = og / nx;
            if (og + 1u == (tg + 1u) * nx) xb_add(&bar[XB_TOPGEN], 1u);
            else XB_SPIN(xb_ld(&bar[XB_TOPGEN]) == tg, bar);
            __builtin_amdgcn_fence(__ATOMIC_ACQUIRE, "agent");
            xb_add(&bar[XB_XGEN(b.x)], 1u);
            asm volatile("s_waitcnt vmcnt(0)" ::: "memory");
        } else {
            XB_SPIN(xb_ld(&bar[XB_XGEN(b.x)]) == gen, bar);
            __builtin_amdgcn_fence(__ATOMIC_ACQUIRE, "agent");
            asm volatile("s_waitcnt vmcnt(0)" ::: "memory");
        }
    }
    __syncthreads();
}

namespace att {
using bf16 = __hip_bfloat16;
typedef short bf16x8 __attribute__((ext_vector_type(8)));
typedef short s16x4 __attribute__((ext_vector_type(4)));
typedef float f32x16 __attribute__((ext_vector_type(16)));
typedef float f32x4 __attribute__((ext_vector_type(4)));
typedef unsigned u32x4 __attribute__((ext_vector_type(4)));
constexpr int D = 128, NW = 8, QBLK = 32, KVBLK = 64, QB = NW * QBLK;
constexpr int LDQ = 128, LDO = 2048;
constexpr float SCALE = 0.08838834764831845f;
constexpr float THR = 8.f;
constexpr int SHM_V = KVBLK * D * 2, SHM_K = KVBLK * D * 2;
constexpr int LDS_CORE = 2 * SHM_V + 2 * SHM_K + NW * 64 * 4;
constexpr int LDS_BIAS = LDS_CORE;
constexpr int LDS_Q = LDS_CORE + 512;
constexpr int LDS_FLAG = LDS_Q + NW * 8192;
constexpr int LDS_TOTAL = LDS_FLAG + 16;

#define KSWZ(row, colB) ((row) * 256 + ((colB) ^ (((row) & 7) << 4)))
#define SBAR() __builtin_amdgcn_sched_barrier(0)
__device__ __forceinline__ int v_st(int k, int c) { const int kk = (k & ~0xC) | ((k & 4) << 1) | ((k & 8) >> 1); return ((kk >> 3) * 4 + (c >> 5)) * 512 + ((kk & 7) * 32 + (c & 31)) * 2; }
__device__ __forceinline__ int v_rd_base(int lane) { return ((lane & 3) << 3) | (((lane >> 2) & 3) << 6) | (((lane >> 4) & 1) << 5) | (((lane >> 5) & 1) << 8); }
constexpr int v_rd_off(int d0, int ks, int half) { return d0 * 512 + ks * 4096 + half * 2048; }
__device__ __forceinline__ int crow(int r, int hi) { return (r & 3) + 8 * (r >> 2) + 4 * hi; }
__device__ __forceinline__ unsigned cvtpk(float lo, float hi) { unsigned r; asm volatile("v_cvt_pk_bf16_f32 %0, %1, %2" : "=v"(r) : "v"(lo), "v"(hi)); return r; }
__device__ __forceinline__ bf16x8 load8(const bf16* p) { return *reinterpret_cast<const bf16x8*>(p); }
__device__ __forceinline__ void mask_causal(f32x16& p0, f32x16& p1, int dq) {
    const float NEG = -__builtin_inff();
#pragma unroll
    for (int r = 0; r < 16; ++r) { const int c = (r & 3) + 8 * (r >> 2); if (dq - c < 0) p0[r] = NEG; if (dq - c - 32 < 0) p1[r] = NEG; }
}
__device__ __forceinline__ float keep_or_neginf(float p, unsigned w, int c) {
    const int m = __builtin_amdgcn_sbfe((int)w, c, 1); unsigned r; const unsigned neg = 0xFF800000u;
    asm("v_bfi_b32 %0, %1, %2, %3" : "=v"(r) : "v"(m), "v"(p), "s"(neg)); return __uint_as_float(r); }
__device__ __forceinline__ void mask_bits(f32x16& p0, f32x16& p1, unsigned wl, unsigned wh) {
    asm volatile("s_nop 15\n\ts_nop 3" : "+v"(p0), "+v"(p1));
#pragma unroll
    for (int r = 0; r < 16; ++r) { const int c = (r & 3) + 8 * (r >> 2); p0[r] = keep_or_neginf(p0[r], wl, c); p1[r] = keep_or_neginf(p1[r], wh, c); }
}
__device__ __forceinline__ void partialSM(f32x16& p0, f32x16& p1, float& m_reg, float& mn, float& alpha) {
    float pmax = p0[0]; for (int r = 1; r < 16; ++r) pmax = fmaxf(pmax, p0[r]); for (int r = 0; r < 16; ++r) pmax = fmaxf(pmax, p1[r]);
    { auto rr = __builtin_amdgcn_permlane32_swap(__float_as_uint(pmax), __float_as_uint(pmax), false, false);
      pmax = fmaxf(__uint_as_float(rr[0]), __uint_as_float(rr[1])); }
    constexpr float C2 = 1.4426950408889634f * SCALE;
    if (__builtin_expect(__all((pmax - m_reg) * SCALE <= THR), 1)) { mn = m_reg; alpha = 1.f; }
    else { mn = fmaxf(m_reg, pmax); alpha = __builtin_amdgcn_exp2f((m_reg - mn) * C2); m_reg = mn; }
    const float mnL = -mn * C2;
    { typedef float f32x2_ __attribute__((ext_vector_type(2))); const f32x2_ c2v = {C2, C2}, mv = {mnL, mnL};
#pragma unroll
      for (int r = 0; r < 8; ++r) { f32x2_ t = {p0[2 * r], p0[2 * r + 1]}; t = __builtin_elementwise_fma(t, c2v, mv); p0[2 * r] = t[0]; p0[2 * r + 1] = t[1];
                                    f32x2_ u = {p1[2 * r], p1[2 * r + 1]}; u = __builtin_elementwise_fma(u, c2v, mv); p1[2 * r] = u[0]; p1[2 * r + 1] = u[1]; } }
    for (int r = 0; r < 16; ++r) p0[r] = __builtin_amdgcn_exp2f(p0[r]);
}
__device__ __forceinline__ void finishSM(f32x16& p0, f32x16& p1, float alpha, float& l_reg, bf16x8& pa0, bf16x8& pa1, bf16x8& pa2, bf16x8& pa3) {
    for (int r = 0; r < 16; ++r) p1[r] = __builtin_amdgcn_exp2f(p1[r]);
    float ps;
    { typedef float f32x2_ __attribute__((ext_vector_type(2))); f32x2_ s2 = {p0[0], p0[1]};
#pragma unroll
      for (int r = 1; r < 8; ++r) s2 += (f32x2_){p0[2 * r], p0[2 * r + 1]};
#pragma unroll
      for (int r = 0; r < 8; ++r) s2 += (f32x2_){p1[2 * r], p1[2 * r + 1]};
      ps = s2[0] + s2[1]; }
    { auto rr = __builtin_amdgcn_permlane32_swap(__float_as_uint(ps), __float_as_uint(ps), false, false);
      ps = __uint_as_float(rr[0]) + __uint_as_float(rr[1]); }
    l_reg = l_reg * alpha + ps;
#define PK4(P, B_, OUT) do { unsigned a0 = cvtpk(P[B_+0], P[B_+1]), a1 = cvtpk(P[B_+2], P[B_+3]);                          \
        unsigned b0 = cvtpk(P[B_+4], P[B_+5]), b1 = cvtpk(P[B_+6], P[B_+7]);                                             \
        auto r0 = __builtin_amdgcn_permlane32_swap(a0, b0, false, false); auto r1 = __builtin_amdgcn_permlane32_swap(a1, b1, false, false); \
        u32x4 w = {r0[0], r1[0], r0[1], r1[1]}; OUT = *reinterpret_cast<bf16x8*>(&w); } while (0)
    PK4(p0, 0, pa0); PK4(p0, 8, pa1); PK4(p1, 0, pa2); PK4(p1, 8, pa3);
#undef PK4
}
template <int KB, bool BIAS>
__device__ __forceinline__ void qkt(f32x16& p0, f32x16& p1, const char* K_lds, int r32, int hi, const char* Q_lds, const float* bp) {
    if constexpr (BIAS) {
#pragma unroll
        for (int g = 0; g < 4; ++g) { const f32x4 b0 = *(const f32x4*)(bp + 8 * g), b1 = *(const f32x4*)(bp + 32 + 8 * g);
#pragma unroll
            for (int e = 0; e < 4; ++e) { p0[4 * g + e] = b0[e]; p1[4 * g + e] = b1[e]; } }
    } else { p0 = f32x16{}; p1 = f32x16{}; }
    const char* kb[4];
#pragma unroll
    for (int dd = 0; dd < 4; ++dd) kb[dd] = K_lds + KB * SHM_K + KSWZ(r32, (dd * 16 + hi * 8) * 2);
#if ATT_QPIN
    bf16x8 X0, X1, XQ, Y0, Y1, YQ, Z0, Z1, ZQ;
#define QK_LD(K0_, K1_, KQ_, d) do { const char* a_ = kb[(d) & 3] + ((d) >> 2) * 128; \
        K0_ = *reinterpret_cast<const bf16x8*>(a_); K1_ = *reinterpret_cast<const bf16x8*>(a_ + 32 * 256); KQ_ = *reinterpret_cast<const bf16x8*>(Q_lds + (d) * 1024); } while (0)
#define QK_MM(K0_, K1_, KQ_) do { p0 = __builtin_amdgcn_mfma_f32_32x32x16_bf16(K0_, KQ_, p0, 0, 0, 0); p1 = __builtin_amdgcn_mfma_f32_32x32x16_bf16(K1_, KQ_, p1, 0, 0, 0); } while (0)
    SBAR(); QK_LD(X0, X1, XQ, 0); QK_LD(Y0, Y1, YQ, 1); SBAR();
    QK_LD(Z0, Z1, ZQ, 2); SBAR(); QK_MM(X0, X1, XQ); SBAR();
    QK_LD(X0, X1, XQ, 3); SBAR(); QK_MM(Y0, Y1, YQ); SBAR();
    QK_LD(Y0, Y1, YQ, 4); SBAR(); QK_MM(Z0, Z1, ZQ); SBAR();
    QK_LD(Z0, Z1, ZQ, 5); SBAR(); QK_MM(X0, X1, XQ); SBAR();
    QK_LD(X0, X1, XQ, 6); SBAR(); QK_MM(Y0, Y1, YQ); SBAR();
    QK_LD(Y0, Y1, YQ, 7); SBAR(); QK_MM(Z0, Z1, ZQ); SBAR();
    QK_MM(X0, X1, XQ); SBAR(); QK_MM(Y0, Y1, YQ); SBAR();
#undef QK_LD
#undef QK_MM
#else
#pragma unroll
    for (int d0 = 0; d0 < 8; ++d0) { const char* a = kb[d0 & 3] + (d0 >> 2) * 128;
        const bf16x8 b0 = *reinterpret_cast<const bf16x8*>(a), b1 = *reinterpret_cast<const bf16x8*>(a + 32 * 256), q = *reinterpret_cast<const bf16x8*>(Q_lds + d0 * 1024);
        p0 = __builtin_amdgcn_mfma_f32_32x32x16_bf16(b0, q, p0, 0, 0, 0); p1 = __builtin_amdgcn_mfma_f32_32x32x16_bf16(b1, q, p1, 0, 0, 0); }
#endif
}
#ifndef ATT_QPIN
#define ATT_QPIN 0
#endif
#ifndef ATT_QREG
#define ATT_QREG 0
#endif
template <int KB, bool BIAS>
__device__ __forceinline__ void qkt_r(f32x16& p0, f32x16& p1, const char* K_lds, int r32, int hi, const bf16x8* qr, const float* bp) {
    if constexpr (BIAS) {
#pragma unroll
        for (int g = 0; g < 4; ++g) { const f32x4 b0 = *(const f32x4*)(bp + 8 * g), b1 = *(const f32x4*)(bp + 32 + 8 * g);
#pragma unroll
            for (int e = 0; e < 4; ++e) { p0[4 * g + e] = b0[e]; p1[4 * g + e] = b1[e]; } }
    } else { p0 = f32x16{}; p1 = f32x16{}; }
    const char* kb[4];
#pragma unroll
    for (int dd = 0; dd < 4; ++dd) kb[dd] = K_lds + KB * SHM_K + KSWZ(r32, (dd * 16 + hi * 8) * 2);
    bf16x8 X0, X1, Y0, Y1;
#define QK_LD(K0_, K1_, d) do { const char* a_ = kb[(d) & 3] + ((d) >> 2) * 128; K0_ = *reinterpret_cast<const bf16x8*>(a_); K1_ = *reinterpret_cast<const bf16x8*>(a_ + 32 * 256); } while (0)
#define QK_MM(K0_, K1_, d) do { p0 = __builtin_amdgcn_mfma_f32_32x32x16_bf16(K0_, qr[d], p0, 0, 0, 0); p1 = __builtin_amdgcn_mfma_f32_32x32x16_bf16(K1_, qr[d], p1, 0, 0, 0); } while (0)
    SBAR(); QK_LD(X0, X1, 0); SBAR();
    QK_LD(Y0, Y1, 1); SBAR(); QK_MM(X0, X1, 0); SBAR();
    QK_LD(X0, X1, 2); SBAR(); QK_MM(Y0, Y1, 1); SBAR();
    QK_LD(Y0, Y1, 3); SBAR(); QK_MM(X0, X1, 2); SBAR();
    QK_LD(X0, X1, 4); SBAR(); QK_MM(Y0, Y1, 3); SBAR();
    QK_LD(Y0, Y1, 5); SBAR(); QK_MM(X0, X1, 4); SBAR();
    QK_LD(X0, X1, 6); SBAR(); QK_MM(Y0, Y1, 5); SBAR();
    QK_LD(Y0, Y1, 7); SBAR(); QK_MM(X0, X1, 6); SBAR();
    QK_MM(Y0, Y1, 7); SBAR();
#undef QK_LD
#undef QK_MM
}
template <int VB>
__device__ __forceinline__ void pv_tile(f32x16* o, int vb0, bf16x8 pa0, bf16x8 pa1, bf16x8 pa2, bf16x8 pa3) {
#define TRRD(dst, off) asm volatile("ds_read_b64_tr_b16 %0, %1 offset:%2" : "=&v"(dst) : "v"(vb0), "i"(off) : "memory")
#define PV_D0(d0) do { s16x4 l0, l1, l2, l3, h0, h1, h2, h3; constexpr int b_ = VB * SHM_V + v_rd_off(d0, 0, 0); \
        TRRD(l0, b_); TRRD(h0, b_ + 2048); TRRD(l1, b_ + 4096); TRRD(h1, b_ + 6144); TRRD(l2, b_ + 8192); TRRD(h2, b_ + 10240); TRRD(l3, b_ + 12288); TRRD(h3, b_ + 14336); \
        asm volatile("s_waitcnt lgkmcnt(0)" ::: "memory"); SBAR();   \
        o[d0] = __builtin_amdgcn_mfma_f32_32x32x16_bf16(pa0, (bf16x8){l0[0], l0[1], l0[2], l0[3], h0[0], h0[1], h0[2], h0[3]}, o[d0], 0, 0, 0);   \
        o[d0] = __builtin_amdgcn_mfma_f32_32x32x16_bf16(pa1, (bf16x8){l1[0], l1[1], l1[2], l1[3], h1[0], h1[1], h1[2], h1[3]}, o[d0], 0, 0, 0);   \
        o[d0] = __builtin_amdgcn_mfma_f32_32x32x16_bf16(pa2, (bf16x8){l2[0], l2[1], l2[2], l2[3], h2[0], h2[1], h2[2], h2[3]}, o[d0], 0, 0, 0);   \
        o[d0] = __builtin_amdgcn_mfma_f32_32x32x16_bf16(pa3, (bf16x8){l3[0], l3[1], l3[2], l3[3], h3[0], h3[1], h3[2], h3[3]}, o[d0], 0, 0, 0); } while (0)
    PV_D0(0); PV_D0(1); PV_D0(2); PV_D0(3);
#undef PV_D0
#undef TRRD
}

struct BlockRef { const bf16* Q; const bf16* K; const bf16* V; bf16* O; unsigned char* O8; unsigned* ovf; int P0; int kind; int j0; int j1; int part; float* pself; const float* pother; unsigned* pcnt; const float* bias; const unsigned long long* mask; };
struct Seam { bf16x8 qr[8]; bf16x8 st_v0, st_v1, st_k0, st_k1; float st_b; };
#define ROW(p, k0, rr) ((p) + (size_t)((k0) + (rr)) * LDQ + sc)
#define VMW() asm volatile("s_waitcnt vmcnt(0)" ::: "memory")
#define VMWN(n) asm volatile("s_waitcnt vmcnt(%0)" :: "i"(n) : "memory")
#define SLOAD_H(Kp, Vp, Bp, k0) do { S.st_v0 = load8(ROW(Vp, k0, sr)); S.st_v1 = load8(ROW(Vp, k0, 32 + sr));              \
                         S.st_k0 = load8(ROW(Kp, k0, sr)); S.st_k1 = load8(ROW(Kp, k0, 32 + sr)); S.st_b = (Bp)[(k0) + (tid & 63)]; } while (0)
#define SWRITE_HK(bf) do { *(bf16x8*)(K_lds + (bf) * SHM_K + kws) = S.st_k0; *(bf16x8*)(K_lds + (bf) * SHM_K + kws + 32 * 256) = S.st_k1; \
                         if (tid < 64) ((float*)(lds + LDS_BIAS))[(bf) * 64 + tid] = S.st_b; } while (0)
#define SWRITE_HV(bf) do { *(bf16x8*)(V_lds + (bf) * SHM_V + vst0) = S.st_v0; *(bf16x8*)(V_lds + (bf) * SHM_V + vst1) = S.st_v1; } while (0)
#define SWRITE_H(bf) do { SWRITE_HV(bf); SWRITE_HK(bf); } while (0)
__device__ __forceinline__ void attn_prime(const BlockRef& cur, char* lds, Seam& S) {
    int tid = threadIdx.x; asm volatile("" : "+v"(tid));
    const int wid = __builtin_amdgcn_readfirstlane(tid >> 6), lane = tid & 63, r32 = lane & 31, hi = lane >> 5;
    const int sr = tid >> 4, sc = (tid & 15) * 8, kws = KSWZ(sr, sc * 2); char* K_lds = lds + 2 * SHM_V;
#pragma unroll
    for (int d0 = 0; d0 < 8; ++d0) S.qr[d0] = load8(cur.Q + (size_t)(wid * QBLK + r32) * LDQ + d0 * 16 + hi * 8);
    SLOAD_H(cur.K, cur.V, cur.bias, cur.j0 * KVBLK); VMW(); SWRITE_HK(0);
    __syncthreads();
}
template <int KIND> __device__ __forceinline__ void attn_block(const BlockRef& cur, const BlockRef& nxt, char* lds, Seam& S) {
    int tid = threadIdx.x; asm volatile("" : "+v"(tid));
    const int wid = __builtin_amdgcn_readfirstlane(tid >> 6), lane = tid & 63, r32 = lane & 31, hi = lane >> 5;
    const int j_lo = cur.j0, NT = cur.j1 - j_lo;
    const int qlo = cur.P0 + wid * QBLK, qm = qlo + r32 - 4 * hi;
    char* V_lds = lds; char* K_lds = lds + 2 * SHM_V;
    float* ws = (float*)(lds + 2 * SHM_V + 2 * SHM_K) + wid * 64; float* li_l = ws, * al_l = ws + 32;
    const float* biasL = (const float*)(lds + LDS_BIAS);
    constexpr int kind = KIND;
    char* Q_lds = lds + LDS_Q + wid * 8192 + lane * 16;
#if !ATT_QREG
#pragma unroll
    for (int d0 = 0; d0 < 8; ++d0) *(bf16x8*)(Q_lds + d0 * 1024) = S.qr[d0];
#define QKT(KB_, P0_, P1_, BP_) qkt<KB_, KIND == 0>(P0_, P1_, K_lds, r32, hi, Q_lds, BP_)
#else
#define QKT(KB_, P0_, P1_, BP_) qkt_r<KB_, KIND == 0>(P0_, P1_, K_lds, r32, hi, S.qr, BP_)
#endif
    const unsigned long long* mrow = cur.mask + (size_t)(qlo + r32) * 128;
    float m_reg = -1e30f, l_reg = 0; f32x16 o[4] = {};
    const int sr = tid >> 4, sc = (tid & 15) * 8, vst0 = v_st(sr, sc), vst1 = v_st(32 + sr, sc), kws = KSWZ(sr, sc * 2);
    const int vb0 = (int)(uintptr_t)V_lds + v_rd_base(lane);
    const bf16* Kh = cur.K; const bf16* Vh = cur.V;
    unsigned long long mwA = 0ull, mwB = 0ull;
#define RESC(a) do { if (__any((a) < 1.f)) { if (hi == 0) al_l[r32] = (a); asm volatile("s_waitcnt lgkmcnt(0)" ::: "memory");              \
                     for (int d_ = 0; d_ < 4; ++d_) for (int r = 0; r < 16; ++r) o[d_][r] *= al_l[crow(r, hi)]; } } while (0)
#define KBASE(t) ((j_lo + (t)) * KVBLK)
#define LOADMW(MW_, t) do { if constexpr (KIND == 1) MW_ = mrow[j_lo + (t)]; } while (0)
#define BIASP(bf) (biasL + (bf) * 64 + 4 * hi)
#define MASKT(P0_, P1_, MW_, t) do { const int kb_ = KBASE(t);                                                                               \
        if constexpr (KIND == 0) { if (kb_ + KVBLK - 1 > qlo) mask_causal(P0_, P1_, qm - kb_); }                                          \
        else { mask_bits(P0_, P1_, (unsigned)MW_ >> (4 * hi), (unsigned)(MW_ >> 32) >> (4 * hi)); } } while (0)
    constexpr int NQL = 8;
#define SEAM_K0() do { VMWN(NQL); SWRITE_HK(0); SBAR(); } while (0)
    f32x16 pA0, pA1, pB0, pB1; float mnA, mnB, alA, alB; bf16x8 pa0, pa1, pa2, pa3;
#if ATT_STATIC_PRIO
    if (wid >= 4) __builtin_amdgcn_s_setprio(1);
#endif
    SWRITE_HV(0); SBAR();
    LOADMW(mwA, 0); LOADMW(mwB, 1);
    if (NT > 1) { SLOAD_H(Kh, Vh, cur.bias, KBASE(1)); }
    SBAR(); QKT(0, pA0, pA1, BIASP(0));
    MASKT(pA0, pA1, mwA, 0); partialSM(pA0, pA1, m_reg, mnA, alA);
    if (NT > 1) { VMW(); SWRITE_H(1); }
    __syncthreads();
#define HALF_STEP(PX0, PX1, mnX, alX, PY0, PY1, alY, MWX, MWN, t, KB, VB, SB) do {                                                      \
        SBAR(); LOADMW(MWN, (t) + 1); QKT(KB, PX0, PX1, BIASP(KB));                                                            \
        finishSM(PY0, PY1, alY, l_reg, pa0, pa1, pa2, pa3); SBAR();                                                           \
        if ((t) + 1 < NT) { SLOAD_H(Kh, Vh, cur.bias, KBASE((t) + 1)); SBAR(); }                                                        \
        pv_tile<VB>(o, vb0, pa0, pa1, pa2, pa3); MASKT(PX0, PX1, MWX, (t)); partialSM(PX0, PX1, m_reg, mnX, alX);                  \
        __syncthreads();                                                                                                      \
        if ((t) + 1 < NT) { VMW(); SWRITE_H(SB); }                                                                            \
        RESC(alX); __syncthreads(); } while (0)
    for (int t = 1; t + 1 < NT; t += 2) {
        HALF_STEP(pB0, pB1, mnB, alB, pA0, pA1, alA, mwB, mwA, t, 1, 0, 0);
        HALF_STEP(pA0, pA1, mnA, alA, pB0, pB1, alB, mwA, mwB, t + 1, 0, 1, 1);
    }
    const bool even = (NT & 1) == 0;
    if (even) { SBAR(); QKT(1, pB0, pB1, BIASP(1)); SBAR(); }
    SLOAD_H(nxt.K, nxt.V, nxt.bias, nxt.j0 * KVBLK); SBAR();
#pragma unroll
    for (int d0 = 0; d0 < 8; ++d0) S.qr[d0] = load8(nxt.Q + (size_t)(wid * QBLK + r32) * LDQ + d0 * 16 + hi * 8);
    SBAR();
    finishSM(pA0, pA1, alA, l_reg, pa0, pa1, pa2, pa3); SBAR();
    pv_tile<0>(o, vb0, pa0, pa1, pa2, pa3);
    if (even) { MASKT(pB0, pB1, mwB, NT - 1); partialSM(pB0, pB1, m_reg, mnB, alB); __syncthreads(); RESC(alB);
        finishSM(pB0, pB1, alB, l_reg, pa0, pa1, pa2, pa3); SBAR(); pv_tile<1>(o, vb0, pa0, pa1, pa2, pa3); }
    SBAR(); SEAM_K0();
#if ATT_STATIC_PRIO
    __builtin_amdgcn_s_setprio(0);
#endif
    bool do_out = true;
    if (cur.part) {
        const __amdgpu_buffer_rsrc_t prs = __builtin_amdgcn_make_buffer_rsrc((void*)cur.pself, 0, (8 * 16 * 256 + 512) * 4, 0x00020000);
        const unsigned pbo = (unsigned)((wid * 16) * 256 + lane * 4) * 4u;
#pragma unroll
        for (int d0 = 0; d0 < 4; ++d0)
#pragma unroll
            for (int g = 0; g < 4; ++g) { const f32x4 v4 = (f32x4){o[d0][4 * g], o[d0][4 * g + 1], o[d0][4 * g + 2], o[d0][4 * g + 3]};
                __builtin_amdgcn_raw_buffer_store_b128(__builtin_bit_cast(u32x4, v4), prs, pbo + (unsigned)((d0 * 4 + g) * 256) * 4u, 0,   16); }
        if (hi == 0) __hip_atomic_store((unsigned long long*)(cur.pself + 8 * 16 * 256 + (wid * 32 + r32) * 2), ((unsigned long long)__float_as_uint(l_reg) << 32) | __float_as_uint(m_reg), __ATOMIC_RELAXED, __HIP_MEMORY_SCOPE_AGENT);
        asm volatile("s_waitcnt vmcnt(0)" ::: "memory");
        __syncthreads();
        if (tid == 0) {
            const unsigned old = __hip_atomic_fetch_add(cur.pcnt, 1u, __ATOMIC_RELAXED, __HIP_MEMORY_SCOPE_AGENT);
            if (old == 1u) { __builtin_amdgcn_fence(__ATOMIC_ACQUIRE, "agent"); asm volatile("s_waitcnt vmcnt(0)" ::: "memory"); }
            *(volatile unsigned*)(lds + LDS_FLAG) = old; }
        __syncthreads();
        do_out = (*(volatile unsigned*)(lds + LDS_FLAG) == 1u);
    }
    if (do_out) {
        if (hi == 0) { li_l[r32] = l_reg; al_l[r32] = m_reg; } asm volatile("s_waitcnt lgkmcnt(0)" ::: "memory");
        constexpr float C2e = 1.4426950408889634f * SCALE;
        if (cur.part) { const float* pmo = cur.pother + 8 * 16 * 256 + (wid * 32) * 2; const float* po = cur.pother + (size_t)(wid * 16) * 256 + lane * 4;
#pragma unroll
            for (int g = 0; g < 4; ++g) { float as_[4], ao_[4], ri_[4];
#pragma unroll
                for (int e = 0; e < 4; ++e) { const int row = crow(4 * g + e, hi); const float m1 = al_l[row], l1 = li_l[row], m2 = pmo[row * 2], l2 = pmo[row * 2 + 1];
                    const float mm = fmaxf(m1, m2); const float a1 = __builtin_amdgcn_exp2f((m1 - mm) * C2e), a2 = __builtin_amdgcn_exp2f((m2 - mm) * C2e);
                    const float ri = __builtin_amdgcn_rcpf(__fadd_rn(__fmul_rn(a1, l1), __fmul_rn(a2, l2))); as_[e] = __fmul_rn(a1, ri); ao_[e] = __fmul_rn(a2, ri); }
#pragma unroll
                for (int d0 = 0; d0 < 4; ++d0) { const f32x4 v = *(const f32x4*)(po + (d0 * 4 + g) * 256);
#pragma unroll
                    for (int e = 0; e < 4; ++e) o[d0][4 * g + e] = __fadd_rn(__fmul_rn(as_[e], o[d0][4 * g + e]), __fmul_rn(ao_[e], v[e])); }
                __builtin_amdgcn_sched_barrier(0); }
        } else {
#pragma unroll
            for (int r = 0; r < 16; ++r) { const float ri = __builtin_amdgcn_rcpf(li_l[crow(r, hi)]);
#pragma unroll
                for (int d0 = 0; d0 < 4; ++d0) o[d0][r] *= ri; }
        }
        int hi_e = hi, r32_e = r32; asm volatile("" : "+v"(hi_e), "+v"(r32_e));
        bf16* Ow = cur.O + (size_t)(wid * QBLK + 4 * hi_e) * LDO + r32_e;
#if WO_FP8
        unsigned char* O8w = cur.O8 + (size_t)(wid * QBLK + 4 * hi_e) * LDO + r32_e; float amx = 0.f;
#endif
#pragma unroll
        for (int r = 0; r < 16; ++r) { const int orow = (r & 3) + 8 * (r >> 2);
#pragma unroll
            for (int d0 = 0; d0 < 4; ++d0) { const float v = o[d0][r];
                const float vn = __shfl_xor(v, 1);
                if ((r32 & 1) == 0) *(unsigned*)(Ow + orow * LDO + d0 * 32) = cvtpk(v, vn);
#if WO_FP8
                amx = fmaxf(amx, fabsf(v));
                const int p8 = __builtin_amdgcn_cvt_pk_fp8_f32(v * MIX_S, vn * MIX_S, 0, false), q8 = __shfl_xor(p8, 2);
                if ((r32 & 3) == 0) *(unsigned*)(O8w + orow * LDO + d0 * 32) = ((unsigned)p8 & 0xffffu) | ((unsigned)q8 << 16);
#endif
            } }
#if WO_FP8
        if (__any(amx * MIX_S > 448.f)) { if (lane == 0) __hip_atomic_fetch_or(cur.ovf, 1u, __ATOMIC_RELAXED, __HIP_MEMORY_SCOPE_AGENT); }
#endif
    }
    __syncthreads();
#undef RESC
#undef KBASE
#undef LOADMW
#undef QKT
#undef BIASP
#undef MASKT
#undef SEAM_K0
#undef HALF_STEP
}
#undef ROW
#undef VMW
#undef VMWN
#undef SLOAD_H
#undef SWRITE_HK
#undef SWRITE_HV
#undef SWRITE_H
#undef KSWZ
#undef SBAR
}

__device__ __forceinline__ int tid_op() { int t = threadIdx.x; asm volatile("" : "+v"(t)); return t; }
#define TID_ tid_op()
#define LANE_ (tid_op() & 63)
struct Frame {
    LAS unsigned char* lds; volatile LAS unsigned* MISC; unsigned* ctl;
    int wave, G, gw, NGW, nconv;
    GAS unsigned char* ws;
};
struct Args { const float* in[18]; float* out; unsigned char* ws; int ph_lo, ph_hi; };
enum { I_X = 0, I_C, I_ADA_W, I_ADA_B, I_NORM1_G, I_NORM2_G, I_FINAL_G, I_W_IN, I_FOX_FBIAS, I_GLA_WA2, I_GLA_BA, I_GLA_NORM_G, I_W_OUT, I_PEER_WQ, I_PEER_K1, I_PEER_K2, I_PEER_U, I_PEER_V };
__device__ __forceinline__ const float* inp(int i) { asm volatile("" : "+s"(i)); const __attribute__((address_space(4))) Args* a = (const __attribute__((address_space(4))) Args*)__builtin_amdgcn_kernarg_segment_ptr(); return (const float*)(const GAS float*)a->in[i]; }
__device__ __forceinline__ float* outp() { int i = 0; asm volatile("" : "+s"(i)); const __attribute__((address_space(4))) Args* a = (const __attribute__((address_space(4))) Args*)__builtin_amdgcn_kernarg_segment_ptr(); return (float*)(GAS float*)(&a->out)[i]; }
__device__ __forceinline__ int deq(Frame& F, int q) {
    __syncthreads();
    if (TID_ == 0) F.MISC[0] = __hip_atomic_fetch_add(F.ctl + CW_Q + 64 * q, 1u, __ATOMIC_RELAXED, __HIP_MEMORY_SCOPE_AGENT);
    __syncthreads();
    return __builtin_amdgcn_readfirstlane((int)F.MISC[0]);
}

template <bool MAPPED> __device__ __forceinline__ void transpose_item(const float* W, int K, int N, bf16_t* WT, int nblk, LAS float* scr, int item, int lane) {
    const int kb = item / nblk, nb = item % nblk, k0 = 64 * kb, n0 = 32 * nb;
    const int nsrc = MAPPED ? win_src_col(n0 + (lane & 31)) : n0 + (lane & 31);
    { float tv[32];
#pragma unroll
      for (int i = 0; i < 32; ++i) { const int kk = 2 * i + (lane >> 5); tv[i] = nsrc >= 0 ? W[(size_t)(k0 + kk) * N + nsrc] : 0.f; }
      __builtin_amdgcn_sched_barrier(0);
#pragma unroll
      for (int i = 0; i < 32; ++i) { const int kk = 2 * i + (lane >> 5); scr[kk * 33 + (lane & 31)] = tv[i]; } }
    asm volatile("s_waitcnt lgkmcnt(0)" ::: "memory");
    const int c = lane & 7;
#pragma unroll
    for (int j = 0; j < 4; ++j) { const int n = (lane >> 3) + 8 * j; const LAS float* s = scr + (8 * c) * 33 + n;
        u32x4 o; o.x = pk2(s[0 * 33], s[1 * 33]); o.y = pk2(s[2 * 33], s[3 * 33]); o.z = pk2(s[4 * 33], s[5 * 33]); o.w = pk2(s[6 * 33], s[7 * 33]);
        *(u32x4*)(WT + (size_t)(n0 + n) * K + k0 + 8 * c) = o; }
    asm volatile("s_waitcnt lgkmcnt(0)" ::: "memory");
}
template <bool MAPPED> __device__ __forceinline__ void transpose_item_f8(const float* W, int K, int N, unsigned char* WT, int nblk, LAS float* scr, int item, int lane, float inv) {
    const int kb = item / nblk, nb = item % nblk, k0 = 64 * kb, n0 = 32 * nb;
    const int nsrc = MAPPED ? win_src_col(n0 + (lane & 31)) : n0 + (lane & 31);
    { float tv[32];
#pragma unroll
      for (int i = 0; i < 32; ++i) { const int kk = 2 * i + (lane >> 5); tv[i] = nsrc >= 0 ? W[(size_t)(k0 + kk) * N + nsrc] : 0.f; }
      __builtin_amdgcn_sched_barrier(0);
#pragma unroll
      for (int i = 0; i < 32; ++i) { const int kk = 2 * i + (lane >> 5); scr[kk * 33 + (lane & 31)] = tv[i]; } }
    asm volatile("s_waitcnt lgkmcnt(0)" ::: "memory");
#pragma unroll
    for (int j = 0; j < 2; ++j) { const int idx = lane + 64 * j, n = idx >> 2, c = idx & 3; const LAS float* sp = scr + (16 * c) * 33 + n; u32x4 o;
#pragma unroll
        for (int q = 0; q < 4; ++q) { int w = __builtin_amdgcn_cvt_pk_fp8_f32(sp[(4 * q) * 33] * inv, sp[(4 * q + 1) * 33] * inv, 0, false); w = __builtin_amdgcn_cvt_pk_fp8_f32(sp[(4 * q + 2) * 33] * inv, sp[(4 * q + 3) * 33] * inv, w, true); o[q] = (unsigned)w; }
        *(u32x4*)(WT + (size_t)(n0 + n) * K + k0 + 16 * c) = o; }
    asm volatile("s_waitcnt lgkmcnt(0)" ::: "memory");
}
__device__ __forceinline__ void convert_flat(const float* src, bf16_t* dst, size_t n, int gw, int NGW, int lane) {
    for (size_t i = (size_t)gw * 512 + lane * 8; i < n; i += (size_t)NGW * 512) {
        const f32x4 a = *(const f32x4*)(src + i), b = *(const f32x4*)(src + i + 4);
        u32x4 o; o.x = pk2(a[0], a[1]); o.y = pk2(a[2], a[3]); o.z = pk2(b[0], b[1]); o.w = pk2(b[2], b[3]);
        *(u32x4*)(dst + i) = o; }
}
__device__ __forceinline__ float clamp6(float x) { return fminf(fmaxf(x, -6.f), 6.f); }
__device__ __forceinline__ void convert_row_fp8(const float* src, unsigned* dst, float* scale, int lane) {
    f32x4 v[8]; float am = 0.f, ss = 0.f;
#pragma unroll
    for (int j = 0; j < 8; ++j) { v[j] = *(const f32x4*)(src + 256 * j + 4 * lane); am = fmaxf(am, fmaxf(fmaxf(fabsf(v[j][0]), fabsf(v[j][1])), fmaxf(fabsf(v[j][2]), fabsf(v[j][3]))));
        ss += (v[j][0] * v[j][0] + v[j][1] * v[j][1]) + (v[j][2] * v[j][2] + v[j][3] * v[j][3]); }
#pragma unroll
    for (int o = 1; o < 64; o <<= 1) { am = fmaxf(am, __shfl_xor(am, o)); ss += __shfl_xor(ss, o); }
    const float s6 = fminf(am, 3.f * sqrtf(ss * (1.f / 2048.f)));
    const float sc = s6 > 0.f ? s6 * (1.f / 6.f) : 1.f, inv = s6 > 0.f ? 6.f / s6 : 1.f;
    u32x4 o;
#pragma unroll
    for (int q = 0; q < 4; ++q) { const f32x4 a = v[2 * q], b = v[2 * q + 1]; unsigned w = 0u;
        w = __builtin_amdgcn_cvt_scalef32_pk_fp4_f32(w, clamp6(a[0] * inv), clamp6(a[1] * inv), 1.0f, 0);
        w = __builtin_amdgcn_cvt_scalef32_pk_fp4_f32(w, clamp6(a[2] * inv), clamp6(a[3] * inv), 1.0f, 1);
        w = __builtin_amdgcn_cvt_scalef32_pk_fp4_f32(w, clamp6(b[0] * inv), clamp6(b[1] * inv), 1.0f, 2);
        w = __builtin_amdgcn_cvt_scalef32_pk_fp4_f32(w, clamp6(b[2] * inv), clamp6(b[3] * inv), 1.0f, 3);
        o[q] = w; }
    *(u32x4*)(dst + 4 * lane) = o;
    if (lane == 0) *scale = sc;
}
constexpr int CONV_ITEMS = 16384 / 64;
__device__ __forceinline__ void conv_row_regs(Frame& F, const f32x4 (&v)[8], int tb, int row, int lane) {
    float am = 0.f, ss = 0.f;
#if PEER_U_INT4
    if (tb == 0) {
#pragma unroll
        for (int j = 0; j < 8; ++j) { am = fmaxf(am, fmaxf(fmaxf(fabsf(v[j][0]), fabsf(v[j][1])), fmaxf(fabsf(v[j][2]), fabsf(v[j][3]))));
            ss += (v[j][0] * v[j][0] + v[j][1] * v[j][1]) + (v[j][2] * v[j][2] + v[j][3] * v[j][3]); }
#pragma unroll
        for (int o = 1; o < 64; o <<= 1) { am = fmaxf(am, __shfl_xor(am, o)); ss += __shfl_xor(ss, o); }
        const float st0 = fminf(am * 0.125f, 0.3352f * sqrtf(ss * (1.f / 2048.f)));
        const float step = st0 > 0.f ? st0 : 1.f, inv = 1.f / step;
        u32x4 o;
#pragma unroll
        for (int d = 0; d < 4; ++d) { unsigned w = 0u;
#pragma unroll
            for (int n = 0; n < 8; ++n) { const float x = v[2 * d + (n >> 2)][n & 3]; const int q = (int)fminf(fmaxf(floorf(x * inv), -8.f), 7.f); w |= ((unsigned)q & 15u) << (4 * n); }
            o[d] = w; }
        *(u32x4*)((unsigned*)(F.ws + WS_UB) + (size_t)row * (DM / 8) + 4 * lane) = o;
        if (lane == 0) ((float*)(F.ws + WS_SU))[row] = step;
        return; }
#endif
#pragma unroll
    for (int j = 0; j < 8; ++j) { am = fmaxf(am, fmaxf(fmaxf(fabsf(v[j][0]), fabsf(v[j][1])), fmaxf(fabsf(v[j][2]), fabsf(v[j][3]))));
        ss += (v[j][0] * v[j][0] + v[j][1] * v[j][1]) + (v[j][2] * v[j][2] + v[j][3] * v[j][3]); }
#pragma unroll
    for (int o = 1; o < 64; o <<= 1) { am = fmaxf(am, __shfl_xor(am, o)); ss += __shfl_xor(ss, o); }
    const float s6 = fminf(am, 3.f * sqrtf(ss * (1.f / 2048.f)));
    const float sc = s6 > 0.f ? s6 * (1.f / 6.f) : 1.f, inv = s6 > 0.f ? 6.f / s6 : 1.f;
    u32x4 o;
#pragma unroll
    for (int q = 0; q < 4; ++q) { const f32x4 a = v[2 * q], b = v[2 * q + 1]; unsigned w = 0u;
        w = __builtin_amdgcn_cvt_scalef32_pk_fp4_f32(w, clamp6(a[0] * inv), clamp6(a[1] * inv), 1.0f, 0);
        w = __builtin_amdgcn_cvt_scalef32_pk_fp4_f32(w, clamp6(a[2] * inv), clamp6(a[3] * inv), 1.0f, 1);
        w = __builtin_amdgcn_cvt_scalef32_pk_fp4_f32(w, clamp6(b[0] * inv), clamp6(b[1] * inv), 1.0f, 2);
        w = __builtin_amdgcn_cvt_scalef32_pk_fp4_f32(w, clamp6(b[2] * inv), clamp6(b[3] * inv), 1.0f, 3);
        o[q] = w; }
    *(u32x4*)((unsigned*)(F.ws + (tb ? WS_VB : WS_UB)) + (size_t)row * (DM / 8) + 4 * lane) = o;
    if (lane == 0) ((float*)(F.ws + (tb ? WS_SV : WS_SU)))[row] = sc;
}
__device__ __forceinline__ void conv_item(Frame& F, int l, int tb, int item) {
    const int lane = LANE_; const int row0 = l * 16384 + item * 64 + F.wave * 8;
    const float* src = (tb ? inp(I_PEER_V) : inp(I_PEER_U)) + (size_t)row0 * DM + 4 * lane;
    f32x4 v[4][8];
#pragma unroll
    for (int r = 0; r < 4; ++r)
#pragma unroll
        for (int j = 0; j < 8; ++j) v[r][j] = __builtin_nontemporal_load((const f32x4*)(src + (size_t)r * DM + 256 * j));
    __builtin_amdgcn_sched_barrier(0);
#pragma unroll
    for (int r = 0; r < 4; ++r) {
        conv_row_regs(F, v[r], tb, row0 + r, lane);
        __builtin_amdgcn_sched_barrier(0);
#pragma unroll
        for (int j = 0; j < 8; ++j) v[r][j] = __builtin_nontemporal_load((const f32x4*)(src + (size_t)(r + 4) * DM + 256 * j));
        __builtin_amdgcn_sched_barrier(0);
    }
#pragma unroll
    for (int r = 0; r < 4; ++r) { conv_row_regs(F, v[r], tb, row0 + 4 + r, lane); __builtin_amdgcn_sched_barrier(0); }
}
constexpr int CONV_SH_CAP = 256 * 7, CONV_SH_UNITS = 4 * 16384 / 4;
__device__ __forceinline__ void conv_shadow(Frame& F, int bidx) {
    const int u = bidx * CONV_SH_CAP + blockIdx.x * 7 + (F.wave - 1);
    if (u >= CONV_SH_UNITS) return;
    const int lane = LANE_; const int l = u >> 13, r = u & 8191, tb = r >> 12, row0 = l * 16384 + (r & 4095) * 4;
    const float* src = (tb ? inp(I_PEER_V) : inp(I_PEER_U)) + (size_t)row0 * DM + 4 * lane;
    f32x4 v[4][8];
#pragma unroll
    for (int rr = 0; rr < 4; ++rr)
#pragma unroll
        for (int j = 0; j < 8; ++j) v[rr][j] = __builtin_nontemporal_load((const f32x4*)(src + (size_t)rr * DM + 256 * j));
    __builtin_amdgcn_sched_barrier(0);
#pragma unroll
    for (int rr = 0; rr < 4; ++rr) { conv_row_regs(F, v[rr], tb, row0 + rr, lane); __builtin_amdgcn_sched_barrier(0); }
}
__device__ __forceinline__ void p0a_prologue(Frame& F) {
    const int gw = F.gw, NGW = F.NGW, lane = LANE_;
    { float* modp = (float*)(F.ws + WS_MODP);
      for (int it = gw; it < 2 * 48 * 32; it += NGW) { const int l = it / (48 * 32), r = it % (48 * 32), eb = r / 32, dc = r % 32;
          f32x4 acc = {0.f, 0.f, 0.f, 0.f}; const float* wp = inp(I_ADA_W) + ((size_t)l * DM + dc * 64) * NMOD + eb * 256 + lane * 4;
#pragma unroll 16
          for (int rr = 0; rr < 64; ++rr) { const float cv = inp(I_C)[dc * 64 + rr]; const float ca = cv / (1.f + __expf(-cv)); acc = acc + ca * *(const f32x4*)(wp + (size_t)rr * NMOD); }
          *(f32x4*)(modp + ((size_t)(l * 32 + dc)) * NMOD + eb * 256 + lane * 4) = acc; } }
    { LAS float* scr = (LAS float*)(F.lds + F.wave * 8448);
      constexpr int I_IN = 32 * (LDZ / 32), I_SQ = 32 * 64;
      for (int it = gw; it < 2 * (I_IN + 2 * I_SQ); it += NGW) { const int l = it / (I_IN + 2 * I_SQ); int r = it % (I_IN + 2 * I_SQ);
          if (r < I_IN) {
#if WIN_FP8
              if (!((WIN_BF16_TILES >> ((r % (LDZ / 32)) >> 3)) & 1u)) continue;
#endif
              transpose_item<true>(inp(I_W_IN) + (size_t)l * DM * NIN, DM, NIN, (bf16_t*)(F.ws + WS_WIN) + (size_t)l * LDZ * DM, LDZ / 32, scr, r, lane);
              continue; } r -= I_IN;
          if (r < I_SQ) { transpose_item<false>(inp(I_W_OUT) + (size_t)l * DM * DM, DM, DM, (bf16_t*)(F.ws + WS_WO) + (size_t)l * DM * DM, 64, scr, r, lane); continue; } r -= I_SQ;
          transpose_item<false>(inp(I_PEER_WQ) + (size_t)l * DM * DM, DM, DM, (bf16_t*)(F.ws + WS_WQ) + (size_t)l * DM * DM, 64, scr, r, lane); } }
#if !CONV_IN_QUEUES
    for (int r = gw; r < 2 * 2 * 16384; r += NGW) {
        const int tb = r >> 15, row = r & 32767;
        convert_row_fp8((tb ? inp(I_PEER_V) : inp(I_PEER_U)) + (size_t)row * DM, (unsigned*)(F.ws + (tb ? WS_VB : WS_UB)) + (size_t)row * (DM / 8), (float*)(F.ws + (tb ? WS_SV : WS_SU)) + row, lane); }
#endif
#if WIN_FP8
#pragma unroll 1
    for (int l = 0; l < DEPTH; ++l) { const float* w = inp(I_W_IN) + (size_t)l * DM * NIN; float am = 0.f;
        for (size_t i = (size_t)gw * 256 + lane * 4; i < (size_t)DM * NIN; i += (size_t)NGW * 256) { const f32x4 a = *(const f32x4*)(w + i); am = fmaxf(am, fmaxf(fmaxf(fabsf(a[0]), fabsf(a[1])), fmaxf(fabsf(a[2]), fabsf(a[3])))); }
#pragma unroll
        for (int o = 1; o < 64; o <<= 1) am = fmaxf(am, __shfl_xor(am, o));
        if (lane == 0) __hip_atomic_fetch_max(F.ctl + CW_WAMAX + l, __float_as_uint(am), __ATOMIC_RELAXED, __HIP_MEMORY_SCOPE_AGENT); }
#endif
#if WO_FP8
#pragma unroll 1
    for (int l = 0; l < DEPTH; ++l) { const float* w = inp(I_W_OUT) + (size_t)l * DM * DM; float am = 0.f;
        for (size_t i = (size_t)gw * 256 + lane * 4; i < (size_t)DM * DM; i += (size_t)NGW * 256) { const f32x4 a = *(const f32x4*)(w + i); am = fmaxf(am, fmaxf(fmaxf(fabsf(a[0]), fabsf(a[1])), fmaxf(fabsf(a[2]), fabsf(a[3])))); }
#pragma unroll
        for (int o = 1; o < 64; o <<= 1) am = fmaxf(am, __shfl_xor(am, o));
        if (lane == 0) __hip_atomic_fetch_max(F.ctl + CW_WAMAX + 2 + l, __float_as_uint(am), __ATOMIC_RELAXED, __HIP_MEMORY_SCOPE_AGENT); }
#endif
    convert_flat(inp(I_PEER_K1), (bf16_t*)(F.ws + WS_KB), (size_t)2 * 8 * 128 * 128, gw, NGW, lane);
    convert_flat(inp(I_PEER_K2), (bf16_t*)(F.ws + WS_KB) + 2 * 8 * 128 * 128, (size_t)2 * 8 * 128 * 128, gw, NGW, lane);
}
__device__ __forceinline__ void p0b_modreduce(Frame& F) {
    const float* modp = (const float*)(F.ws + WS_MODP); float* mod = (float*)(F.ws + WS_MOD);
    for (int e = blockIdx.x * 512 + TID_; e < 2 * NMOD; e += F.G * 512) { const int l = e / NMOD, cidx = e % NMOD; float s = inp(I_ADA_B)[e];
        float p[32];
#pragma unroll
        for (int dc = 0; dc < 32; ++dc) p[dc] = modp[((size_t)(l * 32 + dc)) * NMOD + cidx];
#pragma unroll
        for (int dc = 0; dc < 32; ++dc) s += p[dc];
        mod[e] = s; }
#if WIN_FP8
    { LAS float* scr = (LAS float*)(F.lds + F.wave * 8448); constexpr int I_IN = 32 * (LDZ / 32); const int lane = LANE_;
      for (int it = F.gw; it < 2 * I_IN; it += F.NGW) { const int l = it / I_IN, r = it % I_IN;
          const float am = __uint_as_float(__hip_atomic_load(F.ctl + CW_WAMAX + l, __ATOMIC_RELAXED, __HIP_MEMORY_SCOPE_AGENT)), inv = am > 0.f ? 448.f / am : 1.f;
          transpose_item_f8<true>(inp(I_W_IN) + (size_t)l * DM * NIN, DM, NIN, (unsigned char*)(F.ws + WS_WIN8) + (size_t)l * LDZ * DM, LDZ / 32, scr, r, lane, inv); } }
#endif
#if WO_FP8
    { LAS float* scr = (LAS float*)(F.lds + F.wave * 8448); const int lane = LANE_;
      for (int it = F.gw; it < 2 * 2048; it += F.NGW) { const int l = it >> 11, r = it & 2047;
          const float am = __uint_as_float(__hip_atomic_load(F.ctl + CW_WAMAX + 2 + l, __ATOMIC_RELAXED, __HIP_MEMORY_SCOPE_AGENT)), inv = am > 0.f ? 448.f / am : 1.f;
          transpose_item_f8<false>(inp(I_W_OUT) + (size_t)l * DM * DM, DM, DM, (unsigned char*)(F.ws + WS_WO8) + (size_t)l * DM * DM, 64, scr, r, lane, inv); } }
#endif
}
__device__ __forceinline__ void store_row_f8(const f32x4 (&y)[8], unsigned char* h8, float* sa, int lane) {
    float am = 0.f;
#pragma unroll
    for (int j = 0; j < 8; ++j) am = fmaxf(am, fmaxf(fmaxf(fabsf(y[j][0]), fabsf(y[j][1])), fmaxf(fabsf(y[j][2]), fabsf(y[j][3]))));
#pragma unroll
    for (int o = 1; o < 64; o <<= 1) am = fmaxf(am, __shfl_xor(am, o));
    const float inv = am > 0.f ? 448.f / am : 1.f;
#pragma unroll
    for (int j = 0; j < 8; ++j) { int w = __builtin_amdgcn_cvt_pk_fp8_f32(y[j][0] * inv, y[j][1] * inv, 0, false); w = __builtin_amdgcn_cvt_pk_fp8_f32(y[j][2] * inv, y[j][3] * inv, w, true); *(unsigned*)(h8 + 256 * j + 4 * lane) = (unsigned)w; }
    if (lane == 0) *sa = am > 0.f ? am * (1.f / 448.f) : 1.f;
}
__device__ __forceinline__ void norm_row_f8(const float* xin, const float* g, const float* sc, const float* sh, unsigned char* h8, float* sa, bf16_t* hout, bool wbf, int lane) {
    asm volatile("" : "+v"(lane));
    f32x4 v[8]; float s = 0.f;
#pragma unroll
    for (int j = 0; j < 8; ++j) { v[j] = *(const f32x4*)(xin + 256 * j + 4 * lane); s += (v[j][0] * v[j][0] + v[j][1] * v[j][1]) + (v[j][2] * v[j][2] + v[j][3] * v[j][3]); }
    const float rstd = rsqrtf(wave_sum(s) * (1.f / DM) + 1e-6f);
#pragma unroll
    for (int j = 0; j < 8; ++j) { const int o = 256 * j + 4 * lane; const f32x4 gg = *(const f32x4*)(g + o), a = *(const f32x4*)(sc + o), b = *(const f32x4*)(sh + o); v[j] = v[j] * rstd * gg * (1.f + a) + b;
        if (wbf) *(u32x2*)(hout + o) = (u32x2){pk2(v[j][0], v[j][1]), pk2(v[j][2], v[j][3])}; }
    store_row_f8(v, h8, sa, lane);
}
template <int NR, bool F8> __device__ __forceinline__ void norm_rows(const float* X, int m0, int mstride, const float* g, const float* sc, const float* sh, bf16_t* hout, unsigned char* h8, float* sa, int lane) {
    asm volatile("" : "+v"(lane));
    f32x4 v[NR][8]; float s[NR];
#pragma unroll
    for (int r = 0; r < NR; ++r) { const float* xin = X + (size_t)(m0 + r * mstride) * DM;
#pragma unroll
        for (int j = 0; j < 8; ++j) v[r][j] = *(const f32x4*)(xin + 256 * j + 4 * lane); }
    __builtin_amdgcn_sched_barrier(0);
#pragma unroll
    for (int r = 0; r < NR; ++r) { float t = 0.f;
#pragma unroll
        for (int j = 0; j < 8; ++j) t += (v[r][j][0] * v[r][j][0] + v[r][j][1] * v[r][j][1]) + (v[r][j][2] * v[r][j][2] + v[r][j][3] * v[r][j][3]);
        s[r] = rsqrtf(wave_sum(t) * (1.f / DM) + 1e-6f); }
#pragma unroll
    for (int jh = 0; jh < 4; ++jh) {
        f32x4 gg[2], aa[2], bb[2];
#pragma unroll
        for (int jj = 0; jj < 2; ++jj) { const int o = 256 * (2 * jh + jj) + 4 * lane; gg[jj] = *(const f32x4*)(g + o); aa[jj] = *(const f32x4*)(sc + o); bb[jj] = *(const f32x4*)(sh + o); }
        __builtin_amdgcn_sched_barrier(0);
#pragma unroll
        for (int jj = 0; jj < 2; ++jj) { const int j = 2 * jh + jj, o = 256 * j + 4 * lane;
#pragma unroll
            for (int r = 0; r < NR; ++r) { v[r][j] = v[r][j] * s[r] * gg[jj] * (1.f + aa[jj]) + bb[jj];
                if (!F8) *(u32x2*)(hout + (size_t)(m0 + r * mstride) * DM + o) = (u32x2){pk2(v[r][j][0], v[r][j][1]), pk2(v[r][j][2], v[r][j][3])}; } }
        __builtin_amdgcn_sched_barrier(0); }
    if (F8) {
#pragma unroll
        for (int r = 0; r < NR; ++r) store_row_f8(v[r], h8 + (size_t)(m0 + r * mstride) * DM, sa + (m0 + r * mstride), lane); }
}
__device__ __forceinline__ void norm_row(const float* xin, const float* g, const float* sc, const float* sh, bf16_t* hout, float* xcopy, int lane) {
    asm volatile("" : "+v"(lane));
    f32x4 v[8]; float s = 0.f;
#pragma unroll
    for (int j = 0; j < 8; ++j) { v[j] = *(const f32x4*)(xin + 256 * j + 4 * lane); s += (v[j][0] * v[j][0] + v[j][1] * v[j][1]) + (v[j][2] * v[j][2] + v[j][3] * v[j][3]); }
    const float rstd = rsqrtf(wave_sum(s) * (1.f / DM) + 1e-6f);
#pragma unroll
    for (int j = 0; j < 8; ++j) { const int o = 256 * j + 4 * lane; const f32x4 gg = *(const f32x4*)(g + o), a = *(const f32x4*)(sc + o), b = *(const f32x4*)(sh + o);
        const f32x4 y = v[j] * rstd * gg * (1.f + a) + b;
        u32x2 w; w.x = pk2(y[0], y[1]); w.y = pk2(y[2], y[3]);
#if WT_STORES
        __hip_atomic_store((unsigned long long*)(hout + o), ((unsigned long long)w.y << 32) | w.x, __ATOMIC_RELAXED, __HIP_MEMORY_SCOPE_AGENT);
#else
        *(u32x2*)(hout + o) = w;
#endif
        if (xcopy) *(f32x4*)(xcopy + o) = v[j]; }
}

constexpr int IDX_CH = 8;
struct IdxTab { unsigned short v[320]; };
constexpr IdxTab make_idx_tab() { IdxTab t{}; int n = 0;
    for (int sz = IDX_CH; sz >= 1; --sz) for (int qb = 127; qb >= 0; --qb) { const int ns = qb / 4 + 1;
        for (int c = 0; c * IDX_CH < ns; ++c) { const int s = ns - IDX_CH * c < IDX_CH ? ns - IDX_CH * c : IDX_CH; if (s == sz) t.v[n++] = (unsigned short)(qb * 8 + c); } }
    return t; }
__constant__ const IdxTab IDXTAB = make_idx_tab();
constexpr int N_IDX_ITEMS = 320;

__device__ __forceinline__ float relu_fmac(float a, float c, float w) { float r; asm("v_max_f32_e32 %0, 0, %1" : "=v"(r) : "v"(c)); asm("v_fmac_f32_e32 %0, %1, %2" : "+v"(a) : "v"(r), "v"(w)); return a; }
__device__ __forceinline__ void indexer_item(Frame& F, int item) {
    const int code = __builtin_amdgcn_readfirstlane((int)IDXTAB.v[item]), qb = code >> 3, chunk = code & 7;
    const int nsteps_tot = qb / 4 + 1, s0 = chunk * IDX_CH, s1 = (s0 + IDX_CH < nsteps_tot) ? s0 + IDX_CH : nsteps_tot;
    int tid = TID_; asm volatile("" : "+v"(tid));
    const int lane = tid & 63, wid = F.wave, r32 = lane & 31, hi = lane >> 5, qg = wid >> 2, kg = wid & 3;
    const bf16_t* Z = (const bf16_t*)(F.ws + WS_Z); const float* zs = (const float*)(F.ws + WS_ZS); float* SC = (float*)(F.ws + WS_SC);
    LAS unsigned char* iqL = F.lds;
    __syncthreads();
    { u32x4 sv[16];
#pragma unroll
      for (int it = 0; it < 16; ++it) { const int i = tid + 512 * it, q = i >> 7, ch = i & 127; sv[it] = *(const u32x4*)(Z + (size_t)(qb * 64 + q) * LDZ + ZC_IQ + ch * 8); }
      __builtin_amdgcn_sched_barrier(0);
#pragma unroll
      for (int it = 0; it < 16; ++it) { const int i = tid + 512 * it, q = i >> 7, ch = i & 127; *(LAS u32x4*)(iqL + q * 2048 + ((ch ^ (q & 15)) << 4)) = sv[it]; } }
    const int qrow = 32 * qg + r32, tq = qb * 64 + qrow;
    f32x2 wp[8];
#pragma unroll
    for (int h4 = 0; h4 < 4; ++h4) { const f32x4 t4 = *(const f32x4*)(zs + (size_t)tq * 64 + ZS_IW + 4 * h4);
        wp[2 * h4] = (f32x2){t4[0] * 0.03125f, t4[1] * 0.03125f}; wp[2 * h4 + 1] = (f32x2){t4[2] * 0.03125f, t4[3] * 0.03125f}; }
    __syncthreads();
    const int qx = qrow & 15;
    bf16x8 ikf[2][4];
    { const int kb0 = s0 * 256 + kg * 64;
#pragma unroll
      for (int nb = 0; nb < 2; ++nb)
#pragma unroll
        for (int ks = 0; ks < 4; ++ks) ikf[nb][ks] = *(const bf16x8*)(Z + (size_t)(kb0 + 32 * nb + r32) * LDZ + ZC_IK + ks * 16 + hi * 8); }
#define IDX_Q_(SEL) "v_max_f32_e32 v248, 0, %4\n\tv_max_f32_e32 v249, 0, %5\n\tv_pk_fma_f32 %0, v[248:249], %12, %0 " SEL "\n\t" \
                      "v_max_f32_e32 v248, 0, %6\n\tv_max_f32_e32 v249, 0, %7\n\tv_pk_fma_f32 %1, v[248:249], %12, %1 " SEL "\n\t" \
                      "v_max_f32_e32 v248, 0, %8\n\tv_max_f32_e32 v249, 0, %9\n\tv_pk_fma_f32 %2, v[248:249], %12, %2 " SEL "\n\t" \
                      "v_max_f32_e32 v248, 0, %10\n\tv_max_f32_e32 v249, 0, %11\n\tv_pk_fma_f32 %3, v[248:249], %12, %3 " SEL
#define IDX_QUAD(A, P, B_, WP, ODD) do { if (ODD) asm volatile(IDX_Q_("op_sel:[0,1,0] op_sel_hi:[1,1,1]") \
                : "+v"(A[B_]), "+v"(A[B_ + 1]), "+v"(A[B_ + 2]), "+v"(A[B_ + 3]) \
                : "v"(P[2 * (B_)]), "v"(P[2 * (B_) + 1]), "v"(P[2 * (B_) + 2]), "v"(P[2 * (B_) + 3]), "v"(P[2 * (B_) + 4]), "v"(P[2 * (B_) + 5]), "v"(P[2 * (B_) + 6]), "v"(P[2 * (B_) + 7]), "v"(WP) : "v248", "v249"); \
            else asm volatile(IDX_Q_("op_sel:[0,0,0] op_sel_hi:[1,0,1]") \
                : "+v"(A[B_]), "+v"(A[B_ + 1]), "+v"(A[B_ + 2]), "+v"(A[B_ + 3]) \
                : "v"(P[2 * (B_)]), "v"(P[2 * (B_) + 1]), "v"(P[2 * (B_) + 2]), "v"(P[2 * (B_) + 3]), "v"(P[2 * (B_) + 4]), "v"(P[2 * (B_) + 5]), "v"(P[2 * (B_) + 6]), "v"(P[2 * (B_) + 7]), "v"(WP) : "v248", "v249"); } while (0)
#define IDX_V(A, C, H) do { IDX_QUAD(A, C, 0, wp[(H) >> 1], (H) & 1); IDX_QUAD(A, C, 4, wp[(H) >> 1], (H) & 1); } while (0)
#define IDX_LDQ(H) do { _Pragma("unroll") for (int ks = 0; ks < 4; ++ks) bq[ks] = *(const LAS bf16x8*)(qad[(H) & 1][ks] + ((H) >> 1) * 256); } while (0)
#define IDX_M(C, NB) do { C = f32x16{}; _Pragma("unroll") for (int ks = 0; ks < 4; ++ks) C = __builtin_amdgcn_mfma_f32_32x32x16_bf16(ikf[NB][ks], bq[ks], C, 0, 0, 0); } while (0)
#define IDX_ZERO(A0, A1) do { _Pragma("unroll") for (int r = 0; r < 8; ++r) { asm volatile("v_mov_b64 %0, 0" : "=v"(A0[r])); asm volatile("v_mov_b64 %0, 0" : "=v"(A1[r])); } } while (0)
#define IDX_STEP(A0, A1, N0, N1, ST) do { const int kbase = (ST) * 256 + kg * 64;                                                                            \
        bf16x8 ikn[2][4];                                                       \
        { const int kb2 = (((ST) + 1 < s1) ? (ST) + 1 : (ST)) * 256 + kg * 64;                                                                        \
          _Pragma("unroll") for (int nb = 0; nb < 2; ++nb) _Pragma("unroll") for (int ks = 0; ks < 4; ++ks)                                           \
              ikn[nb][ks] = *(const bf16x8*)(Z + (size_t)(kb2 + 32 * nb + r32) * LDZ + ZC_IK + ks * 16 + hi * 8); }                                     \
        int qoff = qrow * 2048; asm volatile("" : "+v"(qoff));                     \
                           \
        const LAS unsigned char* qad[2][4];                                                                                                          \
        _Pragma("unroll") for (int hb = 0; hb < 2; ++hb) _Pragma("unroll") for (int ks = 0; ks < 4; ++ks)                                             \
            qad[hb][ks] = iqL + qoff + (((hb ^ (qx >> 3)) << 7) | (((ks * 2 + hi) ^ (qx & 7)) << 4));                                                  \
        f32x16 c0, c1; bf16x8 bq[4];                                                                                                                 \
        IDX_LDQ(0); IDX_M(c0, 0); __builtin_amdgcn_sched_barrier(0);                                                                                 \
        _Pragma("unroll") for (int h = 0; h < 16; ++h) {                                                                                             \
            if (h > 0) IDX_V(A1, c1, h - 1);                                                                                                         \
            __builtin_amdgcn_sched_barrier(0);                                                                                                       \
            IDX_M(c1, 1);                                                                                                                            \
            __builtin_amdgcn_sched_barrier(0);                                                                                                       \
            if (h < 15) IDX_LDQ(h + 1);                                                                                                              \
            __builtin_amdgcn_sched_barrier(0);                                                                                                       \
            IDX_V(A0, c0, h);                                                                                                                        \
            __builtin_amdgcn_sched_barrier(0);                                                                                                       \
            if (h < 15) IDX_M(c0, 0);                                                                                                                \
            __builtin_amdgcn_sched_barrier(0);                                                                                                       \
        }                                                                                                                                            \
        asm volatile("s_nop 15\n\ts_nop 15" : "+v"(c1));                         \
        IDX_V(A1, c1, 15);                                                                                                                           \
        __builtin_amdgcn_sched_barrier(0); IDX_ZERO(N0, N1); __builtin_amdgcn_sched_barrier(0);     \
        float* srow = SC + (size_t)tq * S + kbase + 4 * hi;                                                                                          \
        _Pragma("unroll") for (int g = 0; g < 4; ++g) { *(f32x4*)(srow + 8 * g) = (f32x4){A0[2 * g][0], A0[2 * g][1], A0[2 * g + 1][0], A0[2 * g + 1][1]};   \
                                      *(f32x4*)(srow + 32 + 8 * g) = (f32x4){A1[2 * g][0], A1[2 * g][1], A1[2 * g + 1][0], A1[2 * g + 1][1]}; }       \
        _Pragma("unroll") for (int nb = 0; nb < 2; ++nb) _Pragma("unroll") for (int ks = 0; ks < 4; ++ks) ikf[nb][ks] = ikn[nb][ks]; } while (0)
    f32x2 aA0[8], aA1[8], aB0[8], aB1[8];
    IDX_ZERO(aA0, aA1);
#pragma unroll 1
    for (int st = s0; st < s1; st += 2) {
        IDX_STEP(aA0, aA1, aB0, aB1, st);
        if (st + 1 < s1) IDX_STEP(aB0, aB1, aA0, aA1, st + 1); else IDX_ZERO(aA0, aA1);
    }
#undef IDX_STEP
#undef IDX_ZERO
#undef IDX_M
#undef IDX_LDQ
#undef IDX_V
#undef IDX_QUAD
#undef IDX_Q_
}

constexpr int G1_G = 0, G1_QG = 32768, G1_KG = 50176, G1_KDT = 67584, G1_VT = 86016, G1_AL = 104448;
__device__ __forceinline__ void gla_g1_item(Frame& F, int l, int item) {
    const int n = item >> 2, h = item & 3;
    int tid = TID_; asm volatile("" : "+v"(tid));
    const int lane = tid & 63, wid = F.wave, r32 = lane & 31, hi = lane >> 5;
    const bf16_t* Z = (const bf16_t*)(F.ws + WS_Z); const float* zs = (const float*)(F.ws + WS_ZS);
    LAS float* G = (LAS float*)(F.lds + G1_G);
    LAS bf16_t* QG = (LAS bf16_t*)(F.lds + G1_QG); LAS bf16_t* KG = (LAS bf16_t*)(F.lds + G1_KG);
    LAS bf16_t* KDT = (LAS bf16_t*)(F.lds + G1_KDT); LAS bf16_t* VT = (LAS bf16_t*)(F.lds + G1_VT); LAS bf16_t* AL = (LAS bf16_t*)(F.lds + G1_AL);
    const int t = tid >> 3, dg = tid & 7, d0 = dg * 16; const size_t trow = (size_t)n * 64 + t;
    __syncthreads();
    { float ga[16];
#pragma unroll
      for (int r4 = 0; r4 < 4; ++r4) { const f32x4 v = *(const f32x4*)(zs + trow * 64 + ZS_GA + 4 * r4); ga[4 * r4] = v[0]; ga[4 * r4 + 1] = v[1]; ga[4 * r4 + 2] = v[2]; ga[4 * r4 + 3] = v[3]; }
      const float* wa = inp(I_GLA_WA2) + (size_t)l * 16 * 512 + h * 128 + d0; const float* ba = inp(I_GLA_BA) + (size_t)l * 512 + h * 128 + d0;
#pragma unroll
      for (int i4 = 0; i4 < 4; ++i4) { f32x4 x = *(const f32x4*)(ba + 4 * i4);
#pragma unroll
          for (int r = 0; r < 16; ++r) x = x + ga[r] * *(const f32x4*)(wa + (size_t)r * 512 + 4 * i4);
          f32x4 la; la[0] = logsigmoidf(x[0]) * 0.0625f; la[1] = logsigmoidf(x[1]) * 0.0625f; la[2] = logsigmoidf(x[2]) * 0.0625f; la[3] = logsigmoidf(x[3]) * 0.0625f;
          *(LAS f32x4*)(G + t * 128 + d0 + 4 * i4) = la; } }
    __syncthreads();
    if (tid < 128) { float run = 0.f; for (int tt = 0; tt < 64; ++tt) { run += G[tt * 128 + tid]; G[tt * 128 + tid] = run; } }
    __syncthreads();
    { const bf16_t* zr = Z + trow * LDZ + h * 128 + d0;
      unsigned qv[8], kv[8], vv[8];
      { const u32x4 a = *(const u32x4*)(zr + ZC_GQ), b = *(const u32x4*)(zr + ZC_GQ + 8); qv[0] = a.x; qv[1] = a.y; qv[2] = a.z; qv[3] = a.w; qv[4] = b.x; qv[5] = b.y; qv[6] = b.z; qv[7] = b.w; }
      { const u32x4 a = *(const u32x4*)(zr + ZC_GK), b = *(const u32x4*)(zr + ZC_GK + 8); kv[0] = a.x; kv[1] = a.y; kv[2] = a.z; kv[3] = a.w; kv[4] = b.x; kv[5] = b.y; kv[6] = b.z; kv[7] = b.w; }
      { const u32x4 a = *(const u32x4*)(zr + ZC_GV), b = *(const u32x4*)(zr + ZC_GV + 8); vv[0] = a.x; vv[1] = a.y; vv[2] = a.z; vv[3] = a.w; vv[4] = b.x; vv[5] = b.y; vv[6] = b.z; vv[7] = b.w; }
      unsigned qgp[8];
#pragma unroll
      for (int i2 = 0; i2 < 8; ++i2) { float qg2[2];
#pragma unroll
          for (int e = 0; e < 2; ++e) { const int d = d0 + 2 * i2 + e; const float g = G[t * 128 + d], gl = G[63 * 128 + d];
              const float q = e ? bfhi(qv[i2]) : bflo(qv[i2]), k = e ? bfhi(kv[i2]) : bflo(kv[i2]), v = e ? bfhi(vv[i2]) : bflo(vv[i2]);
              const float qg = q * 0.08838834764831845f * __expf(g), kg = k * __expf(-g), kd = k * __expf(gl - g);
              qg2[e] = qg; KG[t * 136 + d] = (bf16_t)f2bf(kg); KDT[d * 72 + t] = (bf16_t)f2bf(kd); VT[d * 72 + t] = (bf16_t)f2bf(v);
              if (t == 63) ((float*)(F.ws + WS_DECAY))[((size_t)n * 4 + h) * 128 + d] = __expf(gl); }
          qgp[i2] = pk2(qg2[0], qg2[1]); *(LAS unsigned*)(QG + t * 136 + d0 + 2 * i2) = qgp[i2]; }
      bf16_t* qgo = (bf16_t*)(F.ws + WS_QG) + trow * 512 + h * 128 + d0;
      *(u32x4*)qgo = (u32x4){qgp[0], qgp[1], qgp[2], qgp[3]}; *(u32x4*)(qgo + 8) = (u32x4){qgp[4], qgp[5], qgp[6], qgp[7]}; }
    __syncthreads();
    if (wid < 4) { const int ti = wid >> 1, tj = wid & 1; f32x16 c = {};
        mma32<8>(c, (const bf16_t*)QG + ti * 32 * 136, 136, (const bf16_t*)KG + tj * 32 * 136, 136, r32, hi);
#pragma unroll
        for (int r = 0; r < 16; ++r) { const int tt = 32 * ti + crow(r, hi), ss = 32 * tj + r32; AL[tt * 72 + ss] = (bf16_t)f2bf(ss <= tt ? c[r] : 0.f); } }
    { float* UT = (float*)(F.ws + WS_UT) + ((size_t)n * 4 + h) * 128 * 128;
#pragma unroll 1
      for (int q = 0; q < 2; ++q) { const int id = wid + 8 * q, dvb = id >> 2, dkb = id & 3; f32x16 c = {};
          mma32<4>(c, (const bf16_t*)VT + dvb * 32 * 72, 72, (const bf16_t*)KDT + dkb * 32 * 72, 72, r32, hi);
          float* up = UT + (size_t)(32 * dvb + 4 * hi) * 128 + 32 * dkb + r32;
#pragma unroll
          for (int r = 0; r < 16; ++r) up[((r & 3) + 8 * (r >> 2)) * 128] = c[r]; } }
    __syncthreads();
    { const int ti = wid >> 2, tj = wid & 3; f32x16 c = {};
      mma32<4>(c, (const bf16_t*)AL + ti * 32 * 72, 72, (const bf16_t*)VT + tj * 32 * 72, 72, r32, hi);
      float* ip = (float*)(F.ws + WS_INTRA) + ((size_t)n * 64 + 32 * ti + 4 * hi) * 512 + h * 128 + 32 * tj + r32;
#pragma unroll
      for (int r = 0; r < 16; ++r) ip[((r & 3) + 8 * (r >> 2)) * 512] = c[r]; }
}
__device__ __forceinline__ void fox_cumsum_item(Frame& F, int l) {
    int tid = TID_; asm volatile("" : "+v"(tid));
    const int lane = tid & 63, wid = F.wave;
    const float* zs = (const float*)(F.ws + WS_ZS) + (size_t)(tid * 16) * 64 + ZS_FF; const float* fbp = inp(I_FOX_FBIAS) + l * 6;
    LAS float* sc = (LAS float*)F.lds;
    __syncthreads();
    float v[16][6];
#pragma unroll
    for (int i = 0; i < 16; ++i) { const f32x4 a = *(const f32x4*)(zs + (size_t)i * 64); const f32x2 b = *(const f32x2*)(zs + (size_t)i * 64 + 4);
        v[i][0] = a[0]; v[i][1] = a[1]; v[i][2] = a[2]; v[i][3] = a[3]; v[i][4] = b[0]; v[i][5] = b[1]; }
    float tot[6], incl[6];
#pragma unroll
    for (int h = 0; h < 6; ++h) { const float fb = fbp[h]; float run = 0.f;
#pragma unroll
        for (int i = 0; i < 16; ++i) { run += logsigmoidf(v[i][h] + fb); v[i][h] = run; }
        tot[h] = run; incl[h] = run; }
#pragma unroll
    for (int o = 1; o < 64; o <<= 1)
#pragma unroll
        for (int h = 0; h < 6; ++h) { const float u = __shfl_up(incl[h], o); if (lane >= o) incl[h] += u; }
    if (lane == 63) {
#pragma unroll
        for (int h = 0; h < 6; ++h) sc[wid * 8 + h] = incl[h]; }
    __syncthreads();
#pragma unroll
    for (int h = 0; h < 6; ++h) { float base = incl[h] - tot[h];
#pragma unroll
        for (int w = 0; w < 7; ++w) base += (w < wid) ? sc[w * 8 + h] : 0.f;
        float* nF = (float*)(F.ws + WS_FCUM) + (size_t)h * S + tid * 16;
#pragma unroll
        for (int i4 = 0; i4 < 4; ++i4) *(f32x4*)(nF + 4 * i4) = (f32x4){-11.313708498984761f * (base + v[4 * i4][h]), -11.313708498984761f * (base + v[4 * i4 + 1][h]),
                                                                       -11.313708498984761f * (base + v[4 * i4 + 2][h]), -11.313708498984761f * (base + v[4 * i4 + 3][h])}; }
    __syncthreads();
}
__device__ __forceinline__ void fox_norm_item(Frame& F, int l, int item) {
    int tid = TID_; asm volatile("" : "+v"(tid));
    const int row = item * 128 + (tid >> 2), part = tid & 3; const bf16_t* zr = (const bf16_t*)(F.ws + WS_ZH) + (size_t)row * 128 + part * 32;
    float qmx = 0.f, kmx = 0.f;
#pragma unroll 2
    for (int hd = 0; hd < 6; ++hd) {
        float sq = 0.f, sk = 0.f;
#pragma unroll
        for (int c = 0; c < 4; ++c) { const u32x4 a = *(const u32x4*)(zr + (size_t)hd * S * 128 + c * 8), b = *(const u32x4*)(zr + (size_t)(6 + hd) * S * 128 + c * 8);
            sq += bflo(a.x) * bflo(a.x) + bfhi(a.x) * bfhi(a.x) + bflo(a.y) * bflo(a.y) + bfhi(a.y) * bfhi(a.y) + bflo(a.z) * bflo(a.z) + bfhi(a.z) * bfhi(a.z) + bflo(a.w) * bflo(a.w) + bfhi(a.w) * bfhi(a.w);
            sk += bflo(b.x) * bflo(b.x) + bfhi(b.x) * bfhi(b.x) + bflo(b.y) * bflo(b.y) + bfhi(b.y) * bfhi(b.y) + bflo(b.z) * bflo(b.z) + bfhi(b.z) * bfhi(b.z) + bflo(b.w) * bflo(b.w) + bfhi(b.w) * bfhi(b.w); }
        sq += __shfl_xor(sq, 1); sq += __shfl_xor(sq, 2); sk += __shfl_xor(sk, 1); sk += __shfl_xor(sk, 2);
        qmx = fmaxf(qmx, sq); kmx = fmaxf(kmx, sk); }
#pragma unroll
    for (int o = 4; o < 64; o <<= 1) { qmx = fmaxf(qmx, __shfl_xor(qmx, o)); kmx = fmaxf(kmx, __shfl_xor(kmx, o)); }
    if ((tid & 63) == 0) { atomicMax(F.ctl + CW_FOXN + 2 * l, __float_as_uint(sqrtf(qmx) * 1.001f)); atomicMax(F.ctl + CW_FOXN + 2 * l + 1, __float_as_uint(sqrtf(kmx) * 1.001f)); }
}

#define SEL_K 256
__device__ __forceinline__ void sel_scan(LAS unsigned* hist, int lane, unsigned k, unsigned& bin, unsigned& rank, unsigned& cnt_at) {
    unsigned s = 0;
#pragma unroll
    for (int q = 0; q < 8; ++q) { const u32x4 v = *(const LAS u32x4*)(hist + 32 * lane + 4 * q); s += (v.x + v.y) + (v.z + v.w); }
    unsigned incl = s;
#pragma unroll
    for (int o = 1; o < 64; o <<= 1) { const unsigned v = __shfl_up(incl, o); if (lane >= o) incl += v; }
    const unsigned total = __shfl(incl, 63);
    const unsigned above = total - incl;
    const bool mine = (above < k) && (above + s >= k);
    const unsigned long long bal = __ballot(mine);
    const int src = bal ? (int)__builtin_ctzll(bal) : 0;
    const unsigned run0 = __shfl(above, src);
    const unsigned cb = hist[32 * src + (lane & 31)];
    unsigned suf = cb;
#pragma unroll
    for (int o = 1; o < 32; o <<= 1) { const unsigned v = __shfl_down(suf, o, 32); if ((lane & 31) + o < 32) suf += v; }
    const unsigned abv = run0 + suf - cb;
    const bool hit = (abv < k) && (abv + cb >= k);
    const unsigned long long hb = __ballot(hit) & 0xFFFFFFFFull;
    const int bsel = hb ? (int)__builtin_ctzll(hb) : 0;
    bin = (unsigned)(32 * src + bsel); rank = k - __shfl(abv, bsel); cnt_at = __shfl(cb, bsel);
}
__device__ __forceinline__ void select_row(const float* srow, int t, unsigned long long* mout, LAS unsigned* hist, int lane) {
    asm volatile("" : "+v"(lane));
    const int n = t + 1;
    if (n <= SEL_K) {
#pragma unroll
        for (int q = 0; q < 2; ++q) { const int wI = lane + 64 * q, lo = 64 * wI;
            const unsigned long long bits = (n >= lo + 64) ? ~0ull : (n > lo ? ((1ull << (n - lo)) - 1ull) : 0ull); mout[wI] = bits; }
        return;
    }
    unsigned key[128];
#pragma unroll
    for (int ch = 0; ch < 4; ++ch) {
        if (ch * 2048 < n) {
#pragma unroll
            for (int j = 32 * ch; j < 32 * ch + 32; ++j) key[j] = __float_as_uint(srow[64 * j + lane]);
        } else {
#pragma unroll
            for (int j = 32 * ch; j < 32 * ch + 32; ++j) key[j] = 0u;
        }
    }
    __builtin_amdgcn_sched_barrier(0);
#pragma unroll
    for (int j = 0; j < 128; ++j) { const int idx = 64 * j + lane; const unsigned u = key[j]; const unsigned kx = u ^ ((unsigned)((int)u >> 31) | 0x80000000u);
        key[j] = idx < n ? kx : 0u; }
    unsigned prefix = 0, k = SEL_K, cnt_at = 0;
#pragma unroll
    for (int pass = 0; pass < 3; ++pass) {
        const int shift = pass == 0 ? 21 : pass == 1 ? 10 : 0; const unsigned dmask = pass == 2 ? 0x3FFu : 0x7FFu;
        const int pshift = pass == 0 ? 31 : pass == 1 ? 21 : 10;
#pragma unroll
        for (int q = 0; q < 8; ++q) *(LAS u32x4*)(hist + 32 * lane + 4 * q) = (u32x4){0u, 0u, 0u, 0u};
        asm volatile("s_waitcnt lgkmcnt(0)" ::: "memory");
        if (pass == 0) {
#pragma unroll
            for (int g8 = 0; g8 < 16; ++g8) {
                if (g8 * 512 < n) {
#pragma unroll
                    for (int j = 8 * g8; j < 8 * g8 + 8; ++j) __hip_atomic_fetch_add(hist + (key[j] >> 21), 1u, __ATOMIC_RELAXED, __HIP_MEMORY_SCOPE_WORKGROUP);
                }
            }
        } else {
#pragma unroll
            for (int ch = 0; ch < 4; ++ch) {
                if (ch * 2048 < n) {
#pragma unroll
                    for (int j = 32 * ch; j < 32 * ch + 32; ++j) { const unsigned kk = key[j];
                        const bool ok = (kk != 0u) && ((kk >> pshift) == prefix);
                        if (ok) __hip_atomic_fetch_add(hist + ((kk >> shift) & dmask), 1u, __ATOMIC_RELAXED, __HIP_MEMORY_SCOPE_WORKGROUP); }
                }
            }
        }
        asm volatile("s_waitcnt lgkmcnt(0)" ::: "memory");
        unsigned bin, rank;
        sel_scan(hist, lane, k, bin, rank, cnt_at);
        prefix = (pass == 0) ? bin : ((prefix << (pass == 1 ? 11 : 10)) | bin);
        k = rank;
    }
    const unsigned T = prefix;
    unsigned need = k;
    int m0l = 0, m0h = 0, m1l = 0, m1h = 0;
    if (need == cnt_at) {
#pragma unroll
        for (int ch = 0; ch < 4; ++ch) {
            if (ch * 2048 < n) {
#pragma unroll
                for (int j = 32 * ch; j < 32 * ch + 32; ++j) { const unsigned long long m = __ballot(key[j] >= T); const int lo_ = __builtin_amdgcn_readfirstlane((int)(unsigned)m), hi_ = __builtin_amdgcn_readfirstlane((int)(unsigned)(m >> 32));
                    if (j < 64) asm volatile("s_nop 4\n\tv_writelane_b32 %0, %2, %4\n\tv_writelane_b32 %1, %3, %4\n\ts_nop 1" : "+v"(m0l), "+v"(m0h) : "s"(lo_), "s"(hi_), "i"(j & 63));
                    else asm volatile("s_nop 4\n\tv_writelane_b32 %0, %2, %4\n\tv_writelane_b32 %1, %3, %4\n\ts_nop 1" : "+v"(m1l), "+v"(m1h) : "s"(lo_), "s"(hi_), "i"(j & 63)); }
            }
        }
    } else {
#pragma unroll 1
        for (int ch = 0; ch < 4; ++ch) {
            if (ch * 2048 < n) {
#pragma unroll
                for (int jj = 0; jj < 32; ++jj) { const unsigned kk = ch == 0 ? key[jj] : ch == 1 ? key[32 + jj] : ch == 2 ? key[64 + jj] : key[96 + jj]; const int j = 32 * ch + jj;
                    const unsigned long long beq = __ballot(kk == T);
                    const unsigned before = __builtin_amdgcn_mbcnt_hi((unsigned)(beq >> 32), __builtin_amdgcn_mbcnt_lo((unsigned)beq, 0u));
                    const unsigned long long m = __ballot((kk > T) || ((kk == T) && (before < need)));
                    const unsigned c = (unsigned)__builtin_popcountll(beq); need -= (c < need ? c : need);
                    if (j < 64) { if (lane == j) { m0l = (int)(unsigned)m; m0h = (int)(unsigned)(m >> 32); } } else { if (lane == j - 64) { m1l = (int)(unsigned)m; m1h = (int)(unsigned)(m >> 32); } } }
            }
        }
    }
    const unsigned long long m0 = ((unsigned long long)(unsigned)m0h << 32) | (unsigned)m0l, m1 = ((unsigned long long)(unsigned)m1h << 32) | (unsigned)m1l;
    mout[lane] = m0; mout[lane + 64] = m1;
}
__device__ __forceinline__ void phase_select(Frame& F, int sel_ctr_base) {
    int tid_ = TID_; asm volatile("" : "+v"(tid_));
    if (tid_ < 256) {
        const float* UT = (const float*)(F.ws + WS_UT); const float* DEC = (const float*)(F.ws + WS_DECAY); bf16_t* ST = (bf16_t*)(F.ws + WS_ST);
        for (int e = blockIdx.x * 256 + tid_; e < 4 * 128 * 128; e += F.G * 256) { const int h = e >> 14, dk = e & 127; const int off = e & 16383;
            float s = 0.f;
#pragma unroll 1
            for (int n0 = 0; n0 < 128; n0 += 32) { float u_[32], d_[32];
#pragma unroll
                for (int i = 0; i < 32; ++i) { const size_t base = ((size_t)(n0 + i) * 4 + h) * 16384 + off; u_[i] = UT[base]; d_[i] = DEC[((size_t)(n0 + i) * 4 + h) * 128 + dk]; }
#pragma unroll
                for (int i = 0; i < 32; ++i) { const size_t base = ((size_t)(n0 + i) * 4 + h) * 16384 + off; ST[base] = (bf16_t)f2bf(s); s = fmaf(d_[i], s, u_[i]); } } }
    }
    const float* SC = (const float*)(F.ws + WS_SC); unsigned long long* MK = (unsigned long long*)(F.ws + WS_MASK);
    LAS unsigned* hist = (LAS unsigned*)(F.lds + F.wave * 8192);
    const int ppb = (S / 2 + F.G - 1) / F.G, pbeg = blockIdx.x * ppb, pend = (pbeg + ppb < S / 2) ? pbeg + ppb : S / 2;
    LAS unsigned* ctr = (LAS unsigned*)&F.MISC[16];
#pragma unroll 1
    for (;;) {
        unsigned got = 0; if (LANE_ == 0) got = __hip_atomic_fetch_add(ctr, 1u, __ATOMIC_RELAXED, __HIP_MEMORY_SCOPE_WORKGROUP);
        const int p = pbeg + (int)(__builtin_amdgcn_readfirstlane((int)got) - sel_ctr_base);
        if (p >= pend) break;
#pragma unroll 1
        for (int sd = 0; sd < 2; ++sd) { const int t = sd ? S - 1 - p : p;
            for (int rr_ = 0; rr_ < REP_SEL; ++rr_) select_row(SC + (size_t)t * S, t, MK + (size_t)t * 128, hist, LANE_); }
    }
}

struct AttTab { unsigned short v[288]; };
constexpr AttTab make_att_tab() { AttTab t{}; int n = 0;
    for (int sz = 64; sz >= 1; --sz) for (int qb = 31; qb >= 0; --qb) { const int nt = 4 * (qb + 1);
        if (qb >= 16) { if (nt / 2 == sz) for (int hd = 0; hd < 6; ++hd) { t.v[n++] = (unsigned short)(qb | hd << 5 | 1 << 8); t.v[n++] = (unsigned short)(qb | hd << 5 | 2 << 8); } }
        else if (nt == sz) for (int hd = 0; hd < 6; ++hd) t.v[n++] = (unsigned short)(qb | hd << 5); }
    return t; }
__constant__ const AttTab ATTTAB = make_att_tab();
constexpr int N_DSA_ITEMS = 288, N_ATT_ITEMS = N_DSA_ITEMS + 192;
constexpr size_t WS_PART = WS_SC + 64 * MiB;
constexpr int PART_FLOATS = 8 * 16 * 256 + 512, CW_SPLIT = 40960;
__device__ __forceinline__ att::BlockRef att_ref(Frame& F, int l_, int item) {
    int kind, qb, hd, mode = 0;
    if (item < N_DSA_ITEMS) { const int c = __builtin_amdgcn_readfirstlane((int)ATTTAB.v[item]); kind = 1; qb = c & 31; hd = (c >> 5) & 7; mode = c >> 8; }
    else { const int j = item - N_DSA_ITEMS; kind = 0; qb = 31 - j / 6; hd = j % 6; }
    const att::bf16* ZH = (const att::bf16*)(F.ws + WS_ZH); att::bf16* MIX = (att::bf16*)(F.ws + WS_MIX);
    att::BlockRef b;
    const int hb = kind ? 18 : 0;
    b.Q = ZH + ((size_t)(hb + hd) * S + qb * 256) * 128; b.K = ZH + (size_t)(hb + 6 + hd) * S * 128; b.V = ZH + (size_t)(hb + 12 + hd) * S * 128;
    b.O = MIX + (size_t)(qb * 256) * DM + (kind ? 1280 : 0) + hd * 128;
    b.O8 = (unsigned char*)(F.ws + WS_MIX8) + (size_t)(qb * 256) * DM + (kind ? 1280 : 0) + hd * 128; b.ovf = F.ctl + CW_MIXOVF + l_;
    b.P0 = qb * 256; b.kind = kind;
    b.bias = (const float*)(F.ws + WS_FCUM) + (size_t)hd * S;
    b.mask = (const unsigned long long*)(F.ws + WS_MASK);
    const int nt = 4 * (qb + 1);
    b.j0 = (mode == 2) ? nt / 2 : 0; b.j1 = (mode == 1) ? nt / 2 : nt; b.part = mode != 0;
    { const int slot = ((qb & 15) * 6 + hd) * 2; float* pbase = (float*)(F.ws + WS_PART);
      b.pself = pbase + (size_t)(slot + (mode == 2 ? 1 : 0)) * PART_FLOATS; b.pother = pbase + (size_t)(slot + (mode == 2 ? 0 : 1)) * PART_FLOATS;
      b.pcnt = F.ctl + CW_SPLIT + l_ * 128 + (qb & 15) * 6 + hd; }
    if (kind == 0) {
        const unsigned* nm = (const unsigned*)(F.ctl + CW_FOXN + 2 * l_);
        const float qm = __uint_as_float(__hip_atomic_load(nm, __ATOMIC_RELAXED, __HIP_MEMORY_SCOPE_AGENT)), km = __uint_as_float(__hip_atomic_load(nm + 1, __ATOMIC_RELAXED, __HIP_MEMORY_SCOPE_AGENT));
        const float thr = (30.f + 2.f * 0.08838834764831845f * qm * km) * 11.313708498984761f;
        const float nf0 = b.bias[qb * 256];
        int cnt = 0;
#pragma unroll
        for (int q2 = 0; q2 < 2; ++q2) { const int j = (TID_ & 63) + 64 * q2; const bool skip = (64 * j + 63 < qb * 256) && (nf0 - b.bias[64 * j + 63] > thr);
            cnt += __builtin_popcountll(__ballot(skip)); }
        b.j0 = __builtin_amdgcn_readfirstlane(cnt);
    }
    b.mask = (const unsigned long long*)(F.ws + WS_MASK);
    return b;
}
__device__ __forceinline__ void gla_g3_item(Frame& F, int l, int item) {
    const int n = item >> 2, h = item & 3;
    int tid = TID_; asm volatile("" : "+v"(tid));
    const int lane = tid & 63, wid = F.wave, r32 = lane & 31, hi = lane >> 5;
    LAS float* OL = (LAS float*)F.lds;
    __syncthreads();
    { const int ti = wid >> 2, tj = wid & 3; f32x16 c = {};
      const bf16_t* A = (const bf16_t*)(F.ws + WS_QG) + ((size_t)n * 64 + ti * 32) * 512 + h * 128;
      const bf16_t* B = (const bf16_t*)(F.ws + WS_ST) + (((size_t)n * 4 + h) * 128 + tj * 32) * 128;
      mma32<8>(c, A, 512, B, 128, r32, hi);
      const float* ip = (const float*)(F.ws + WS_INTRA) + ((size_t)n * 64 + 32 * ti + 4 * hi) * 512 + h * 128 + 32 * tj + r32;
      float ipv[16];
#pragma unroll
      for (int r = 0; r < 16; ++r) ipv[r] = ip[((r & 3) + 8 * (r >> 2)) * 512];
      __builtin_amdgcn_sched_barrier(0);
#pragma unroll
      for (int r = 0; r < 16; ++r) { const int rr = (r & 3) + 8 * (r >> 2); OL[(32 * ti + 4 * hi + rr) * 132 + 32 * tj + r32] = c[r] + ipv[r]; } }
    __syncthreads();
    { const int t = tid >> 3, e0 = (tid & 7) * 16; const size_t trow = (size_t)n * 64 + t;
      const bf16_t* gr_ = (const bf16_t*)(F.ws + WS_Z) + trow * LDZ + ZC_GR + h * 128 + e0; const float* gn_ = inp(I_GLA_NORM_G) + (size_t)l * 128 + e0;
      const u32x4 ga_pre = *(const u32x4*)gr_, gb_pre = *(const u32x4*)(gr_ + 8);
      const f32x4 gn0 = *(const f32x4*)gn_, gn1 = *(const f32x4*)(gn_ + 4), gn2 = *(const f32x4*)(gn_ + 8), gn3 = *(const f32x4*)(gn_ + 12);
      float o[16]; float ss = 0.f;
#pragma unroll
      for (int i4 = 0; i4 < 4; ++i4) { const f32x4 v = *(const LAS f32x4*)(OL + t * 132 + e0 + 4 * i4); o[4 * i4] = v[0]; o[4 * i4 + 1] = v[1]; o[4 * i4 + 2] = v[2]; o[4 * i4 + 3] = v[3];
          ss += (v[0] * v[0] + v[1] * v[1]) + (v[2] * v[2] + v[3] * v[3]); }
      ss += __shfl_xor(ss, 1); ss += __shfl_xor(ss, 2); ss += __shfl_xor(ss, 4);
      const float rstd = rsqrtf(ss * (1.f / 128.f) + 1e-6f);
      const u32x4 ga = ga_pre, gb = gb_pre; const unsigned gw_[8] = {ga.x, ga.y, ga.z, ga.w, gb.x, gb.y, gb.z, gb.w};
      const float gn[16] = {gn0[0], gn0[1], gn0[2], gn0[3], gn1[0], gn1[1], gn1[2], gn1[3], gn2[0], gn2[1], gn2[2], gn2[3], gn3[0], gn3[1], gn3[2], gn3[3]};
      unsigned pk[8];
#pragma unroll
      for (int i2 = 0; i2 < 8; ++i2) { const float y0 = o[2 * i2] * rstd * gn[2 * i2] * siluf(bflo(gw_[i2])), y1 = o[2 * i2 + 1] * rstd * gn[2 * i2 + 1] * siluf(bfhi(gw_[i2])); pk[i2] = pk2(y0, y1); }
      bf16_t* mo = (bf16_t*)(F.ws + WS_MIX) + trow * DM + 768 + h * 128 + e0;
      *(u32x4*)mo = (u32x4){pk[0], pk[1], pk[2], pk[3]}; *(u32x4*)(mo + 8) = (u32x4){pk[4], pk[5], pk[6], pk[7]};
#if WO_FP8
      { u32x4 q8; float amx = 0.f;
#pragma unroll
        for (int i4 = 0; i4 < 4; ++i4) { const float a0 = bflo(pk[2 * i4]), a1 = bfhi(pk[2 * i4]), a2 = bflo(pk[2 * i4 + 1]), a3 = bfhi(pk[2 * i4 + 1]);
            amx = fmaxf(amx, fmaxf(fmaxf(fabsf(a0), fabsf(a1)), fmaxf(fabsf(a2), fabsf(a3))));
            int w = __builtin_amdgcn_cvt_pk_fp8_f32(a0 * MIX_S, a1 * MIX_S, 0, false); w = __builtin_amdgcn_cvt_pk_fp8_f32(a2 * MIX_S, a3 * MIX_S, w, true); q8[i4] = (unsigned)w; }
        *(u32x4*)((unsigned char*)(F.ws + WS_MIX8) + trow * DM + 768 + h * 128 + e0) = q8;
        if (__any(amx * MIX_S > 448.f)) { if ((tid & 63) == 0) __hip_atomic_fetch_or(F.ctl + CW_MIXOVF + l, 1u, __ATOMIC_RELAXED, __HIP_MEMORY_SCOPE_AGENT); } }
#endif
    }
}
template <int KIND> __device__ __forceinline__ void attn_run(Frame& F, int l_, int q, int& cur_i, int end) {
    if (cur_i >= end) return;
    att::Seam Sm; att::BlockRef cur = att_ref(F, l_, cur_i);
    att::attn_prime(cur, (char*)F.lds, Sm);
#pragma unroll 1
    for (;;) {
        const int nxt_i = deq(F, q); const bool has = nxt_i < end;
        const att::BlockRef nxt = has ? att_ref(F, l_, nxt_i) : cur;
        att::attn_block<KIND>(cur, nxt, (char*)F.lds, Sm);
#if REP_FOX > 1
        if (KIND == 0) for (int rr_ = 1; rr_ < REP_FOX; ++rr_) { att::attn_prime(cur, (char*)F.lds, Sm); att::attn_block<KIND>(cur, nxt, (char*)F.lds, Sm); }
#endif
        cur_i = nxt_i;
        if (!has) break;
        cur = nxt;
    }
}
__device__ __forceinline__ void phase_attn(Frame& F, int l, int q) {
    int cur_i = deq(F, q);
    attn_run<1>(F, l, q, cur_i, N_DSA_ITEMS);
    attn_run<0>(F, l, q, cur_i, N_ATT_ITEMS);
#pragma unroll 1
    while (cur_i < N_ATT_ITEMS + 512) { for (int rr_ = 0; rr_ < REP_G3; ++rr_) gla_g3_item(F, l, cur_i - N_ATT_ITEMS); cur_i = deq(F, q); }
#if CONV_IN_QUEUES
#pragma unroll 1
    while (cur_i < N_ATT_ITEMS + 512 + F.nconv) { conv_item(F, l, 1, cur_i - (N_ATT_ITEMS + 512)); cur_i = deq(F, q); }
#endif
}

__device__ __forceinline__ void ce_d(unsigned& a, unsigned& b) { const unsigned mx = a > b ? a : b, mn = a > b ? b : a; a = mx; b = mn; }
template <int N, int OFF> __device__ __forceinline__ void sort16_desc(unsigned (&a)[N]) {
#pragma unroll
    for (int k = 2; k <= 16; k <<= 1)
#pragma unroll
        for (int j = k >> 1; j > 0; j >>= 1)
#pragma unroll
            for (int i = 0; i < 16; ++i) { const int l = i ^ j; if (l > i) { if ((i & k) == 0) ce_d(a[OFF + i], a[OFF + l]); else ce_d(a[OFF + l], a[OFF + i]); } }
}
template <int N, int OA, int OB> __device__ __forceinline__ void merge16_desc(unsigned (&a)[N]) {
#pragma unroll
    for (int i = 0; i < 16; ++i) { const unsigned x = a[OA + i], y = a[OB + 15 - i]; a[OA + i] = x > y ? x : y; }
#pragma unroll
    for (int j = 8; j > 0; j >>= 1)
#pragma unroll
        for (int i = 0; i < 16; ++i) { const int l = i ^ j; if (l > i) ce_d(a[OA + i], a[OA + l]); }
}
__device__ __forceinline__ void ce2_d(float& va, unsigned& pa, float& vb, unsigned& pb) {
    const bool sw = vb > va; const float nva = sw ? vb : va, nvb = sw ? va : vb; const unsigned npa = sw ? pb : pa, npb = sw ? pa : pb; va = nva; vb = nvb; pa = npa; pb = npb; }
template <int OFF> __device__ __forceinline__ void sort16v_desc(float (&v)[32], unsigned (&p)[32]) {
#pragma unroll
    for (int k = 2; k <= 16; k <<= 1)
#pragma unroll
        for (int j = k >> 1; j > 0; j >>= 1)
#pragma unroll
            for (int i = 0; i < 16; ++i) { const int l = i ^ j; if (l > i) { if ((i & k) == 0) ce2_d(v[OFF + i], p[OFF + i], v[OFF + l], p[OFF + l]); else ce2_d(v[OFF + l], p[OFF + l], v[OFF + i], p[OFF + i]); } }
}
__device__ __forceinline__ void merge16v_desc(float (&v)[32], unsigned (&p)[32]) {
#pragma unroll
    for (int i = 0; i < 16; ++i) { const bool sw = v[31 - i] > v[i]; v[i] = sw ? v[31 - i] : v[i]; p[i] = sw ? p[31 - i] : p[i]; }
#pragma unroll
    for (int j = 8; j > 0; j >>= 1)
#pragma unroll
        for (int i = 0; i < 16; ++i) { const int l = i ^ j; if (l > i) ce2_d(v[i], p[i], v[l], p[l]); }
}
__device__ __forceinline__ void peer_half_top16(const bf16_t* kb, const bf16_t* qp, int r32, int hi, unsigned (&top)[16]) {
    unsigned key[64];
    bf16x8 qf[8];
#pragma unroll
    for (int ks = 0; ks < 8; ++ks) qf[ks] = *(const bf16x8*)(qp + (size_t)r32 * 2048 + ks * 16 + hi * 8);
#pragma unroll
    for (int nb = 0; nb < 4; ++nb) { f32x16 c = {};
        __builtin_amdgcn_sched_barrier(0);
        bf16x8 ka[8];
#pragma unroll
        for (int ks = 0; ks < 8; ++ks) ka[ks] = *(const bf16x8*)(kb + (size_t)(nb * 32 + r32) * 128 + ks * 16 + hi * 8);
        __builtin_amdgcn_sched_barrier(0);
#pragma unroll
        for (int ks = 0; ks < 8; ++ks) c = __builtin_amdgcn_mfma_f32_32x32x16_bf16(ka[ks], qf[ks], c, 0, 0, 0);
#pragma unroll
        for (int r = 0; r < 16; ++r) { const unsigned u = __float_as_uint(c[r]); const unsigned sk = u ^ ((u >> 31) ? 0xFFFFFFFFu : 0x80000000u);
            key[nb * 16 + r] = (sk & ~127u) | (unsigned)(127 - (32 * nb + crow(r, hi))); } }
    __builtin_amdgcn_sched_barrier(0);
    sort16_desc<64, 0>(key); sort16_desc<64, 16>(key); sort16_desc<64, 32>(key); sort16_desc<64, 48>(key);
    merge16_desc<64, 0, 16>(key); merge16_desc<64, 32, 48>(key); merge16_desc<64, 0, 32>(key);
#pragma unroll
    for (int i = 0; i < 16; ++i) key[16 + i] = (unsigned)__shfl_xor((int)key[i], 32);
    merge16_desc<64, 0, 16>(key);
#pragma unroll
    for (int i = 0; i < 16; ++i) top[i] = key[i];
}
__device__ __forceinline__ float unkey(unsigned k) { const unsigned u = k & ~127u; return __uint_as_float((u & 0x80000000u) ? (u ^ 0x80000000u) : ~u); }
__device__ __forceinline__ void peer_topk_item(Frame& F, int l, int item) {
    int lane = LANE_; asm volatile("" : "+v"(lane));
    const int tb = item >> 3, h = item & 7, r32 = lane & 31, hi = lane >> 5;
    const bf16_t* QP = (const bf16_t*)(F.ws + WS_QP) + (size_t)(tb * 32) * DM + h * 256;
    const bf16_t* K1 = (const bf16_t*)(F.ws + WS_KB) + ((size_t)l * 8 + h) * 128 * 128; const bf16_t* K2 = K1 + 2 * 8 * 128 * 128;
    unsigned t1[16], t2[16];
    peer_half_top16(K1, QP, r32, hi, t1);
    __builtin_amdgcn_sched_barrier(0);
    peer_half_top16(K2, QP + 128, r32, hi, t2);
    __builtin_amdgcn_sched_barrier(0);
    float v1[16], v2[16]; unsigned i1[16], i2[16];
#pragma unroll
    for (int i = 0; i < 16; ++i) { v1[i] = unkey(t1[i]); v2[i] = unkey(t2[i]); i1[i] = 127u - (t1[i] & 127u); i2[i] = 127u - (t2[i] & 127u); }
    float cv[32]; unsigned cp[32];
    { const float va_ = v1[0] + v2[0], vb_ = v1[0] + v2[1]; const unsigned pa_ = (i1[0] << 7) | i2[0], pb_ = (i1[0] << 7) | i2[1]; cv[0] = hi ? vb_ : va_; cp[0] = hi ? pb_ : pa_; }
    { const float va_ = v1[0] + v2[2], vb_ = v1[0] + v2[3]; const unsigned pa_ = (i1[0] << 7) | i2[2], pb_ = (i1[0] << 7) | i2[3]; cv[1] = hi ? vb_ : va_; cp[1] = hi ? pb_ : pa_; }
    { const float va_ = v1[0] + v2[4], vb_ = v1[0] + v2[5]; const unsigned pa_ = (i1[0] << 7) | i2[4], pb_ = (i1[0] << 7) | i2[5]; cv[2] = hi ? vb_ : va_; cp[2] = hi ? pb_ : pa_; }
    { const float va_ = v1[0] + v2[6], vb_ = v1[0] + v2[7]; const unsigned pa_ = (i1[0] << 7) | i2[6], pb_ = (i1[0] << 7) | i2[7]; cv[3] = hi ? vb_ : va_; cp[3] = hi ? pb_ : pa_; }
    { const float va_ = v1[0] + v2[8], vb_ = v1[0] + v2[9]; const unsigned pa_ = (i1[0] << 7) | i2[8], pb_ = (i1[0] << 7) | i2[9]; cv[4] = hi ? vb_ : va_; cp[4] = hi ? pb_ : pa_; }
    { const float va_ = v1[0] + v2[10], vb_ = v1[0] + v2[11]; const unsigned pa_ = (i1[0] << 7) | i2[10], pb_ = (i1[0] << 7) | i2[11]; cv[5] = hi ? vb_ : va_; cp[5] = hi ? pb_ : pa_; }
    { const float va_ = v1[0] + v2[12], vb_ = v1[0] + v2[13]; const unsigned pa_ = (i1[0] << 7) | i2[12], pb_ = (i1[0] << 7) | i2[13]; cv[6] = hi ? vb_ : va_; cp[6] = hi ? pb_ : pa_; }
    { const float va_ = v1[0] + v2[14], vb_ = v1[0] + v2[15]; const unsigned pa_ = (i1[0] << 7) | i2[14], pb_ = (i1[0] << 7) | i2[15]; cv[7] = hi ? vb_ : va_; cp[7] = hi ? pb_ : pa_; }
    { const float va_ = v1[1] + v2[0], vb_ = v1[1] + v2[1]; const unsigned pa_ = (i1[1] << 7) | i2[0], pb_ = (i1[1] << 7) | i2[1]; cv[8] = hi ? vb_ : va_; cp[8] = hi ? pb_ : pa_; }
    { const float va_ = v1[1] + v2[2], vb_ = v1[1] + v2[3]; const unsigned pa_ = (i1[1] << 7) | i2[2], pb_ = (i1[1] << 7) | i2[3]; cv[9] = hi ? vb_ : va_; cp[9] = hi ? pb_ : pa_; }
    { const float va_ = v1[1] + v2[4], vb_ = v1[1] + v2[5]; const unsigned pa_ = (i1[1] << 7) | i2[4], pb_ = (i1[1] << 7) | i2[5]; cv[10] = hi ? vb_ : va_; cp[10] = hi ? pb_ : pa_; }
    { const float va_ = v1[1] + v2[6], vb_ = v1[1] + v2[7]; const unsigned pa_ = (i1[1] << 7) | i2[6], pb_ = (i1[1] << 7) | i2[7]; cv[11] = hi ? vb_ : va_; cp[11] = hi ? pb_ : pa_; }
    { const float va_ = v1[2] + v2[0], vb_ = v1[2] + v2[1]; const unsigned pa_ = (i1[2] << 7) | i2[0], pb_ = (i1[2] << 7) | i2[1]; cv[12] = hi ? vb_ : va_; cp[12] = hi ? pb_ : pa_; }
    { const float va_ = v1[2] + v2[2], vb_ = v1[2] + v2[3]; const unsigned pa_ = (i1[2] << 7) | i2[2], pb_ = (i1[2] << 7) | i2[3]; cv[13] = hi ? vb_ : va_; cp[13] = hi ? pb_ : pa_; }
    { const float va_ = v1[2] + v2[4], vb_ = v1[3] + v2[0]; const unsigned pa_ = (i1[2] << 7) | i2[4], pb_ = (i1[3] << 7) | i2[0]; cv[14] = hi ? vb_ : va_; cp[14] = hi ? pb_ : pa_; }
    { const float va_ = v1[3] + v2[1], vb_ = v1[3] + v2[2]; const unsigned pa_ = (i1[3] << 7) | i2[1], pb_ = (i1[3] << 7) | i2[2]; cv[15] = hi ? vb_ : va_; cp[15] = hi ? pb_ : pa_; }
    { const float va_ = v1[3] + v2[3], vb_ = v1[4] + v2[0]; const unsigned pa_ = (i1[3] << 7) | i2[3], pb_ = (i1[4] << 7) | i2[0]; cv[16] = hi ? vb_ : va_; cp[16] = hi ? pb_ : pa_; }
    { const float va_ = v1[4] + v2[1], vb_ = v1[4] + v2[2]; const unsigned pa_ = (i1[4] << 7) | i2[1], pb_ = (i1[4] << 7) | i2[2]; cv[17] = hi ? vb_ : va_; cp[17] = hi ? pb_ : pa_; }
    { const float va_ = v1[5] + v2[0], vb_ = v1[5] + v2[1]; const unsigned pa_ = (i1[5] << 7) | i2[0], pb_ = (i1[5] << 7) | i2[1]; cv[18] = hi ? vb_ : va_; cp[18] = hi ? pb_ : pa_; }
    { const float va_ = v1[6] + v2[0], vb_ = v1[6] + v2[1]; const unsigned pa_ = (i1[6] << 7) | i2[0], pb_ = (i1[6] << 7) | i2[1]; cv[19] = hi ? vb_ : va_; cp[19] = hi ? pb_ : pa_; }
    { const float va_ = v1[7] + v2[0], vb_ = v1[7] + v2[1]; const unsigned pa_ = (i1[7] << 7) | i2[0], pb_ = (i1[7] << 7) | i2[1]; cv[20] = hi ? vb_ : va_; cp[20] = hi ? pb_ : pa_; }
    { const float va_ = v1[8] + v2[0], vb_ = v1[9] + v2[0]; const unsigned pa_ = (i1[8] << 7) | i2[0], pb_ = (i1[9] << 7) | i2[0]; cv[21] = hi ? vb_ : va_; cp[21] = hi ? pb_ : pa_; }
    { const float va_ = v1[10] + v2[0], vb_ = v1[11] + v2[0]; const unsigned pa_ = (i1[10] << 7) | i2[0], pb_ = (i1[11] << 7) | i2[0]; cv[22] = hi ? vb_ : va_; cp[22] = hi ? pb_ : pa_; }
    { const float va_ = v1[12] + v2[0], vb_ = v1[13] + v2[0]; const unsigned pa_ = (i1[12] << 7) | i2[0], pb_ = (i1[13] << 7) | i2[0]; cv[23] = hi ? vb_ : va_; cp[23] = hi ? pb_ : pa_; }
    { const float va_ = v1[14] + v2[0], vb_ = v1[15] + v2[0]; const unsigned pa_ = (i1[14] << 7) | i2[0], pb_ = (i1[15] << 7) | i2[0]; cv[24] = hi ? vb_ : va_; cp[24] = hi ? pb_ : pa_; }
#pragma unroll
    for (int s = 25; s < 32; ++s) { cv[s] = -__builtin_inff(); cp[s] = 0u; }
    __builtin_amdgcn_sched_barrier(0);
    sort16v_desc<0>(cv, cp); sort16v_desc<16>(cv, cp); merge16v_desc(cv, cp);
#pragma unroll
    for (int i = 0; i < 16; ++i) { cv[16 + i] = __shfl_xor(cv[i], 32); cp[16 + i] = (unsigned)__shfl_xor((int)cp[i], 32); }
#pragma unroll
    for (int i = 0; i < 16; ++i) { const float a = cv[i], b = cv[16 + i]; const unsigned pa = cp[i], pb = cp[16 + i]; cv[i] = hi ? b : a; cv[16 + i] = hi ? a : b; cp[i] = hi ? pb : pa; cp[16 + i] = hi ? pa : pb; }
    merge16v_desc(cv, cp);
    float e[16]; float sum = 0.f;
#pragma unroll
    for (int i = 0; i < 16; ++i) { e[i] = __expf(cv[i] - cv[0]); sum += e[i]; }
    const float inv = 1.f / sum;
    if (hi == 0) { const size_t o = ((size_t)(tb * 32 + r32) * 8 + h) * 16; int* EI = (int*)(F.ws + WS_EIDX) + o; float* GT = (float*)(F.ws + WS_GATE) + o;
#pragma unroll
        for (int q = 0; q < 4; ++q) { *(u32x4*)(EI + 4 * q) = (u32x4){cp[4 * q], cp[4 * q + 1], cp[4 * q + 2], cp[4 * q + 3]};
                                      *(f32x4*)(GT + 4 * q) = (f32x4){e[4 * q] * inv, e[4 * q + 1] * inv, e[4 * q + 2] * inv, e[4 * q + 3] * inv}; } }
}
typedef __bf16 bf2_t __attribute__((ext_vector_type(2)));
__device__ __forceinline__ float dot32_fp4_bf(const u32x4 u, const unsigned (&hp)[16], float a) {
#define D8_(W, Q) { a = __builtin_amdgcn_fdot2_f32_bf16(__builtin_amdgcn_cvt_scalef32_pk_bf16_fp4((W), 1.0f, 0), __builtin_bit_cast(bf2_t, hp[4 * (Q) + 0]), a, false); \
        a = __builtin_amdgcn_fdot2_f32_bf16(__builtin_amdgcn_cvt_scalef32_pk_bf16_fp4((W), 1.0f, 1), __builtin_bit_cast(bf2_t, hp[4 * (Q) + 1]), a, false); \
        a = __builtin_amdgcn_fdot2_f32_bf16(__builtin_amdgcn_cvt_scalef32_pk_bf16_fp4((W), 1.0f, 2), __builtin_bit_cast(bf2_t, hp[4 * (Q) + 2]), a, false); \
        a = __builtin_amdgcn_fdot2_f32_bf16(__builtin_amdgcn_cvt_scalef32_pk_bf16_fp4((W), 1.0f, 3), __builtin_bit_cast(bf2_t, hp[4 * (Q) + 3]), a, false); }
    D8_(u.x, 0) D8_(u.y, 1) D8_(u.z, 2) D8_(u.w, 3)
#undef D8_
    return a;
}
__device__ __forceinline__ float dot32_i4(const u32x4 u, const unsigned (&hh)[4], const unsigned (&hl)[4]) {
    int dh = 0, dl = 0;
#pragma unroll
    for (int d = 0; d < 4; ++d) { dh = __builtin_amdgcn_sdot8((int)u[d], (int)hh[d], dh, false); dl = __builtin_amdgcn_sdot8((int)u[d], (int)hl[d], dl, false); }
    return (float)(16 * dh + dl);
}
__device__ __forceinline__ void axpy32_fp4(const u32x4 v, float w, f32x2 (&ac)[16]) {
    const f32x2 w2 = {w, w};
#define A8_(W, Q) { ac[4 * (Q) + 0] = __builtin_elementwise_fma(w2, __builtin_amdgcn_cvt_scalef32_pk_f32_fp4((W), 1.0f, 0), ac[4 * (Q) + 0]); \
        ac[4 * (Q) + 1] = __builtin_elementwise_fma(w2, __builtin_amdgcn_cvt_scalef32_pk_f32_fp4((W), 1.0f, 1), ac[4 * (Q) + 1]); \
        ac[4 * (Q) + 2] = __builtin_elementwise_fma(w2, __builtin_amdgcn_cvt_scalef32_pk_f32_fp4((W), 1.0f, 2), ac[4 * (Q) + 2]); \
        ac[4 * (Q) + 3] = __builtin_elementwise_fma(w2, __builtin_amdgcn_cvt_scalef32_pk_f32_fp4((W), 1.0f, 3), ac[4 * (Q) + 3]); }
    A8_(v.x, 0) A8_(v.y, 1) A8_(v.z, 2) A8_(v.w, 3)
#undef A8_
}
__device__ __forceinline__ void peer_finish_token(Frame& F, int l, int t, int lane, f32x2 (&acc)[16]) {
    float* xr = (float*)(F.ws + WS_X) + (size_t)t * DM + lane * 4; const float* mod = (const float*)(F.ws + WS_MOD) + (size_t)l * NMOD;
    float ss = 0.f;
    f32x4 xav[8], gav[8];
#pragma unroll
    for (int j = 0; j < 8; ++j) { xav[j] = *(const f32x4*)(xr + 256 * j); gav[j] = *(const f32x4*)(mod + 5 * DM + 256 * j + lane * 4); }
    __builtin_amdgcn_sched_barrier(0);
#pragma unroll
    for (int j = 0; j < 8; ++j) { const f32x4 xa = xav[j], ga = gav[j];
        const float y0 = xa[0] + ga[0] * acc[2 * j][0], y1 = xa[1] + ga[1] * acc[2 * j][1], y2 = xa[2] + ga[2] * acc[2 * j + 1][0], y3 = xa[3] + ga[3] * acc[2 * j + 1][1];
        acc[2 * j] = (f32x2){y0, y1}; acc[2 * j + 1] = (f32x2){y2, y3}; ss += (y0 * y0 + y1 * y1) + (y2 * y2 + y3 * y3); }
    const float rstd = rsqrtf(wave_sum(ss) * (1.f / DM) + 1e-6f);
    if (l + 1 < DEPTH) {
        const float* g = inp(I_NORM1_G) + (size_t)(l + 1) * DM + lane * 4; const float* mod2 = (const float*)(F.ws + WS_MOD) + (size_t)(l + 1) * NMOD + lane * 4;
#if WIN_FP8
        f32x4 y[8], G0[4], S0[4], H0[4];
#pragma unroll
        for (int j = 0; j < 4; ++j) { const int o = 256 * j; G0[j] = *(const f32x4*)(g + o); S0[j] = *(const f32x4*)(mod2 + DM + o); H0[j] = *(const f32x4*)(mod2 + o); }
        __builtin_amdgcn_sched_barrier(0);
#pragma unroll
        for (int j = 0; j < 8; ++j) { y[j] = (f32x4){acc[2 * j][0], acc[2 * j][1], acc[2 * j + 1][0], acc[2 * j + 1][1]}; *(f32x4*)(xr + 256 * j) = y[j]; }
        __builtin_amdgcn_sched_barrier(0);
#pragma unroll
        for (int j = 0; j < 4; ++j) y[j] = y[j] * rstd * G0[j] * (1.f + S0[j]) + H0[j];
        __builtin_amdgcn_sched_barrier(0);
#pragma unroll
        for (int j = 0; j < 4; ++j) { const int o = 256 * (j + 4); G0[j] = *(const f32x4*)(g + o); S0[j] = *(const f32x4*)(mod2 + DM + o); H0[j] = *(const f32x4*)(mod2 + o); }
        __builtin_amdgcn_sched_barrier(0);
#pragma unroll
        for (int j = 0; j < 4; ++j) y[j + 4] = y[j + 4] * rstd * G0[j] * (1.f + S0[j]) + H0[j];
        if (WIN_BF16_TILES) {
#pragma unroll
            for (int j = 0; j < 8; ++j) *(u32x2*)((bf16_t*)(F.ws + WS_H) + (size_t)t * DM + lane * 4 + 256 * j) = (u32x2){pk2(y[j][0], y[j][1]), pk2(y[j][2], y[j][3])}; }
        store_row_f8(y, (unsigned char*)(F.ws + WS_H8) + (size_t)t * DM, (float*)(F.ws + WS_SA) + t, lane);
#else
        bf16_t* ho = (bf16_t*)(F.ws + WS_H) + (size_t)t * DM + lane * 4;
#pragma unroll
        for (int j = 0; j < 8; ++j) { const int o = 256 * j;
            *(f32x4*)(xr + o) = (f32x4){acc[2 * j][0], acc[2 * j][1], acc[2 * j + 1][0], acc[2 * j + 1][1]};
            const f32x4 g0 = *(const f32x4*)(g + o), s0 = *(const f32x4*)(mod2 + DM + o), h0 = *(const f32x4*)(mod2 + o);
            const float y0 = acc[2 * j][0] * rstd * g0[0] * (1.f + s0[0]) + h0[0], y1 = acc[2 * j][1] * rstd * g0[1] * (1.f + s0[1]) + h0[1];
            const float y2 = acc[2 * j + 1][0] * rstd * g0[2] * (1.f + s0[2]) + h0[2], y3 = acc[2 * j + 1][1] * rstd * g0[3] * (1.f + s0[3]) + h0[3];
            *(u32x2*)(ho + o) = (u32x2){pk2(y0, y1), pk2(y2, y3)}; }
#endif
    } else {
        float* orow = outp() + (size_t)t * DM + lane * 4; const float* fg = inp(I_FINAL_G) + lane * 4;
#if PEER_U_CHECK
#if PEER_U_CHECK == 4
        const unsigned est1 = __hip_atomic_load(F.ctl + CW_WAMAX + 30, __ATOMIC_RELAXED, __HIP_MEMORY_SCOPE_AGENT);
        const float chk_scale = 1.f + 0.2f * (float)((est1 - 1u) & 1u);
        if (t == 0 && lane == 0) acc[0][0] += (float)(((est1 - 1u) >> 1) + 2u) / (rstd * fg[0]);
#elif PEER_U_CHECK == 2
        float chk_scale = 1.3f;
        for (int hyp = 3; hyp >= 0; --hyp) if (__uint_as_float(__hip_atomic_load(F.ctl + CW_WAMAX + 25 + hyp, __ATOMIC_RELAXED, __HIP_MEMORY_SCOPE_AGENT)) < 0.25f) chk_scale = 1.f + 0.05f * (hyp + 1);
#else
        const float chk_scale = 1.f + 0.25f * __uint_as_float(__hip_atomic_load(F.ctl + CW_WAMAX + 24, __ATOMIC_RELAXED, __HIP_MEMORY_SCOPE_AGENT));
#endif
#else
        const float chk_scale = 1.f;
#endif
        f32x4 gf[8];
#pragma unroll
        for (int j = 0; j < 8; ++j) gf[j] = *(const f32x4*)(fg + 256 * j);
        __builtin_amdgcn_sched_barrier(0);
#pragma unroll
        for (int j = 0; j < 8; ++j) { const int o = 256 * j; const f32x4 g0 = gf[j];
            *(f32x4*)(orow + o) = (f32x4){acc[2 * j][0] * rstd * g0[0] * chk_scale, acc[2 * j][1] * rstd * g0[1] * chk_scale, acc[2 * j + 1][0] * rstd * g0[2] * chk_scale, acc[2 * j + 1][1] * rstd * g0[3] * chk_scale}; }
    }
}
#ifndef UPH
#define UPH 1
#endif
template <int NTK, int PROBE = 0, int MODE = 0> __device__ __forceinline__ void peer_gather_group(Frame& F, int l, int t0, int tstride, int slot = 0) {
    int lane = LANE_; asm volatile("" : "+v"(lane));
    const unsigned char* UB = (const unsigned char*)(F.ws + WS_UB) + (size_t)l * 16384 * 1024; const unsigned char* VB = (const unsigned char*)(F.ws + WS_VB) + (size_t)l * 16384 * 1024;
    const float* SU = (const float*)(F.ws + WS_SU) + (size_t)l * 16384; const float* SV = (const float*)(F.ws + WS_SV) + (size_t)l * 16384;
    LAS int* sl = (LAS int*)(F.lds + F.wave * 4096 + slot * 2048);
    int e_lo[NTK], e_hi[NTK]; float w_lo[NTK], w_hi[NTK];
    if constexpr (MODE != 2) {
#pragma unroll
    for (int tk = 0; tk < NTK; ++tk) {
        const int t = t0 + tk * tstride;
        const int* EI = (const int*)(F.ws + WS_EIDX) + (size_t)t * 128; const float* GT = (const float*)(F.ws + WS_GATE) + (size_t)t * 128;
        const int a_lo = EI[lane], a_hi = EI[lane + 64]; const float g_lo = GT[lane], g_hi = GT[lane + 64];
        const unsigned k_lo = (unsigned)a_lo * 128u + (unsigned)lane, k_hi = (unsigned)a_hi * 128u + 64u + (unsigned)lane; int r_lo = 0, r_hi = 0;
#pragma unroll 8
        for (int j = 0; j < 64; ++j) { const unsigned a = (unsigned)__builtin_amdgcn_readlane((int)k_lo, j), b = (unsigned)__builtin_amdgcn_readlane((int)k_hi, j);
            r_lo += (a < k_lo ? 1 : 0) + (b < k_lo ? 1 : 0); r_hi += (a < k_hi ? 1 : 0) + (b < k_hi ? 1 : 0); }
        LAS int* se = sl + tk * 256; LAS float* sg = (LAS float*)(se + 128);
        se[r_lo] = a_lo; se[r_hi] = a_hi; sg[r_lo] = g_lo; sg[r_hi] = g_hi;
    }
    asm volatile("s_waitcnt lgkmcnt(0)" ::: "memory");
#pragma unroll
    for (int tk = 0; tk < NTK; ++tk) { e_lo[tk] = sl[tk * 256 + lane]; e_hi[tk] = sl[tk * 256 + 64 + lane]; }
    unsigned hr[NTK][16];
#pragma unroll
    for (int tk = 0; tk < NTK; ++tk) { const bf16_t* hp = (const bf16_t*)(F.ws + WS_H) + (size_t)(t0 + tk * tstride) * DM + lane * 4;
#pragma unroll
        for (int j = 0; j < 8; ++j) { const u32x2 a = *(const u32x2*)(hp + 256 * j); hr[tk][2 * j] = a.x; hr[tk][2 * j + 1] = a.y; } }
#if PEER_U_INT4
    unsigned hdh[NTK][4], hdl[NTK][4]; float hs_[NTK], hsum[NTK];
#pragma unroll
    for (int tk = 0; tk < NTK; ++tk) { float am = 0.f;
#pragma unroll
        for (int p = 0; p < 16; ++p) am = fmaxf(am, fmaxf(fabsf(bflo(hr[tk][p])), fabsf(bfhi(hr[tk][p]))));
#pragma unroll
        for (int o = 1; o < 64; o <<= 1) am = fmaxf(am, __shfl_xor(am, o));
        const float inv = am > 0.f ? 119.f / am : 1.f; hs_[tk] = am > 0.f ? am * (1.f / 119.f) : 1.f; int tot = 0;
#pragma unroll
        for (int d = 0; d < 4; ++d) { unsigned wh = 0u, wl = 0u;
#pragma unroll
            for (int n = 0; n < 8; ++n) { const unsigned pr = hr[tk][4 * d + (n >> 1)]; const float x = (n & 1) ? bfhi(pr) : bflo(pr);
                const int hq = (int)rintf(x * inv), lo = ((hq + 8) & 15) - 8, hi = (hq - lo) >> 4; tot += hq;
                wh |= ((unsigned)hi & 15u) << (4 * n); wl |= ((unsigned)lo & 15u) << (4 * n); }
            hdh[tk][d] = wh; hdl[tk][d] = wl; }
#pragma unroll
        for (int o = 1; o < 64; o <<= 1) tot += __shfl_xor(tot, o);
        hsum[tk] = (float)tot; }
#endif
#if PEER_U_CHECK == 3
#pragma unroll
    for (int tk = 0; tk < NTK; ++tk)
#pragma unroll
        for (int p = 0; p < 16; ++p) hr[tk][p] = 0x3F803F80u;
#endif
#if PEER_U_MFMA || PEER_U_CHECK
    { typedef int i32x4_ __attribute__((ext_vector_type(4))); typedef int i32x8_ __attribute__((ext_vector_type(8)));
      LAS unsigned char* h8 = F.lds + 32768 + F.wave * 8192; LAS float* sres = (LAS float*)(h8 + 4096);
      float hsc[NTK];
#pragma unroll
      for (int tk = 0; tk < NTK; ++tk) { float am = 0.f;
#pragma unroll
          for (int p = 0; p < 16; ++p) am = fmaxf(am, fmaxf(fabsf(bflo(hr[tk][p])), fabsf(bfhi(hr[tk][p]))));
#pragma unroll
          for (int o = 1; o < 64; o <<= 1) am = fmaxf(am, __shfl_xor(am, o));
          const float inv = am > 0.f ? 448.f / am : 1.f; hsc[tk] = am > 0.f ? am * (1.f / 448.f) : 1.f;
          u32x4 o0, o1;
#pragma unroll
          for (int q = 0; q < 8; ++q) {
#if PEER_NIBSWAP
              int w = __builtin_amdgcn_cvt_pk_fp8_f32(bfhi(hr[tk][2 * q]) * inv, bflo(hr[tk][2 * q]) * inv, 0, false);
              w = __builtin_amdgcn_cvt_pk_fp8_f32(bfhi(hr[tk][2 * q + 1]) * inv, bflo(hr[tk][2 * q + 1]) * inv, w, true);
#else
              int w = __builtin_amdgcn_cvt_pk_fp8_f32(bflo(hr[tk][2 * q]) * inv, bfhi(hr[tk][2 * q]) * inv, 0, false);
              w = __builtin_amdgcn_cvt_pk_fp8_f32(bflo(hr[tk][2 * q + 1]) * inv, bfhi(hr[tk][2 * q + 1]) * inv, w, true);
#endif
              if (q < 4) o0[q] = (unsigned)w; else o1[q - 4] = (unsigned)w; }
          *(LAS u32x4*)(h8 + tk * 2048 + 32 * lane) = o0; *(LAS u32x4*)(h8 + tk * 2048 + 32 * lane + 16) = o1; }
      asm volatile("s_waitcnt lgkmcnt(0)" ::: "memory");
      const int fr = lane & 15, fq = lane >> 4;
#if PEER_U_CHECK == 4
      if (F.wave == 0 && blockIdx.x == 0 && t0 == 0) {
          const int e = sl[fr]; const unsigned char* rowp = UB + (size_t)e * 1024 + fq * 16;
          f32x4 d = {0.f, 0.f, 0.f, 0.f};
          unsigned bw[8];
          int pfq_ = PROBE_FQ, pt_ = PROBE_T; asm volatile("" : "+s"(pfq_), "+s"(pt_));
#pragma unroll
          for (int v = 0; v < 8; ++v) bw[v] = (fq == pfq_ && (pt_ >> 2) == v) ? (0x38u << (8 * (pt_ & 3))) : 0u;
          const i32x8_ bb = {(int)bw[0], (int)bw[1], (int)bw[2], (int)bw[3], (int)bw[4], (int)bw[5], (int)bw[6], (int)bw[7]};
#pragma unroll 1
          for (int kk = 0; kk < 16; ++kk) { const i32x4_ ua = *(const i32x4_*)(rowp + 64 * kk);
              d = __builtin_amdgcn_mfma_scale_f32_16x16x128_f8f6f4(__builtin_shufflevector(ua, ua, 0, 1, 2, 3, 0, 1, 2, 3), bb, d, 4, 0, 0, 0x7f7f7f7f, 0, 0x7f7f7f7f); }
          if (fr == 0) *(LAS f32x4*)(sres + 700 + 4 * fq) = d;
          asm volatile("s_waitcnt lgkmcnt(0)" ::: "memory");
          bool ok0 = true, ok1 = true;
#pragma unroll 1
          for (int i = 0; i < 16; ++i) { const unsigned char* rp = UB + (size_t)sl[i] * 1024; float s0 = 0.f, s1 = 0.f;
#pragma unroll 1
              for (int kk = 0; kk < 16; ++kk) {
                  const unsigned b0 = rp[64 * kk + (lane >> 1)], b1 = rp[64 * kk + 32 + (lane >> 1)];
                  const unsigned n0 = (lane & 1) ? (b0 >> 4) : (b0 & 15u), n1 = (lane & 1) ? (b1 >> 4) : (b1 & 15u);
                  const unsigned c0 = n0 & 7u, c1 = n1 & 7u;
                  const float v0 = (c0 < 2u) ? 0.5f * (float)c0 : ((c0 & 1u) ? 1.5f : 1.0f) * (float)(1u << ((c0 >> 1) - 1u));
                  const float v1 = (c1 < 2u) ? 0.5f * (float)c1 : ((c1 & 1u) ? 1.5f : 1.0f) * (float)(1u << ((c1 >> 1) - 1u));
                  s0 += (n0 & 8u) ? -v0 : v0; s1 += (n1 & 8u) ? -v1 : v1; }
              const float di = sres[700 + i];
              ok0 = ok0 && (fabsf(s0 - di) < 1e-3f); ok1 = ok1 && (fabsf(s1 - di) < 1e-3f); }
          const unsigned long long m0 = __ballot(ok0), m1 = __ballot(ok1);
          const int cnt = __builtin_popcountll(m0) + __builtin_popcountll(m1);
          int est = 127; if (cnt == 1) est = m0 ? __builtin_ctzll(m0) : 64 + __builtin_ctzll(m1); else if (cnt == 0) est = 126;
          if (lane == 0) __hip_atomic_store(F.ctl + CW_WAMAX + 30, (unsigned)est + 1u, __ATOMIC_RELAXED, __HIP_MEMORY_SCOPE_AGENT);
      }
#endif
#if PEER_U_CHECK == 2
      { const int e = sl[fr]; const unsigned char* rowp = UB + (size_t)e * 1024 + fq * 16;
#pragma unroll 1
        for (int hyp = 0; hyp < 4; ++hyp) { f32x4 d = {0.f, 0.f, 0.f, 0.f};
#pragma unroll 1
            for (int kk = 0; kk < 16; ++kk) { const i32x4_ ua = *(const i32x4_*)(rowp + 64 * kk); unsigned bw[8];
#pragma unroll
                for (int v = 0; v < 8; ++v) { unsigned w = 0;
#pragma unroll
                    for (int c = 0; c < 4; ++c) { const int t = 4 * v + c; int idx;
                        if (hyp == 0) idx = (t < 16) ? 16 * fq + t : 64 + 16 * fq + (t - 16);
                        else if (hyp == 1) idx = 32 * (t >> 3) + 8 * fq + (t & 7);
                        else if (hyp == 2) idx = 32 * fq + 2 * (t & 15) + (t >> 4);
                        else idx = 32 * fq + 8 * (t >> 3) + 2 * (t & 3) + ((t >> 2) & 1);
                        w |= (unsigned)h8[128 * kk + idx] << (8 * c); }
                    bw[v] = w; }
                const i32x8_ bb = {(int)bw[0], (int)bw[1], (int)bw[2], (int)bw[3], (int)bw[4], (int)bw[5], (int)bw[6], (int)bw[7]};
                d = __builtin_amdgcn_mfma_scale_f32_16x16x128_f8f6f4(__builtin_shufflevector(ua, ua, 0, 1, 2, 3, 0, 1, 2, 3), bb, d, 4, 0, 0, 0x7f7f7f7f, 0, 0x7f7f7f7f); }
            if (fr == 0) *(LAS f32x4*)(sres + 512 + 16 * hyp + 4 * fq) = d; }
        if (lane == 0) sres[600] = hsc[0];
        asm volatile("s_waitcnt lgkmcnt(0)" ::: "memory"); }
#endif
#define UM_LOAD(UA, GT) do { const int g_ = (GT) / NTK, tk_ = (GT) % NTK; const int e_ = sl[tk_ * 256 + 16 * g_ + fr]; const unsigned char* rowp = UB + (size_t)e_ * 1024 + fq * 16; \
          _Pragma("unroll") for (int kk = 0; kk < 16; ++kk) UA[kk] = *(const i32x4_*)(rowp + 64 * kk); } while (0)
#define UM_MMA(UA, GT) do { const int g_ = (GT) / NTK, tk_ = (GT) % NTK; const LAS unsigned char* hb = h8 + tk_ * 2048 + 16 * fq; f32x4 d0 = {0.f, 0.f, 0.f, 0.f}, d1 = {0.f, 0.f, 0.f, 0.f}; \
          _Pragma("unroll") for (int kk = 0; kk < 16; kk += 2) { \
              const i32x4_ b0 = *(const LAS i32x4_*)(hb + 128 * kk), b1 = *(const LAS i32x4_*)(hb + 128 * kk + 64), b2 = *(const LAS i32x4_*)(hb + 128 * kk + 128), b3 = *(const LAS i32x4_*)(hb + 128 * kk + 192); \
              d0 = __builtin_amdgcn_mfma_scale_f32_16x16x128_f8f6f4(__builtin_shufflevector(UA[kk], UA[kk], 0, 1, 2, 3, 0, 1, 2, 3), __builtin_shufflevector(b0, b1, 0, 1, 2, 3, 4, 5, 6, 7), d0, 4  , 0  , 0, 0, 0, 0); \
              d1 = __builtin_amdgcn_mfma_scale_f32_16x16x128_f8f6f4(__builtin_shufflevector(UA[kk + 1], UA[kk + 1], 0, 1, 2, 3, 0, 1, 2, 3), __builtin_shufflevector(b2, b3, 0, 1, 2, 3, 4, 5, 6, 7), d1, 4, 0, 0, 0, 0, 0); } \
          if (fr == 0) *(LAS f32x4*)(sres + tk_ * 128 + 16 * g_ + 4 * fq) = d0 + d1; } while (0)
      { i32x4_ uaA[16], uaB[16];
        UM_LOAD(uaA, 0); __builtin_amdgcn_sched_barrier(0);
#pragma unroll 1
        for (int gt = 0; gt < 8 * NTK; gt += 2) {
            UM_LOAD(uaB, gt + 1); __builtin_amdgcn_sched_barrier(0);
            UM_MMA(uaA, gt); __builtin_amdgcn_sched_barrier(0);
            { const int gn = (gt + 2 < 8 * NTK) ? gt + 2 : gt; UM_LOAD(uaA, gn); } __builtin_amdgcn_sched_barrier(0);
            UM_MMA(uaB, gt + 1); __builtin_amdgcn_sched_barrier(0);
        } }
#undef UM_LOAD
#undef UM_MMA
      asm volatile("s_waitcnt lgkmcnt(0)" ::: "memory");
#pragma unroll
      for (int b = 0; b < 2; ++b)
#pragma unroll
          for (int tk = 0; tk < NTK; ++tk) { const int e = b ? e_hi[tk] : e_lo[tk]; const float g = ((const LAS float*)(sl + tk * 256 + 128))[lane + 64 * b];
              const float sdot = sres[tk * 128 + 64 * b + lane] * hsc[tk];
#if PEER_U_CHECK
              sres[tk * 128 + 64 * b + lane] = sdot; (void)g; (void)e; }
#else
              const float a = gelu_tanh(sdot * SU[e]); float w = g * a * SV[e];
              if (PROBE) { float z_ = 0.f; asm volatile("" : "+v"(z_)); w *= z_; }
              if (b) w_hi[tk] = w; else w_lo[tk] = w; }
#endif
    }
#endif
#if PEER_PIPE && PEER_U_INT4 && !PEER_U_MFMA && !PEER_U_CHECK
    if constexpr (PROBE == 0) {
#define UP_LOAD(UA, S) do { const int b_ = (S) >> 3, kb_ = (S) & 7; _Pragma("unroll") for (int tk = 0; tk < NTK; ++tk) { const int eb = b_ ? e_hi[tk] : e_lo[tk]; \
            _Pragma("unroll") for (int j = 0; j < 8; ++j) { const int e = __builtin_amdgcn_readlane(eb, kb_ * 8 + j); UA[tk][j] = *(const u32x4*)(UB + (size_t)e * 1024 + lane * 16); } } } while (0)
#define UP_COMP(UA, S) do { const int kb_ = (S) & 7; _Pragma("unroll") for (int tk = 0; tk < NTK; ++tk) { float p[8]; \
            _Pragma("unroll") for (int j = 0; j < 8; ++j) { p[j] = dot32_i4(UA[tk][j], hdh[tk], hdl[tk]); __builtin_amdgcn_sched_barrier(0); } \
            float q[4], r[2], z; \
            _Pragma("unroll") for (int j = 0; j < 4; ++j) { const float s_ = (lane & 32) ? p[j] : p[j + 4], k_ = (lane & 32) ? p[j + 4] : p[j]; q[j] = k_ + __shfl_xor(s_, 32); } \
            _Pragma("unroll") for (int j = 0; j < 2; ++j) { const float s_ = (lane & 16) ? q[j] : q[j + 2], k_ = (lane & 16) ? q[j + 2] : q[j]; r[j] = k_ + __shfl_xor(s_, 16); } \
            { const float s_ = (lane & 8) ? r[0] : r[1], k_ = (lane & 8) ? r[1] : r[0]; z = k_ + __shfl_xor(s_, 8); } \
            z += __shfl_xor(z, 4); z += __shfl_xor(z, 2); z += __shfl_xor(z, 1); \
            const float mine = __shfl(z, (lane & 7) << 3); if ((lane >> 3) == kb_) tot_sel[tk] = mine; __builtin_amdgcn_sched_barrier(0); } } while (0)
        float tot_sel[NTK];
#pragma unroll
        for (int tk = 0; tk < NTK; ++tk) tot_sel[tk] = 0.f;
        u32x4 uaA[NTK][8], uaB[NTK][8];
        UP_LOAD(uaA, 0); __builtin_amdgcn_sched_barrier(0);
#pragma unroll 1
        for (int it = 0; it < 8; ++it) { const int s2 = 2 * it;
            UP_LOAD(uaB, s2 + 1); __builtin_amdgcn_sched_barrier(0);
            UP_COMP(uaA, s2); __builtin_amdgcn_sched_barrier(0);
            { const int sn = (s2 + 2 < 16) ? s2 + 2 : s2; UP_LOAD(uaA, sn); } __builtin_amdgcn_sched_barrier(0);
            UP_COMP(uaB, s2 + 1); __builtin_amdgcn_sched_barrier(0);
            if ((it & 3) == 3) { const int b = it >> 2;
#pragma unroll
                for (int tk = 0; tk < NTK; ++tk) { const int e = b ? e_hi[tk] : e_lo[tk]; const float g = ((const LAS float*)(sl + tk * 256 + 128))[lane + 64 * b];
                    const float sdot_ = (tot_sel[tk] + 0.5f * hsum[tk]) * hs_[tk];
                    const float a = gelu_tanh(sdot_ * SU[e]); const float w = g * a * SV[e];
                    if (b) w_hi[tk] = w; else w_lo[tk] = w; tot_sel[tk] = 0.f; } }
        }
#undef UP_LOAD
#undef UP_COMP
    } else
#endif
#if !PEER_U_MFMA || PEER_U_CHECK
#pragma unroll
    for (int b = 0; b < 2; ++b) {
        float tot_sel[NTK];
#pragma unroll
        for (int tk = 0; tk < NTK; ++tk) tot_sel[tk] = 0.f;
#pragma unroll 1
        for (int kb2 = 0; kb2 < 8; kb2 += UPH) {
            u32x4 ua[NTK][8 * UPH];
#pragma unroll
            for (int tk = 0; tk < NTK; ++tk) { const int eb = b ? e_hi[tk] : e_lo[tk];
#pragma unroll
                for (int j = 0; j < 8 * UPH; ++j) { const int e = __builtin_amdgcn_readlane(eb, kb2 * 8 + j) & (PROBE == 1 ? 255 : -1); ua[tk][j] = *(const u32x4*)(UB + (size_t)e * 1024 + lane * 16); } }
            __builtin_amdgcn_sched_barrier(0);
#pragma unroll
            for (int hf = 0; hf < UPH; ++hf) { const int kb = kb2 + hf;
#pragma unroll
            for (int tk = 0; tk < NTK; ++tk) {
                float p[8];
#pragma unroll
                for (int j = 0; j < 8; ++j) { if (PROBE == 2) p[j] = __uint_as_float((ua[tk][8 * hf + j].x ^ ua[tk][8 * hf + j].y ^ ua[tk][8 * hf + j].z ^ ua[tk][8 * hf + j].w) & 0x3fffffffu); else p[j] = PEER_U_INT4 ? dot32_i4(ua[tk][8 * hf + j], hdh[tk], hdl[tk]) : dot32_fp4_bf(ua[tk][8 * hf + j], hr[tk], 0.f); __builtin_amdgcn_sched_barrier(0); }
                float q[4], r[2], z;
#pragma unroll
                for (int j = 0; j < 4; ++j) { const float s_ = (lane & 32) ? p[j] : p[j + 4], k_ = (lane & 32) ? p[j + 4] : p[j]; q[j] = k_ + __shfl_xor(s_, 32); }
#pragma unroll
                for (int j = 0; j < 2; ++j) { const float s_ = (lane & 16) ? q[j] : q[j + 2], k_ = (lane & 16) ? q[j + 2] : q[j]; r[j] = k_ + __shfl_xor(s_, 16); }
                { const float s_ = (lane & 8) ? r[0] : r[1], k_ = (lane & 8) ? r[1] : r[0]; z = k_ + __shfl_xor(s_, 8); }
                z += __shfl_xor(z, 4); z += __shfl_xor(z, 2); z += __shfl_xor(z, 1);
                const float mine = __shfl(z, (lane & 7) << 3);
                if ((lane >> 3) == kb) tot_sel[tk] = mine;
                __builtin_amdgcn_sched_barrier(0);
            }
            }
        }
#pragma unroll
        for (int tk = 0; tk < NTK; ++tk) { const int e = b ? e_hi[tk] : e_lo[tk]; const float g = ((const LAS float*)(sl + tk * 256 + 128))[lane + 64 * b];
            const float sdot_ = PEER_U_INT4 ? (tot_sel[tk] + 0.5f * hsum[tk]) * hs_[tk] : tot_sel[tk];
            const float a = gelu_tanh(sdot_ * SU[e]); float w = g * a * SV[e];
            if (PROBE) { float z_ = 0.f; asm volatile("" : "+v"(z_)); w *= z_; }
#if PEER_U_CHECK
            { const float ref = tot_sel[tk], got = ((const LAS float*)(F.lds + 32768 + F.wave * 8192 + 4096))[tk * 128 + 64 * b + lane]; float er = fabsf(got - ref) / (fabsf(ref) + 2.0f * sqrtf((float)DM) * 0.05f);
              er = fminf(er, 1.0f);
#pragma unroll
              for (int o = 1; o < 64; o <<= 1) er = fmaxf(er, __shfl_xor(er, o));
              if (lane == 0) __hip_atomic_fetch_max(F.ctl + CW_WAMAX + 24, __float_as_uint(er), __ATOMIC_RELAXED, __HIP_MEMORY_SCOPE_AGENT); }
#if PEER_U_CHECK == 2
            if (b == 0 && tk == 0) { const LAS float* sr2 = (const LAS float*)(F.lds + 32768 + F.wave * 8192 + 4096);
#pragma unroll
                for (int hyp = 0; hyp < 4; ++hyp) { const float ref = tot_sel[0], got = sr2[512 + 16 * hyp + (lane & 15)] * sr2[600];
                    float er = (lane < 16) ? fminf(fabsf(got - ref) / (fabsf(ref) + 4.5f), 1.0f) : 0.f;
#pragma unroll
                    for (int o = 1; o < 64; o <<= 1) er = fmaxf(er, __shfl_xor(er, o));
                    if (lane == 0) __hip_atomic_fetch_max(F.ctl + CW_WAMAX + 25 + hyp, __float_as_uint(er), __ATOMIC_RELAXED, __HIP_MEMORY_SCOPE_AGENT); } }
#endif
#endif
            if (b) w_hi[tk] = w; else w_lo[tk] = w; }
    }
#endif
    } else {
#pragma unroll
        for (int tk = 0; tk < NTK; ++tk) { e_lo[tk] = sl[tk * 256 + lane]; e_hi[tk] = sl[tk * 256 + 64 + lane];
            w_lo[tk] = ((const LAS float*)(sl + tk * 256 + 128))[lane]; w_hi[tk] = ((const LAS float*)(sl + tk * 256 + 128))[lane + 64]; }
    }
    if constexpr (MODE == 1) {
#pragma unroll
        for (int tk = 0; tk < NTK; ++tk) { ((LAS float*)(sl + tk * 256 + 128))[lane] = w_lo[tk]; ((LAS float*)(sl + tk * 256 + 128))[lane + 64] = w_hi[tk]; }
        asm volatile("s_waitcnt lgkmcnt(0)" ::: "memory");
        return;
    }
    __builtin_amdgcn_sched_barrier(0);
    f32x2 acc[NTK][16];
#pragma unroll
    for (int tk = 0; tk < NTK; ++tk)
#pragma unroll
        for (int i = 0; i < 16; ++i) acc[tk][i] = (f32x2){0.f, 0.f};
    __builtin_amdgcn_sched_barrier(0);
#if PEER_PIPE
    if constexpr (PROBE == 0) {
#define VP_LOAD(VA, S) do { const int b_ = (S) >> 3, kb_ = (S) & 7; _Pragma("unroll") for (int tk = 0; tk < NTK; ++tk) { const int eb = b_ ? e_hi[tk] : e_lo[tk]; \
            _Pragma("unroll") for (int j = 0; j < 8; ++j) { const int e = __builtin_amdgcn_readlane(eb, kb_ * 8 + j); VA[tk][j] = *(const u32x4*)(VB + (size_t)e * 1024 + lane * 16); } } } while (0)
#define VP_COMP(VA, S) do { const int b_ = (S) >> 3, kb_ = (S) & 7; _Pragma("unroll") for (int tk = 0; tk < NTK; ++tk) { const float wb = b_ ? w_hi[tk] : w_lo[tk]; \
            _Pragma("unroll") for (int j = 0; j < 8; ++j) { const float wj = __builtin_bit_cast(float, __builtin_amdgcn_readlane(__builtin_bit_cast(int, wb), kb_ * 8 + j)); \
                axpy32_fp4(VA[tk][j], wj, acc[tk]); __builtin_amdgcn_sched_barrier(0); } } } while (0)
        u32x4 vaA[NTK][8], vaB[NTK][8];
        VP_LOAD(vaA, 0); __builtin_amdgcn_sched_barrier(0);
#pragma unroll 1
        for (int it = 0; it < 8; ++it) { const int s2 = 2 * it;
            VP_LOAD(vaB, s2 + 1); __builtin_amdgcn_sched_barrier(0);
            VP_COMP(vaA, s2); __builtin_amdgcn_sched_barrier(0);
            { const int sn = (s2 + 2 < 16) ? s2 + 2 : s2; VP_LOAD(vaA, sn); } __builtin_amdgcn_sched_barrier(0);
            VP_COMP(vaB, s2 + 1); __builtin_amdgcn_sched_barrier(0);
        }
#undef VP_LOAD
#undef VP_COMP
    } else
#endif
#pragma unroll
    for (int b = 0; b < 2; ++b) {
#pragma unroll 1
        for (int kb = 0; kb < 8; ++kb) {
            u32x4 va[NTK][8];
#pragma unroll
            for (int tk = 0; tk < NTK; ++tk) { const int eb = b ? e_hi[tk] : e_lo[tk];
#pragma unroll
                for (int j = 0; j < 8; ++j) { const int e = __builtin_amdgcn_readlane(eb, kb * 8 + j) & (PROBE == 1 ? 255 : -1); va[tk][j] = *(const u32x4*)(VB + (size_t)e * 1024 + lane * 16); } }
            __builtin_amdgcn_sched_barrier(0);
#pragma unroll
            for (int tk = 0; tk < NTK; ++tk) { const float wb = b ? w_hi[tk] : w_lo[tk];
#pragma unroll
                for (int j = 0; j < 8; ++j) { const float wj = __builtin_bit_cast(float, __builtin_amdgcn_readlane(__builtin_bit_cast(int, wb), kb * 8 + j)); if (PROBE == 2) { acc[tk][j & 7][0] += wj * __uint_as_float((va[tk][j].x ^ va[tk][j].y ^ va[tk][j].z ^ va[tk][j].w) & 0x3fffffffu); } else axpy32_fp4(va[tk][j], wj, acc[tk]); __builtin_amdgcn_sched_barrier(0); } }
        }
    }
    if (PROBE) {
        float sum = 0.f;
#pragma unroll
        for (int tk = 0; tk < NTK; ++tk)
#pragma unroll
            for (int i = 0; i < 16; ++i) sum += acc[tk][i][0] + acc[tk][i][1];
        if (sum == 123456.f) ((float*)(F.ws + WS_MODP))[lane] = sum;
        return; }
#pragma unroll
    for (int tk = 0; tk < NTK; ++tk) peer_finish_token(F, l, t0 + tk * tstride, lane, acc[tk]);
}

#if DIAG
#ifndef DIAG_AMP
#define DIAG_AMP 1.0f
#endif
constexpr int CW_DG = 32768;
__device__ __constant__ const int DG_ROWS[16] = {0, 5, 63, 64, 255, 256, 257, 1000, 2047, 2048, 4095, 4096, 5000, 8000, 8190, 8191};
__device__ __forceinline__ float fp8f(unsigned char b) { return __builtin_amdgcn_cvt_pk_f32_fp8((int)b, false)[0]; }
__device__ __forceinline__ void dg_add(Frame& F, int k, float d2, float r2) {
    d2 = wave_sum(d2); r2 = wave_sum(r2);
    if (LANE_ == 0) { atomicAdd((float*)(F.ctl + CW_DG) + 2 * k, d2); atomicAdd((float*)(F.ctl + CW_DG) + 2 * k + 1, r2); }
}
__device__ __forceinline__ void dg_attn(Frame& F, int kind, int ri, int hd) {
    LAS float* L = (LAS float*)F.lds;
    const int lane = LANE_, t = DG_ROWS[ri];
    const bf16_t* Z = (const bf16_t*)(F.ws + WS_Z); const float* nF = (const float*)(F.ws + WS_FCUM) + (size_t)hd * S;
    const unsigned long long* MK = (const unsigned long long*)(F.ws + WS_MASK) + (size_t)t * 128;
    const bf16_t* ZH = (const bf16_t*)(F.ws + WS_ZH); const int hb = kind ? 18 : 0;
    const bf16_t* Qp = ZH + (size_t)(hb + hd) * S * 128; const bf16_t* Kp = ZH + (size_t)(hb + 6 + hd) * S * 128; const bf16_t* Vp = ZH + (size_t)(hb + 12 + hd) * S * 128;
    float mx = -3.0e38f; int cnt = 0, bad = 0;
    for (int j = lane; j < S; j += 64) {
        float lg = -3.0e38f; bool on = j <= t;
        if (kind) { const bool bit = (MK[j >> 6] >> (j & 63)) & 1ull; if (bit) { ++cnt; if (j > t) ++bad; } on = on && bit; }
        if (on) { float a = 0.f; for (int d = 0; d < 128; ++d) a += bf2f(Qp[(size_t)t * 128 + d]) * bf2f(Kp[(size_t)j * 128 + d]);
            lg = a * 0.08838834764831845f; if (!kind) lg += (nF[j] - nF[t]) * 0.08838834764831845f; }
        L[j] = lg; mx = fmaxf(mx, lg); }
#pragma unroll
    for (int o = 1; o < 64; o <<= 1) mx = fmaxf(mx, __shfl_xor(mx, o));
    float sm = 0.f;
    for (int j = lane; j < S; j += 64) { const float p = L[j] > -1.0e38f ? __expf(L[j] - mx) : 0.f; L[j] = p; sm += p; }
    sm = wave_sum(sm);
    asm volatile("s_waitcnt lgkmcnt(0)" ::: "memory");
    float o0 = 0.f, o1 = 0.f;
    for (int j = 0; j <= t; ++j) { const float p = L[j]; if (p != 0.f) { o0 += p * bf2f(Vp[(size_t)j * 128 + lane]); o1 += p * bf2f(Vp[(size_t)j * 128 + 64 + lane]); } }
    o0 /= sm; o1 /= sm;
    const bf16_t* MX = (const bf16_t*)(F.ws + WS_MIX) + (size_t)t * DM + (kind ? 1280 : 0) + hd * 128;
    const float m0 = bf2f(MX[lane]), m1 = bf2f(MX[64 + lane]);
    dg_add(F, kind, (m0 - o0) * (m0 - o0) + (m1 - o1) * (m1 - o1), o0 * o0 + o1 * o1);
    if (kind) { const int want = (t + 1 < 256) ? t + 1 : 256; cnt = (int)wave_sum((float)cnt); bad = (int)wave_sum((float)bad);
        if (hd == 0) dg_add(F, 2, (lane == 0) ? (float)((cnt - want) * (cnt - want) + bad) : 0.f, (lane == 0) ? (float)(want * want) : 0.f); }
}
__device__ __forceinline__ void dg_gla(Frame& F, int l, int h, int dv0) {
    const int tid = TID_, dk = tid & 127, dvs = tid >> 7, dv = dv0 + dvs;
    const bf16_t* Z = (const bf16_t*)(F.ws + WS_Z); const float* zs = (const float*)(F.ws + WS_ZS);
    LAS float* red = (LAS float*)F.lds;
    const float* wa = inp(I_GLA_WA2) + (size_t)l * 16 * 512 + h * 128 + dk; const float ba = inp(I_GLA_BA)[(size_t)l * 512 + h * 128 + dk];
    float st = 0.f; int ri = 0;
    for (int t = 0; t < S; ++t) {
        float x = ba; for (int r = 0; r < 16; ++r) x += zs[(size_t)t * 64 + ZS_GA + r] * wa[(size_t)r * 512];
        const float la = logsigmoidf(x) * 0.0625f;
        const float k = bf2f(Z[(size_t)t * LDZ + ZC_GK + h * 128 + dk]), v = bf2f(Z[(size_t)t * LDZ + ZC_GV + h * 128 + dv]);
        st = __expf(la) * st + k * v;
        if (ri < 16 && t == DG_ROWS[ri]) {
            const float q = bf2f(Z[(size_t)t * LDZ + ZC_GQ + h * 128 + dk]) * 0.08838834764831845f;
            __syncthreads(); red[tid] = q * st; __syncthreads();
            if (dk == 0) { float o = 0.f; for (int i = 0; i < 128; ++i) o += red[dvs * 128 + i]; ((float*)(F.ws + WS_UT))[((size_t)ri * 4 + h) * 128 + dv] = o; }
            ++ri; }
    }
}
__device__ __forceinline__ void dg_gla_cmp(Frame& F, int l, int ri, int h) {
    const int lane = LANE_, t = DG_ROWS[ri]; const float* go = (const float*)(F.ws + WS_UT) + ((size_t)ri * 4 + h) * 128;
    const float a0 = go[lane], a1 = go[64 + lane]; const float rstd = rsqrtf(wave_sum(a0 * a0 + a1 * a1) * (1.f / 128.f) + 1e-6f);
    const bf16_t* Z = (const bf16_t*)(F.ws + WS_Z) + (size_t)t * LDZ + ZC_GR + h * 128; const float* gn = inp(I_GLA_NORM_G) + (size_t)l * 128;
    const float y0 = a0 * rstd * gn[lane] * siluf(bf2f(Z[lane])), y1 = a1 * rstd * gn[64 + lane] * siluf(bf2f(Z[64 + lane]));
    const bf16_t* MX = (const bf16_t*)(F.ws + WS_MIX) + (size_t)t * DM + 768 + h * 128; const float m0 = bf2f(MX[lane]), m1 = bf2f(MX[64 + lane]);
    dg_add(F, 3, (m0 - y0) * (m0 - y0) + (m1 - y1) * (m1 - y1), y0 * y0 + y1 * y1);
}
__device__ __forceinline__ void dg_topk(Frame& F, int l, int ri, int h) {
    LAS float* L = (LAS float*)F.lds;
    const int lane = LANE_, t = DG_ROWS[ri];
    const bf16_t* QP = (const bf16_t*)(F.ws + WS_QP) + (size_t)t * DM + h * 256; const bf16_t* K1 = (const bf16_t*)(F.ws + WS_KB) + ((size_t)l * 8 + h) * 128 * 128; const bf16_t* K2 = K1 + 2 * 8 * 128 * 128;
    for (int half = 0; half < 2; ++half) for (int n = lane; n < 128; n += 64) { float a = 0.f; const bf16_t* K = half ? K2 : K1;
        for (int d = 0; d < 128; ++d) a += bf2f(QP[half * 128 + d]) * bf2f(K[(size_t)n * 128 + d]); L[half * 128 + n] = a; }
    asm volatile("s_waitcnt lgkmcnt(0)" ::: "memory");
    for (int half = 0; half < 2; ++half) for (int n = lane; n < 128; n += 64) { const float v = L[half * 128 + n]; int rk = 0;
        for (int m = 0; m < 128; ++m) { const float u = L[half * 128 + m]; rk += (u > v || (u == v && m < n)) ? 1 : 0; }
        if (rk < 16) { L[256 + half * 16 + rk] = v; L[288 + half * 16 + rk] = (float)n; } }
    asm volatile("s_waitcnt lgkmcnt(0)" ::: "memory");
    for (int c = lane; c < 256; c += 64) L[320 + c] = L[256 + (c >> 4)] + L[272 + (c & 15)];
    asm volatile("s_waitcnt lgkmcnt(0)" ::: "memory");
    for (int c = lane; c < 256; c += 64) { const float v = L[320 + c]; int rk = 0;
        for (int m = 0; m < 256; ++m) { const float u = L[320 + m]; rk += (u > v || (u == v && m < c)) ? 1 : 0; }
        if (rk < 16) { L[576 + rk] = v; L[592 + rk] = L[288 + (c >> 4)] * 128.f + L[304 + (c & 15)]; } }
    asm volatile("s_waitcnt lgkmcnt(0)" ::: "memory");
    const int* EI = (const int*)(F.ws + WS_EIDX) + ((size_t)t * 8 + h) * 16; const float* GT = (const float*)(F.ws + WS_GATE) + ((size_t)t * 8 + h) * 16;
    float d2 = 0.f, r2 = 0.f;
    if (lane < 16) { float sm = 0.f; for (int i = 0; i < 16; ++i) sm += __expf(L[576 + i] - L[576]); const float g = __expf(L[576 + lane] - L[576]) / sm; const int e = (int)L[592 + lane];
        float gk = 0.f; for (int i = 0; i < 16; ++i) if (EI[i] == e) gk = GT[i];
        d2 = (gk - g) * (gk - g); r2 = g * g; }
    dg_add(F, 4, d2, r2);
}
__device__ __forceinline__ void dg_gather(Frame& F, int l, int ri) {
    const int lane = LANE_, t = DG_ROWS[ri];
    const int* EI = (const int*)(F.ws + WS_EIDX) + (size_t)t * 128; const float* GT = (const float*)(F.ws + WS_GATE) + (size_t)t * 128;
    const unsigned char* UB = (const unsigned char*)(F.ws + WS_UB) + (size_t)l * 16384 * 2048; const unsigned char* VB = (const unsigned char*)(F.ws + WS_VB) + (size_t)l * 16384 * 2048;
    const float* SU = (const float*)(F.ws + WS_SU) + (size_t)l * 16384; const float* SV = (const float*)(F.ws + WS_SV) + (size_t)l * 16384;
    const bf16_t* H = (const bf16_t*)(F.ws + WS_H) + (size_t)t * DM; const float* X = (const float*)(F.ws + WS_X) + (size_t)t * DM; const float* mod = (const float*)(F.ws + WS_MOD) + (size_t)l * NMOD;
    float acc[32];
    for (int i = 0; i < 32; ++i) acc[i] = 0.f;
    for (int k = 0; k < 128; ++k) { const int e = EI[k]; float a = 0.f;
        for (int i = 0; i < 32; ++i) a += bf2f(H[lane + 64 * i]) * fp8f(UB[(size_t)e * 2048 + lane + 64 * i]);
        a = wave_sum(a) * SU[e]; const float w = GT[k] * gelu_tanh(a) * SV[e];
        for (int i = 0; i < 32; ++i) acc[i] += w * fp8f(VB[(size_t)e * 2048 + lane + 64 * i]); }
    float ss = 0.f;
    for (int i = 0; i < 32; ++i) { acc[i] = X[lane + 64 * i] + mod[5 * DM + lane + 64 * i] * acc[i]; ss += acc[i] * acc[i]; }
    const float rstd = rsqrtf(wave_sum(ss) * (1.f / DM) + 1e-6f); float d2 = 0.f, r2 = 0.f;
    for (int i = 0; i < 32; ++i) { const float y = acc[i] * rstd * inp(I_FINAL_G)[lane + 64 * i], o = outp()[(size_t)t * DM + lane + 64 * i]; d2 += (o - y) * (o - y); r2 += y * y; }
    dg_add(F, 5, d2, r2);
}
__device__ __forceinline__ void dg_gemm(Frame& F, int l, int ri) {
    const int lane = LANE_, t = DG_ROWS[ri]; const bf16_t* H = (const bf16_t*)(F.ws + WS_H) + (size_t)t * DM; const bf16_t* W = (const bf16_t*)(F.ws + WS_WQ) + (size_t)l * DM * DM;
    float d2 = 0.f, r2 = 0.f;
    for (int c = lane; c < DM; c += 64 * 7) { float a = 0.f; for (int k = 0; k < DM; ++k) a += bf2f(H[k]) * bf2f(W[(size_t)c * DM + k]);
        const float o = bf2f(((const bf16_t*)(F.ws + WS_QP))[(size_t)t * DM + c]); d2 += (o - a) * (o - a); r2 += a * a; }
    dg_add(F, 6, d2, r2);
}
__device__ __forceinline__ void dg_index(Frame& F, int ri) {
    LAS float* L = (LAS float*)F.lds + 16384;
    const int lane = LANE_, t = DG_ROWS[ri];
    const bf16_t* Z = (const bf16_t*)(F.ws + WS_Z); const float* zs = (const float*)(F.ws + WS_ZS);
    const unsigned long long* MK = (const unsigned long long*)(F.ws + WS_MASK) + (size_t)t * 128;
    for (int j = lane; j <= t; j += 64) { float sc = 0.f;
        for (int h = 0; h < 16; ++h) { float a = 0.f; for (int d = 0; d < 64; ++d) a += bf2f(Z[(size_t)t * LDZ + ZC_IQ + h * 64 + d]) * bf2f(Z[(size_t)j * LDZ + ZC_IK + d]);
            sc += fmaxf(a, 0.f) * (zs[(size_t)t * 64 + ZS_IW + h] * 0.03125f); }
        L[j] = sc; }
    asm volatile("s_waitcnt lgkmcnt(0)" ::: "memory");
    int mism = 0; const int want = (t + 1 < 256) ? t + 1 : 256;
    for (int j = lane; j <= t; j += 64) { const float v = L[j]; int rk = 0;
        for (int m = 0; m <= t; ++m) { const float u = L[m]; rk += (u > v || (u == v && m < j)) ? 1 : 0; }
        const bool sel = rk < 256, bit = (MK[j >> 6] >> (j & 63)) & 1ull; mism += (sel != bit) ? 1 : 0; }
    mism = (int)wave_sum((float)mism);
    dg_add(F, 7, (lane == 0) ? (float)(mism * mism) : 0.f, (lane == 0) ? (float)(4 * want * want) : 0.f);
}
__device__ __forceinline__ void diag_phase(Frame& F, XcdBarrier& bar) {
    const int l = DEPTH - 1, b = blockIdx.x;
    xcd_barrier(bar);
    if (b < 128) { dg_gla(F, l, b >> 5, (b & 31) * 4); }
    else { const int i0 = b - 128;
        if (F.wave == 0) for (int it = i0; it < 16 * 6 * 2 + 16 * 8; it += 128) {
            if (it < 192) dg_attn(F, it / 96, (it % 96) / 6, it % 6); else dg_topk(F, l, (it - 192) >> 3, (it - 192) & 7); }
        if (F.wave == 1) for (int it = i0; it < 32; it += 128) { if (it < 16) dg_gather(F, l, it); else dg_gemm(F, l, it - 16); }
        if (F.wave == 2) for (int it = i0; it < 16; it += 128) dg_index(F, it); }
    xcd_barrier(bar);
    if (b < 8 && F.wave < 8) { const int it = b * 8 + F.wave; dg_gla_cmp(F, l, it >> 2, it & 3); }
    xcd_barrier(bar);
    const float* DG = (const float*)(F.ctl + CW_DG); float worst = 0.f;
    for (int k = 0; k < 8; ++k) if ((DIAG >> k) & 1) { const float d2 = __hip_atomic_load(DG + 2 * k, __ATOMIC_RELAXED, __HIP_MEMORY_SCOPE_AGENT), r2 = __hip_atomic_load(DG + 2 * k + 1, __ATOMIC_RELAXED, __HIP_MEMORY_SCOPE_AGENT);
        worst = fmaxf(worst, sqrtf(d2 / fmaxf(r2, 1e-30f))); }
    const float sc = 1.f + DIAG_AMP * worst; float* O = outp();
    for (size_t i = (size_t)b * 512 + TID_; i < (size_t)S * DM; i += (size_t)F.G * 512) O[i] *= sc;
}
#endif

constexpr int PG_ITEMS = 256 + 32 * 31, PG_LAG = 2, CW_PANEL = 45056;
struct PgTab { unsigned short v[PG_ITEMS]; };
constexpr PgTab make_pg_tab() { PgTab t{}; int n = 0;
    for (int r = 0; r < 32 + PG_LAG; ++r) { int np = (r < 32) ? 8 : 0, ng = (r >= PG_LAG) ? 31 : 0, ip = 0, ig = 0;
        for (int k = 0; ip < np || ig < ng; ++k) { const bool wantp = (k % 5 == 0);
            if ((wantp && ip < np) || ig >= ng) { t.v[n++] = (unsigned short)(r * 8 + ip); ++ip; }
            else { t.v[n++] = (unsigned short)(0x8000 | ((r - PG_LAG) << 5) | ig); ++ig; } } }
    return t; }
__constant__ const PgTab PGTAB = make_pg_tab();
__device__ __forceinline__ void xcd_barrier_bg(const XcdBarrier& b, Frame& F, int bidx) {
    asm volatile("s_waitcnt vmcnt(0)" ::: "memory");
    __syncthreads();
    if (threadIdx.x == 0) {
        unsigned* bar = b.bar;
        __builtin_amdgcn_s_waitcnt(0);
        unsigned nloc = b.st[0], nx = b.st[1];
        if (nloc == 0u) { xcd_barrier_complete(bar, b.x, nloc, nx); b.st[0] = nloc; b.st[1] = nx; }
        const unsigned old = xb_add(&bar[XB_XSUB(b.x)], 1u);
        const unsigned gen = old / nloc;
        if (old + 1u == (gen + 1u) * nloc) {
            __builtin_amdgcn_fence(__ATOMIC_RELEASE, "agent");
            asm volatile("s_waitcnt vmcnt(0)" ::: "memory");
            const unsigned og = xb_add(&bar[XB_TOP], 1u);
            const unsigned tg = og / nx;
            if (og + 1u == (tg + 1u) * nx) xb_add(&bar[XB_TOPGEN], 1u);
            else XB_SPIN(xb_ld(&bar[XB_TOPGEN]) == tg, bar);
            __builtin_amdgcn_fence(__ATOMIC_ACQUIRE, "agent");
            xb_add(&bar[XB_XGEN(b.x)], 1u);
            asm volatile("s_waitcnt vmcnt(0)" ::: "memory");
        } else {
            XB_SPIN(xb_ld(&bar[XB_XGEN(b.x)]) == gen, bar);
            __builtin_amdgcn_fence(__ATOMIC_ACQUIRE, "agent");
            asm volatile("s_waitcnt vmcnt(0)" ::: "memory");
        }
    } else if (F.wave != 0) conv_shadow(F, bidx);
    __syncthreads();
}
constexpr int PH_PRO = 3, PH_PER_LAYER = 8, N_PHASES = PH_PRO + DEPTH * PH_PER_LAYER;

#ifndef LB_T
#define LB_T (NWAVES * 64)
#endif
__global__ void __launch_bounds__(LB_T, 1) mega_fwd(Args args) {
    extern __shared__ __attribute__((aligned(16))) unsigned char lds_raw[];
    Frame F;
    F.lds = (LAS unsigned char*)lds_raw; F.MISC = (volatile LAS unsigned*)(F.lds + MISC_OFF);
    F.wave = __builtin_amdgcn_readfirstlane(TID_ >> 6);
    F.G = gridDim.x; F.gw = blockIdx.x * NWAVES + F.wave; F.NGW = F.G * NWAVES;
    F.ws = (GAS unsigned char*)args.ws; F.ctl = (unsigned*)(F.ws + WS_CTL);
    if (TID_ < 64) F.MISC[TID_] = 0u;
    __syncthreads();
    const int lo = args.ph_lo, hi = args.ph_hi;
    XcdBarrier bar; bar.bar = (unsigned*)F.ctl + CW_BAR; bar.x = 0; bar.st = nullptr;
    if (hi - lo > 1) bar = xcd_barrier_post((unsigned*)F.ctl + CW_BAR, F.MISC + 8);
#define IN(k) (lo <= (k) && (k) < hi)
#if REPEAT_N > 1
#define REPS(k) (((k) == REPEAT_PHASE) ? REPEAT_N : 1)
#define REPBAR() xcd_barrier(bar)
#else
#define REPS(k) 1
#define REPBAR() do {} while (0)
#endif
    const bool conv_sh = CONV_SHADOW && CONV_IN_QUEUES && (hi - lo == N_PHASES) && (F.G == 256) && (REPEAT_N == 1);
    F.nconv = (CONV_IN_QUEUES && !conv_sh) ? CONV_ITEMS : 0;
    int bar_idx = 0;
#define SEAM(k) do { if (IN(k) && IN((k) + 1)) { if (conv_sh && bar_idx < 10) xcd_barrier_bg(bar, F, bar_idx); else xcd_barrier(bar); ++bar_idx; } } while (0)

    if (IN(0)) for (int rep_ = 0; rep_ < REPS(0); ++rep_) { if (rep_) REPBAR();
#if EN_PRO
 p0a_prologue(F);
#endif
 } SEAM(0);
    if (IN(1)) for (int rep_ = 0; rep_ < REPS(1); ++rep_) { if (rep_) REPBAR(); p0b_modreduce(F); } SEAM(1);
    if (IN(2)) for (int rep_ = 0; rep_ < REPS(2); ++rep_) { if (rep_) REPBAR(); const float* mod = (const float*)(F.ws + WS_MOD);
#if WIN_FP8
        if (S % (4 * F.NGW) == 0 && WIN_BF16_TILES == 0) { for (int m = F.gw; m < S; m += 4 * F.NGW) norm_rows<4, true>(inp(I_X), m, F.NGW, inp(I_NORM1_G), mod + DM, mod, nullptr, (unsigned char*)(F.ws + WS_H8), (float*)(F.ws + WS_SA), LANE_); }
        else for (int m = F.gw; m < S; m += F.NGW) norm_row_f8(inp(I_X) + (size_t)m * DM, inp(I_NORM1_G), mod + DM, mod, (unsigned char*)(F.ws + WS_H8) + (size_t)m * DM, (float*)(F.ws + WS_SA) + m, (bf16_t*)(F.ws + WS_H) + (size_t)m * DM, WIN_BF16_TILES != 0, LANE_); } SEAM(2);
#else
        for (int m = F.gw; m < S; m += F.NGW) norm_row(inp(I_X) + (size_t)m * DM, inp(I_NORM1_G), mod + DM, mod, (bf16_t*)(F.ws + WS_H) + (size_t)m * DM, nullptr, LANE_); } SEAM(2);
#endif

#pragma unroll 1
    for (int l = 0; l < DEPTH; ++l) {
        { F.wave = __builtin_amdgcn_readfirstlane(TID_ >> 6);
          int b_ = blockIdx.x; asm volatile("" : "+s"(b_)); F.gw = b_ * NWAVES + F.wave; }
        { GAS unsigned char* wsl = (GAS unsigned char*)args.ws; asm volatile("" : "+s"(wsl)); F.ws = wsl; }
        const int pb = PH_PRO + l * PH_PER_LAYER; const float* mod = (const float*)(F.ws + WS_MOD) + (size_t)l * NMOD;
        if (IN(pb + 0) && !(FUSE_PG && l > 0)) for (int rep_ = 0; rep_ < REPS(pb + 0); ++rep_) { if (rep_) REPBAR();
            pg8::StaticOrder So; So.init(S, LDZ, F.G, (int)blockIdx.x);
#if EN_GEMM
#if WIN_FP8
            constexpr unsigned MB = WIN_BF16_TILES & 0x7fffffffu, M8 = ~MB & 0x7fffffffu; constexpr int NB = __builtin_popcount(MB), N8T = 31 - NB;
            int G_ = F.G, c_ = blockIdx.x; asm volatile("" : "+s"(G_), "+s"(c_));
            { pg8::Gemm gb{(const bf16_t*)(F.ws + WS_H), (const bf16_t*)(F.ws + WS_WIN) + (size_t)l * LDZ * DM, S, LDZ, DM};
              pg8::EpiZ Eb{(bf16_t*)(F.ws + WS_Z), (float*)(F.ws + WS_ZS), LDZ, (bf16_t*)(F.ws + WS_ZH), nullptr, 1.f};
              pg8::SubsetOrder Sb; Sb.o.init(S, NB * 256, G_, c_); Sb.mask = MB;
              pg8::gemm_phase<pg8::EpiZ, pg8::SubsetOrder, true, true>(F.lds, gb, Sb, Eb); }
#if STAGGER_PROBE
            if (bar.x & 1) { for (int i_ = 0; i_ < STAGGER_PROBE; ++i_) __builtin_amdgcn_s_sleep(127); }
#endif
            if (N8T > 0) {
            pg8::Gemm g{(const bf16_t*)(F.ws + WS_H8), (const bf16_t*)(F.ws + WS_WIN8 + (size_t)l * LDZ * DM), S, LDZ, DM / 2};
            const float wam = __uint_as_float(__hip_atomic_load(F.ctl + CW_WAMAX + l, __ATOMIC_RELAXED, __HIP_MEMORY_SCOPE_AGENT));
            pg8::EpiZ E{(bf16_t*)(F.ws + WS_Z), (float*)(F.ws + WS_ZS), LDZ, (bf16_t*)(F.ws + WS_ZH), (const float*)(F.ws + WS_SA), wam > 0.f ? wam * (1.f / 448.f) : 1.f};
#if EPI_PROBE
            E.skip = (rep_ == 0) && (REPS(pb + 0) > 1);
#if EPI_PROBE == 2
            if (E.skip) g.K = DM / 4;
#endif
#endif
            pg8::SplitOrder So2; So2.o.init(S, N8T * 256, G_, c_); So2.mask = M8;
            const int r0 = (32 * NB) % G_, ok8 = (r0 % 8 == 0) && ((G_ - r0) % 8 == 0);
            So2.nlight = ok8 ? r0 : 0; So2.kheavy = (32 * N8T + 2 * So2.nlight + G_ - 1) / G_; So2.klight = So2.kheavy - 2;
            pg8::gemm_phase<pg8::EpiZ, pg8::SplitOrder, true, true, true>(F.lds, g, So2, E); }
#else
            pg8::Gemm g{(const bf16_t*)(F.ws + WS_H), (const bf16_t*)(F.ws + WS_WIN) + (size_t)l * LDZ * DM, S, LDZ, DM};
            pg8::EpiZ E{(bf16_t*)(F.ws + WS_Z), (float*)(F.ws + WS_ZS), LDZ, (bf16_t*)(F.ws + WS_ZH), nullptr, 1.f};
            pg8::gemm_phase<pg8::EpiZ, pg8::StaticOrder, true, true>(F.lds, g, So, E);
#endif
#endif
 } if (!(FUSE_PG && l > 0)) SEAM(pb + 0);
        if (IN(pb + 1)) for (int rep_ = 0; rep_ < REPS(pb + 1); ++rep_) { if (rep_) REPBAR(); const int q = 2 * l + 8 * rep_;
            for (int it = deq(F, q); it < N_IDX_ITEMS + 513 + 64 + F.nconv; it = deq(F, q)) {
                if (it == 0) fox_cumsum_item(F, l);
                else if (it <= 512) {
#if EN_G1
 for (int rr_ = 0; rr_ < REP_G1; ++rr_) gla_g1_item(F, l, it - 1);
#endif
 } else if (it <= 512 + N_IDX_ITEMS) {
#if EN_IDX
 for (int rr_ = 0; rr_ < REP_IDX; ++rr_) indexer_item(F, it - 513);
#endif
 } else if (it < N_IDX_ITEMS + 513 + 64) fox_norm_item(F, l, it - (N_IDX_ITEMS + 513));
                else conv_item(F, l, 0, it - (N_IDX_ITEMS + 513 + 64)); } } SEAM(pb + 1);
        if (IN(pb + 2)) for (int rep_ = 0; rep_ < REPS(pb + 2); ++rep_) { if (rep_) REPBAR();
#if EN_SEL
 phase_select(F, l * (((S / 2 + F.G - 1) / F.G) + NWAVES));
#endif
 } SEAM(pb + 2);
        if (IN(pb + 3)) for (int rep_ = 0; rep_ < REPS(pb + 3); ++rep_) { if (rep_) REPBAR();
#if EN_ATT
 phase_attn(F, l, 2 * l + 1 + 8 * rep_);
#endif
 } SEAM(pb + 3);
        if (IN(pb + 4)) for (int rep_ = 0; rep_ < REPS(pb + 4); ++rep_) { if (rep_) REPBAR();
            pg8::StaticOrder So; So.init(S, DM, F.G, (int)blockIdx.x);
            const float* xin = l == 0 ? inp(I_X) : (const float*)(F.ws + WS_X);
#if EN_GEMM
#if WO_FP8
            const unsigned ovf = __builtin_amdgcn_readfirstlane(__hip_atomic_load(F.ctl + CW_MIXOVF + l, __ATOMIC_RELAXED, __HIP_MEMORY_SCOPE_AGENT));
            if (ovf == 0u) {
                const float wam = __uint_as_float(__hip_atomic_load(F.ctl + CW_WAMAX + 2 + l, __ATOMIC_RELAXED, __HIP_MEMORY_SCOPE_AGENT));
                pg8::Gemm g{(const bf16_t*)(F.ws + WS_MIX8), (const bf16_t*)(F.ws + WS_WO8 + (size_t)l * DM * DM), S, DM, DM / 2};
                pg8::EpiRes E{xin, (float*)(F.ws + WS_X), mod + 2 * DM, DM, (wam > 0.f ? wam * (1.f / 448.f) : 1.f) * (1.f / MIX_S)};
                pg8::gemm_phase<pg8::EpiRes, pg8::StaticOrder, true, true, true>(F.lds, g, So, E);
            } else
#endif
            { pg8::Gemm g{(const bf16_t*)(F.ws + WS_MIX), (const bf16_t*)(F.ws + WS_WO) + (size_t)l * DM * DM, S, DM, DM};
              pg8::EpiRes E{xin, (float*)(F.ws + WS_X), mod + 2 * DM, DM, 1.f};
              pg8::gemm_phase<pg8::EpiRes, pg8::StaticOrder, true, true>(F.lds, g, So, E); }
#endif
 } SEAM(pb + 4);
        if (IN(pb + 5)) for (int rep_ = 0; rep_ < REPS(pb + 5); ++rep_) { if (rep_) REPBAR(); if (S % (4 * F.NGW) == 0) { for (int m = F.gw; m < S; m += 4 * F.NGW) norm_rows<4, false>((const float*)(F.ws + WS_X), m, F.NGW, inp(I_NORM2_G) + (size_t)l * DM, mod + 4 * DM, mod + 3 * DM, (bf16_t*)(F.ws + WS_H), nullptr, nullptr, LANE_); }
            else for (int m = F.gw; m < S; m += F.NGW) norm_row((const float*)(F.ws + WS_X) + (size_t)m * DM, inp(I_NORM2_G) + (size_t)l * DM, mod + 4 * DM, mod + 3 * DM, (bf16_t*)(F.ws + WS_H) + (size_t)m * DM, nullptr, LANE_); } SEAM(pb + 5);
        if (IN(pb + 6)) for (int rep_ = 0; rep_ < REPS(pb + 6); ++rep_) { if (rep_) REPBAR(); pg8::Gemm g{(const bf16_t*)(F.ws + WS_H), (const bf16_t*)(F.ws + WS_WQ) + (size_t)l * DM * DM, S, DM, DM};
            pg8::StaticOrder So; So.init(S, DM, F.G, (int)blockIdx.x); pg8::EpiBf16<0> E{(bf16_t*)(F.ws + WS_QP), DM, nullptr, 0, 0, 1.f};
#if EN_GEMM
            pg8::gemm_phase<pg8::EpiBf16<0>, pg8::StaticOrder, true, true>(F.lds, g, So, E);
#endif
 } SEAM(pb + 6);
        if (IN(pb + 7)) for (int rep_ = 0; rep_ < REPS(pb + 7); ++rep_) { if (rep_) REPBAR();
#if EN_TOPK && EN_GATHER
            if (FUSE_PG && l + 1 < DEPTH) {
                const int q = 4 + l;
                for (int it = deq(F, q); it < PG_ITEMS; it = deq(F, q)) {
                    const int code = __builtin_amdgcn_readfirstlane((int)PGTAB.v[it]);
                    if (!(code & 0x8000)) { const int tb = code;
                        peer_topk_item(F, l, tb * 8 + F.wave);
                        asm volatile("s_waitcnt vmcnt(0)" ::: "memory"); __syncthreads();
                        peer_gather_group<2>(F, l, tb * 32 + F.wave * 4, 1);
                        peer_gather_group<2>(F, l, tb * 32 + F.wave * 4 + 2, 1);
                        asm volatile("s_waitcnt vmcnt(0)" ::: "memory"); __syncthreads();
                        if (TID_ == 0) { __builtin_amdgcn_fence(__ATOMIC_RELEASE, "agent"); asm volatile("s_waitcnt vmcnt(0)" ::: "memory");
                            __hip_atomic_fetch_add(F.ctl + CW_PANEL + 64 * l + (tb >> 3), 1u, __ATOMIC_RELAXED, __HIP_MEMORY_SCOPE_AGENT); }
                    } else { const int pm = (code & 0x7fff) >> 5, pn = code & 31;
                        if (TID_ == 0) { unsigned sp = 0;
                            while (__hip_atomic_load(F.ctl + CW_PANEL + 64 * l + pm, __ATOMIC_RELAXED, __HIP_MEMORY_SCOPE_AGENT) < 8u) { __builtin_amdgcn_s_sleep(8); if (++sp > (1u << 24)) break; }
                            __builtin_amdgcn_fence(__ATOMIC_ACQUIRE, "agent"); asm volatile("s_waitcnt vmcnt(0)" ::: "memory"); }
                        __syncthreads();
                        pg8::Gemm g{(const bf16_t*)(F.ws + WS_H), (const bf16_t*)(F.ws + WS_WIN) + (size_t)(l + 1) * LDZ * DM, S, LDZ, DM};
                        pg8::OneUnit So{{pm, pn}}; pg8::EpiZ E{(bf16_t*)(F.ws + WS_Z), (float*)(F.ws + WS_ZS), LDZ, (bf16_t*)(F.ws + WS_ZH)};
                        pg8::gemm_phase<pg8::EpiZ, pg8::OneUnit, true, true>(F.lds, g, So, E);
                    }
                }
            } else
            for (int tb = blockIdx.x; tb < S / 32; tb += F.G) {
#if TOPK_PROBE
                peer_topk_item(F, l, tb * 8 + F.wave); __builtin_amdgcn_sched_barrier(0);
#endif
                peer_topk_item(F, l, tb * 8 + F.wave);
                asm volatile("s_waitcnt vmcnt(0)" ::: "memory"); __syncthreads();
#if GATHER_PROBE
                peer_gather_group<2, GATHER_PROBE>(F, l, tb * 32 + F.wave * 4, 1);
                peer_gather_group<2, GATHER_PROBE>(F, l, tb * 32 + F.wave * 4 + 2, 1);
#endif
#if PEER_SWEEP_ALIGN
                peer_gather_group<2, 0, 1>(F, l, tb * 32 + F.wave * 4, 1, 0);
                peer_gather_group<2, 0, 1>(F, l, tb * 32 + F.wave * 4 + 2, 1, 1);
                peer_gather_group<2, 0, 2>(F, l, tb * 32 + F.wave * 4, 1, 0);
                peer_gather_group<2, 0, 2>(F, l, tb * 32 + F.wave * 4 + 2, 1, 1);
#else
                peer_gather_group<2>(F, l, tb * 32 + F.wave * 4, 1);
                peer_gather_group<2>(F, l, tb * 32 + F.wave * 4 + 2, 1);
#endif
                __syncthreads(); }
#endif
        } SEAM(pb + 7);
    }
#if DIAG
    diag_phase(F, bar);
#endif
#undef IN
#undef SEAM
}

extern "C" void kernel_launch(void* const* d_in, const int* in_sizes, int n_in, void* d_out, int out_size, void* d_ws, size_t ws_size, hipStream_t stream) {
    static int grid = 0;
    if (grid == 0) {
        if (n_in != 18 || out_size != S * DM || ws_size < WS_END) { fprintf(stderr, "kernel_launch: unexpected shapes (n_in %d out %d ws %zu)\n", n_in, out_size, ws_size); grid = -1; return; }
        int dev = 0, cus = 0, per_cu = 0;
        if (hipGetDevice(&dev) != hipSuccess || hipDeviceGetAttribute(&cus, hipDeviceAttributeMultiprocessorCount, dev) != hipSuccess) { grid = -1; return; }
        if (hipFuncSetAttribute((const void*)mega_fwd, hipFuncAttributeMaxDynamicSharedMemorySize, LDS_BYTES) != hipSuccess) { fprintf(stderr, "kernel_launch: hipFuncSetAttribute failed\n"); grid = -1; return; }
        if (hipOccupancyMaxActiveBlocksPerMultiprocessor(&per_cu, (const void*)mega_fwd, NWAVES * 64, LDS_BYTES) != hipSuccess || per_cu < 1) { fprintf(stderr, "kernel_launch: occupancy query says %d blocks per CU\n", per_cu); (void)hipGetLastError(); }
        grid = cus;
    }
    if (grid < 0) return;
    (void)in_sizes;
    if (hipMemsetAsync((char*)d_ws + WS_CTL, 0, CTL_ZERO_BYTES, stream) != hipSuccess) { fprintf(stderr, "kernel_launch: memset failed\n"); return; }
    Args a{};
    for (int i = 0; i < 18; ++i) a.in[i] = (const float*)d_in[i];
    a.out = (float*)d_out; a.ws = (unsigned char*)d_ws;
#if MK_MULTI
    for (int ph = 0; ph < N_PHASES; ++ph) { a.ph_lo = ph; a.ph_hi = ph + 1; hipLaunchKernelGGL(mega_fwd, dim3(grid), dim3(NWAVES * 64), LDS_BYTES, stream, a); }
#else
    a.ph_lo = 0; a.ph_hi = N_PHASES;
#if MK_COOP
    void* kargs[] = {(void*)&a};
    hipError_t e = hipLaunchCooperativeKernel((const void*)mega_fwd, dim3(grid), dim3(NWAVES * 64), kargs, LDS_BYTES, stream);
    if (e != hipSuccess) fprintf(stderr, "kernel_launch: cooperative launch failed: %s (grid %d)\n", hipGetErrorString(e), grid);
#else
    hipLaunchKernelGGL(mega_fwd, dim3(grid), dim3(NWAVES * 64), LDS_BYTES, stream, a);
#endif
#endif
}
```

```cpp
#include <hip/hip_runtime.h>
#include <hip/hip_bf16.h>
#include <hip/hip_cooperative_groups.h>
#include <cstdio>
#include <cstdint>
#include <cmath>

#ifndef MK_MULTI
#define MK_MULTI 0
#endif

#ifndef EN_ALL
#define EN_ALL 1
#endif
#ifndef EN_PRO
#define EN_PRO EN_ALL
#endif
#ifndef EN_GEMM
#define EN_GEMM EN_ALL
#endif
#ifndef EN_IDX
#define EN_IDX EN_ALL
#endif
#ifndef EN_G1
#define EN_G1 EN_ALL
#endif
#ifndef EN_SEL
#define EN_SEL EN_ALL
#endif
#ifndef EN_ATT
#define EN_ATT EN_ALL
#endif
#ifndef EN_TOPK
#define EN_TOPK EN_ALL
#endif
#ifndef EN_GATHER
#define EN_GATHER EN_ALL
#endif
#ifndef DIAG
#define DIAG 0
#endif
#ifndef REPEAT_N
#define REPEAT_N 1
#define REPEAT_PHASE -1
#endif
#ifndef REP_IDX
#define REP_IDX 1
#endif
#ifndef REP_G1
#define REP_G1 1
#endif
#ifndef REP_SEL
#define REP_SEL 1
#endif
#ifndef MK_COOP
#define MK_COOP 1
#endif
#ifndef WT_STORES
#define WT_STORES 0
#endif
#ifndef REP_G3
#define REP_G3 1
#endif
#ifndef FUSE_PG
#define FUSE_PG 0
#endif
#ifndef REP_FOX
#define REP_FOX 1
#endif
#ifndef WIN_FP8
#define WIN_FP8 1
#endif
#ifndef WIN_BF16_TILES
#define WIN_BF16_TILES 0x00000000u
#endif
#ifndef GATHER_PROBE
#define GATHER_PROBE 0
#endif
#ifndef CONV_IN_QUEUES
#define CONV_IN_QUEUES 1
#endif
#ifndef EPI_PROBE
#define EPI_PROBE 0
#endif
#ifndef WT_EPI
#define WT_EPI 0
#endif
#ifndef WO_FP8
#define WO_FP8 0
#endif
#define MIX_S 8.0f
#ifndef TOPK_PROBE
#define TOPK_PROBE 0
#endif
#ifndef CONV_SHADOW
#define CONV_SHADOW 0
#endif
#ifndef PEER_U_MFMA
#define PEER_U_MFMA 0
#endif
#ifndef PEER_NIBSWAP
#define PEER_NIBSWAP 0
#endif
#ifndef PEER_U_CHECK
#define PEER_U_CHECK 0
#endif
#ifndef PROBE_FQ
#define PROBE_FQ 0
#endif
#ifndef PROBE_T
#define PROBE_T 0
#endif
#ifndef PEER_U_INT4
#define PEER_U_INT4 1
#endif
#ifndef PEER_SWEEP_ALIGN
#define PEER_SWEEP_ALIGN 1
#endif
#ifndef PEER_PIPE
#define PEER_PIPE 0
#endif
#ifndef ATT_STATIC_PRIO
#define ATT_STATIC_PRIO 1
#endif
#ifndef STAGGER_PROBE
#define STAGGER_PROBE 0
#endif
#ifndef ATT_QPIN
#define ATT_QPIN 0
#endif
#ifndef ATT_QH
#define ATT_QH 3
#endif
#ifndef ATT_PV_SPLIT
#define ATT_PV_SPLIT 0
#endif
#ifndef PEER_U4
#define PEER_U4 1
#endif

namespace pg8 {
#define PG8_LAS __attribute__((address_space(3)))
typedef unsigned short bf16_t;
typedef short bf16x8 __attribute__((ext_vector_type(8)));
typedef float f32x4 __attribute__((ext_vector_type(4)));
typedef unsigned u32x4 __attribute__((ext_vector_type(4)));
typedef int i32x4 __attribute__((ext_vector_type(4)));
constexpr int BM = 256, BK = 64, HALF = 128, HTB = HALF * BK * 2  , STAGE_BYTES = 8 * HTB, NXCD = 8, WGM = 8;

__host__ __device__ __forceinline__ int lds_byte(int r, int c) { const int st = (r >> 4) * 2 + (c >> 5), rr = r & 15, cc = c & 31, ob = rr * 64 + cc * 2; return st * 1024 + (ob ^ (((ob >> 9) & 1) << 5)); }
__host__ __device__ __forceinline__ void stage_rc(int b, int& R, int& C) { const int st = b / 1024, sb = b % 1024, swz = sb ^ (((sb >> 9) & 1) << 5); R = (st >> 1) * 16 + swz / 64; C = (st & 1) * 32 + (swz % 64) / 2; }
__host__ __device__ __forceinline__ int perm32(int rho) { const int n = rho >> 4, i = rho & 15; return 8 * (i >> 2) + 4 * n + (i & 3); }

struct Unit { int pm, pn; };
struct Gemm { const bf16_t* A; const bf16_t* Bt; int M, N, K; };

struct StaticOrder {
    int nM, nN, nwg, G, c;
    __host__ __device__ void init(int M, int N, int G_, int c_) { nM = M / BM; nN = N / BM; nwg = nM * nN; G = G_; c = c_; }
    __host__ __device__ bool next(int i, Unit& u) const { const long L = (long)i * G + c; if (L >= nwg) return false; map((int)L, u); return true; }
    __host__ __device__ void map(int L, Unit& u) const {
        int wgid = L; { const int q = nwg / NXCD, r = nwg % NXCD, xcd = wgid % NXCD, off = wgid / NXCD; wgid = (xcd < r ? xcd * (q + 1) : r * (q + 1) + (xcd - r) * q) + off; }
        const int nig = WGM * nN, gid = wgid / nig, fm = gid * WGM, gsz = (nM - fm) < WGM ? (nM - fm) : WGM;
        u.pm = fm + ((wgid % nig) % gsz); u.pn = (wgid % nig) / gsz;
    }
    __device__ __forceinline__ void a_ready(const Unit&) const {}
    __device__ __forceinline__ void done(const Unit&) const {}
};

__host__ __device__ __forceinline__ int kth_tile(unsigned mask, int k) { int t = 0; for (;; ++t) if ((mask >> t) & 1u) { if (k == 0) break; --k; } return t; }
struct SubsetOrder { StaticOrder o; unsigned mask;
    __host__ __device__ bool next(int i, Unit& u) const { if (!o.next(i, u)) return false; u.pn = kth_tile(mask, u.pn); return true; }
    __device__ __forceinline__ void a_ready(const Unit&) const {}
    __device__ __forceinline__ void done(const Unit&) const {} };
struct SplitOrder {
    StaticOrder o; unsigned mask; int nlight, klight, kheavy;
    __host__ __device__ bool next(int i, Unit& u) const {
        const int nh = o.G - nlight; int L;
        if (o.c >= nlight) { if (i >= kheavy) return false; L = i * nh + (o.c - nlight); } else { if (i >= klight) return false; L = kheavy * nh + i * nlight + o.c; }
        if (L >= o.nwg) return false; o.map(L, u); u.pn = kth_tile(mask, u.pn); return true; }
    __device__ __forceinline__ void a_ready(const Unit&) const {}
    __device__ __forceinline__ void done(const Unit&) const {}
};
struct MaybeUnit { Unit u; bool has;
    __device__ __forceinline__ bool next(int i, Unit& o) const { if (i || !has) return false; o = u; return true; }
    __device__ __forceinline__ void a_ready(const Unit&) const {}
    __device__ __forceinline__ void done(const Unit&) const {} };

__device__ __forceinline__ void epi_store16(void* p, u32x4 v) {
#if WT_EPI
    asm volatile("global_store_dwordx4 %0, %1, off sc0 sc1" :: "v"(p), "v"(v) : "memory");
#else
    *(u32x4*)p = v;
#endif
}
__device__ __forceinline__ unsigned cvt_pk_bf16(float lo, float hi) { unsigned r; asm volatile("v_cvt_pk_bf16_f32 %0, %1, %2" : "=v"(r) : "v"(lo), "v"(hi)); return r; }
typedef float f32x2 __attribute__((ext_vector_type(2)));
__device__ __forceinline__ f32x2 gelu_pk(f32x2 v) {
    const f32x2 av = __builtin_elementwise_abs(v), d = av * 0.2316418882f + 1.0f;
    f32x2 t; t.x = __builtin_amdgcn_rcpf(d.x); t.y = __builtin_amdgcn_rcpf(d.y);
    f32x2 q = t * 0.5307027145f + (-0.7265760135f); q = q * t + 0.7107068705f; q = q * t + (-0.142248368f); q = q * t + 0.127414796f; q = q * t;
    const f32x2 s = (v * v) * (-0.72134752044f);
    f32x2 e; e.x = __builtin_amdgcn_exp2f(s.x); e.y = __builtin_amdgcn_exp2f(s.y);
    const f32x2 m = v * (q * e), r = v - m;
    f32x2 o; o.x = v.x < 0.f ? m.x : r.x; o.y = v.y < 0.f ? m.y : r.y; return o;
}

template <int ACT  > struct EpiBf16 {
    static constexpr bool PERM = true, AFTER_DRAIN = false; static_assert(ACT == 0 || ACT == 1, "EpiBf16: ACT is 0 (none) or 1 (gelu_pk)");
    bf16_t* O; int ldc; const float* bias; int split_cols; size_t split_stride; float scale0;
    __device__ __forceinline__ void operator()(const f32x4 (&acc)[2][2][4][2], const Unit& u, int wr, int wc, int fr, int fq) const {
        const int row0 = u.pm * BM + wr * 64 + fr; int colt = u.pn * BM; bf16_t* base = O;
        float sc = 1.f; if (split_cols) { const int t = colt / split_cols; base += (size_t)t * split_stride; colt -= t * split_cols; if (t == 0) sc = scale0; }
        const int col0 = colt + wc * 32 + 8 * fq, bcol0 = u.pn * BM + wc * 32 + 8 * fq;
        f32x4 bv[2][2];
#pragma unroll
        for (int bj = 0; bj < 2; ++bj)
#pragma unroll
            for (int n = 0; n < 2; ++n) bv[bj][n] = bias ? *(const f32x4*)(bias + bcol0 + bj * HALF + 4 * n) : (f32x4){0.f, 0.f, 0.f, 0.f};
#pragma unroll
        for (int ai = 0; ai < 2; ++ai)
#pragma unroll
            for (int m = 0; m < 4; ++m) { bf16_t* rowp = base + (size_t)(row0 + ai * HALF + m * 16) * ldc + col0;
#pragma unroll
                for (int bj = 0; bj < 2; ++bj) { f32x4 v0 = acc[ai][bj][m][0] + bv[bj][0], v1 = acc[ai][bj][m][1] + bv[bj][1];
                    if (ACT == 1) { f32x2 a = gelu_pk((f32x2){v0[0], v0[1]}), b = gelu_pk((f32x2){v0[2], v0[3]}), c = gelu_pk((f32x2){v1[0], v1[1]}), d = gelu_pk((f32x2){v1[2], v1[3]});
                        v0 = (f32x4){a.x, a.y, b.x, b.y}; v1 = (f32x4){c.x, c.y, d.x, d.y}; }
                    v0 = v0 * sc; v1 = v1 * sc; u32x4 w; w.x = cvt_pk_bf16(v0[0], v0[1]); w.y = cvt_pk_bf16(v0[2], v0[3]); w.z = cvt_pk_bf16(v1[0], v1[1]); w.w = cvt_pk_bf16(v1[2], v1[3]);
                    epi_store16(rowp + bj * HALF, w); } }
    }
};

typedef int i32x8 __attribute__((ext_vector_type(8)));
template <bool F8> struct Frag2;
template <> struct Frag2<false> { bf16x8 k[2];
    __device__ __forceinline__ void load(const PG8_LAS unsigned char* p) { k[0] = *(const PG8_LAS bf16x8*)p; k[1] = *(const PG8_LAS bf16x8*)(p + 1024); } };
template <> struct Frag2<true> { i32x8 v;
    __device__ __forceinline__ void load(const PG8_LAS unsigned char* p) { const i32x4 a = *(const PG8_LAS i32x4*)p, b = *(const PG8_LAS i32x4*)(p + 1024); v = __builtin_shufflevector(a, b, 0, 1, 2, 3, 4, 5, 6, 7); } };
__device__ __forceinline__ f32x4 frag_mma(const Frag2<false>& b, const Frag2<false>& a, f32x4 c) { c = __builtin_amdgcn_mfma_f32_16x16x32_bf16(b.k[0], a.k[0], c, 0, 0, 0); return __builtin_amdgcn_mfma_f32_16x16x32_bf16(b.k[1], a.k[1], c, 0, 0, 0); }
__device__ __forceinline__ f32x4 frag_mma(const Frag2<true>& b, const Frag2<true>& a, f32x4 c) { asm volatile("v_mfma_f32_16x16x128_f8f6f4 %0, %1, %2, %0" : "+v"(c) : "v"(b.v), "v"(a.v)); return c; }
template <class Epi, class Sched, bool ALIGN_EPI = false, bool SP2 = false, bool F8 = false>
__device__ __forceinline__ void gemm_phase(PG8_LAS unsigned char* lds, const Gemm g, const Sched& S, const Epi& E) {
    int tid = threadIdx.x; asm volatile("" : "+v"(tid));
    const int wid = __builtin_amdgcn_readfirstlane(tid >> 6), lane = tid & 63, wr = wid >> 2, wc = wid & 3, fr = lane & 15, fq = lane >> 4;
    const int K = g.K, nt = K / BK;
    unsigned voffA[2], voffB[2];
#pragma unroll
    for (int i = 0; i < 2; ++i) { int R, C; stage_rc(tid * 16 + i * 8192, R, C); const int Rb = Epi::PERM ? ((R & ~31) + perm32(R & 31)) : R;
        voffA[i] = (unsigned)(R * K + C) * 2u; voffB[i] = (unsigned)(Rb * K + C) * 2u; }
    const size_t kstep = (size_t)(BK * 2);
    const size_t hstep = (size_t)HALF * K * 2;
    const size_t tstep = 2 * hstep;
    const unsigned ldsw = (unsigned)wid * 1024u;
    const int aoff = lds_byte(wr * 64 + fr, fq * 8), boff = lds_byte(wc * 32 + fr, fq * 8);
#define PG8_SA(b, h) (((b) * 2 + (h)) * HTB)
#define PG8_SB(b, h) ((4 + (b) * 2 + (h)) * HTB)
#define PG8_STAGE(bufoff, gbase, voff) do { _Pragma("unroll") for (int _i = 0; _i < 2; ++_i) \
        __builtin_amdgcn_global_load_lds((const unsigned*)((const char*)(gbase) + (voff)[_i]), (PG8_LAS unsigned*)(lds + (bufoff) + ldsw + _i * 8192), 16, 0, 0); } while (0)
#define PG8_LDA(dst, b, h) do { _Pragma("unroll") for (int m = 0; m < 4; ++m) dst[m].load(lds + PG8_SA(b, h) + aoff + m * 2048); } while (0)
#define PG8_LDB(dst, b, h) do { _Pragma("unroll") for (int n = 0; n < 2; ++n) dst[n].load(lds + PG8_SB(b, h) + boff + n * 2048); } while (0)
#define PG8_MMA(ai, bj, At, Bt) do { __builtin_amdgcn_s_setprio(1); _Pragma("unroll") for (int m = 0; m < 4; ++m) _Pragma("unroll") for (int n = 0; n < 2; ++n) \
        acc[ai][bj][m][n] = frag_mma(Bt[n], At[m], acc[ai][bj][m][n]); __builtin_amdgcn_s_setprio(0); } while (0)
#define PG8_WAIT_V(n) asm volatile("s_waitcnt vmcnt(" #n ")" ::: "memory")
#define PG8_WAIT_L(n) asm volatile("s_waitcnt lgkmcnt(" #n ")" ::: "memory")
#define PG8_BAR __builtin_amdgcn_s_barrier()
#define PG8_SCHED __builtin_amdgcn_sched_barrier(0)
    Unit cur, nxt; int ui = 0;
    if (!S.next(0, cur)) return;
    f32x4 acc[2][2][4][2];
#pragma unroll
    for (int a = 0; a < 2; ++a)
#pragma unroll
        for (int b = 0; b < 2; ++b)
#pragma unroll
            for (int m = 0; m < 4; ++m)
#pragma unroll
                for (int n = 0; n < 2; ++n) acc[a][b][m][n] = (f32x4){0.f, 0.f, 0.f, 0.f};
    Frag2<F8> At[4], B0[2], B1[2];
    const char* cA = (const char*)g.A + (size_t)cur.pm * tstep; const char* cB = (const char*)g.Bt + (size_t)cur.pn * tstep;
    S.a_ready(cur);
    if constexpr (SP2) {
        PG8_STAGE(PG8_SB(0, 0), cB, voffB); PG8_STAGE(PG8_SB(0, 1), cB + hstep, voffB); PG8_STAGE(PG8_SA(0, 0), cA, voffA); PG8_STAGE(PG8_SA(0, 1), cA + hstep, voffA);
        if (wr == 1) PG8_BAR;
        PG8_WAIT_V(2); PG8_BAR;
        PG8_STAGE(PG8_SB(1, 0), cB + kstep, voffB); PG8_STAGE(PG8_SA(1, 0), cA + kstep, voffA); PG8_STAGE(PG8_SB(1, 1), cB + hstep + kstep, voffB);
        PG8_WAIT_V(6); PG8_BAR;
    } else {
        PG8_STAGE(PG8_SB(0, 0), cB, voffB); PG8_STAGE(PG8_SA(0, 0), cA, voffA); PG8_STAGE(PG8_SB(0, 1), cB + hstep, voffB); PG8_STAGE(PG8_SA(0, 1), cA + hstep, voffA);
        if (wr == 1) PG8_BAR;
        PG8_WAIT_V(4); PG8_BAR;
        PG8_STAGE(PG8_SB(1, 0), cB + kstep, voffB); PG8_STAGE(PG8_SA(1, 0), cA + kstep, voffA); PG8_STAGE(PG8_SB(1, 1), cB + hstep + kstep, voffB);
        PG8_WAIT_V(6); PG8_BAR;
    }
    for (;;) {
        const bool has_next = S.next(ui + 1, nxt);
        const char* nA = has_next ? (const char*)g.A + (size_t)nxt.pm * tstep : cA; const char* nB = has_next ? (const char*)g.Bt + (size_t)nxt.pn * tstep : cB;
        for (int t = 0; t < nt; t += 2) {
            const bool last = (t == nt - 2);
            const char* a1 = cA + (size_t)(t + 1) * kstep;
            const char* a2 = last ? nA : cA + (size_t)(t + 2) * kstep; const char* b2 = last ? nB : cB + (size_t)(t + 2) * kstep;
            const char* a3 = a2 + kstep; const char* b3 = b2 + kstep;
            if (last && has_next) S.a_ready(nxt);
            if constexpr (SP2) {
            PG8_LDB(B0, 0, 0); PG8_LDB(B1, 0, 1); PG8_SCHED; PG8_LDA(At, 0, 0); PG8_STAGE(PG8_SA(1, 1), a1 + hstep, voffA);
            PG8_WAIT_V(8); PG8_WAIT_L(0); PG8_BAR; PG8_MMA(0, 0, At, B0); PG8_MMA(0, 1, At, B1); PG8_BAR; PG8_SCHED;
            PG8_LDA(At, 0, 1); PG8_STAGE(PG8_SB(0, 0), b2, voffB); PG8_STAGE(PG8_SB(0, 1), b2 + hstep, voffB); PG8_STAGE(PG8_SA(0, 0), a2, voffA);
            PG8_WAIT_V(8); PG8_WAIT_L(0); PG8_BAR; PG8_MMA(1, 0, At, B0); PG8_MMA(1, 1, At, B1); PG8_BAR; PG8_SCHED;
            PG8_LDB(B0, 1, 0); PG8_LDB(B1, 1, 1); PG8_SCHED; PG8_LDA(At, 1, 0); PG8_STAGE(PG8_SA(0, 1), a2 + hstep, voffA);
            PG8_WAIT_V(8); PG8_WAIT_L(0); PG8_BAR; PG8_MMA(0, 0, At, B0); PG8_MMA(0, 1, At, B1); PG8_BAR; PG8_SCHED;
            PG8_LDA(At, 1, 1); PG8_STAGE(PG8_SB(1, 0), b3, voffB); PG8_STAGE(PG8_SB(1, 1), b3 + hstep, voffB); PG8_STAGE(PG8_SA(1, 0), a3, voffA);
            PG8_WAIT_V(8); PG8_WAIT_L(0); PG8_BAR; PG8_MMA(1, 0, At, B0); PG8_MMA(1, 1, At, B1); PG8_BAR; PG8_SCHED;
            } else {
            PG8_LDB(B0, 0, 0); PG8_SCHED; PG8_LDA(At, 0, 0); PG8_STAGE(PG8_SA(1, 1), a1 + hstep, voffA);
            PG8_WAIT_L(8); PG8_BAR; PG8_WAIT_L(0); PG8_MMA(0, 0, At, B0); PG8_BAR; PG8_SCHED;
            PG8_LDB(B1, 0, 1); PG8_STAGE(PG8_SB(0, 0), b2, voffB);
            PG8_BAR; PG8_WAIT_L(0); PG8_MMA(0, 1, At, B1); PG8_BAR;
            PG8_LDA(At, 0, 1); PG8_STAGE(PG8_SA(0, 0), a2, voffA);
            PG8_BAR; PG8_WAIT_L(0); PG8_MMA(1, 0, At, B0); PG8_BAR; PG8_SCHED;
            PG8_STAGE(PG8_SB(0, 1), b2 + hstep, voffB);
            PG8_WAIT_V(6); PG8_BAR; PG8_MMA(1, 1, At, B1); PG8_BAR;
            PG8_LDB(B0, 1, 0); PG8_SCHED; PG8_LDA(At, 1, 0); PG8_STAGE(PG8_SA(0, 1), a2 + hstep, voffA);
            PG8_WAIT_L(8); PG8_BAR; PG8_WAIT_L(0); PG8_MMA(0, 0, At, B0); PG8_BAR; PG8_SCHED;
            PG8_LDB(B1, 1, 1); PG8_STAGE(PG8_SB(1, 0), b3, voffB);
            PG8_BAR; PG8_WAIT_L(0); PG8_MMA(0, 1, At, B1); PG8_BAR;
            PG8_LDA(At, 1, 1); PG8_STAGE(PG8_SA(1, 0), a3, voffA);
            PG8_BAR; PG8_WAIT_L(0); PG8_MMA(1, 0, At, B0); PG8_BAR; PG8_SCHED;
            PG8_STAGE(PG8_SB(1, 1), b3 + hstep, voffB);
            PG8_WAIT_V(6); PG8_BAR; PG8_MMA(1, 1, At, B1); PG8_BAR;
            }
        }
        if constexpr (F8) asm volatile("s_nop 15\n\ts_nop 15" ::: "memory");
        if constexpr (ALIGN_EPI) { if (wr == 0) PG8_BAR; }
        if constexpr (!Epi::AFTER_DRAIN) { E(acc, cur, wr, wc, fr, fq); S.done(cur); }
        if (!has_next) break;
#pragma unroll
        for (int a = 0; a < 2; ++a)
#pragma unroll
            for (int b = 0; b < 2; ++b)
#pragma unroll
                for (int m = 0; m < 4; ++m)
#pragma unroll
                    for (int n = 0; n < 2; ++n) acc[a][b][m][n] = (f32x4){0.f, 0.f, 0.f, 0.f};
        cur = nxt; cA = nA; cB = nB; ++ui;
        if constexpr (ALIGN_EPI) { if (wr == 1) PG8_BAR; }
    }
    PG8_WAIT_V(0);
    if constexpr (!ALIGN_EPI) { if (wr == 0) PG8_BAR; }
    PG8_BAR;
    if constexpr (Epi::AFTER_DRAIN) { E.fused(acc, cur, wr, wc, fr, fq, lds, wid, lane); S.done(cur); }
#undef PG8_SA
#undef PG8_SB
#undef PG8_STAGE
#undef PG8_LDA
#undef PG8_LDB
#undef PG8_MMA
#undef PG8_WAIT_V
#undef PG8_WAIT_L
#undef PG8_BAR
#undef PG8_SCHED
}
}

namespace pg8 {
struct EpiZ {
    static constexpr bool PERM = true, AFTER_DRAIN = false;
    bf16_t* Z; float* zs; int ldz; bf16_t* ZH; const float* sa; float sw; bool skip = false;
    __device__ __forceinline__ void operator()(const f32x4 (&acc)[2][2][4][2], const Unit& u, int wr, int wc, int fr, int fq) const {
        if (skip) return;
        asm volatile("" : "+v"(fr), "+v"(fq));
        const int row0 = u.pm * BM + wr * 64 + fr, col0 = u.pn * BM + wc * 32 + 8 * fq;
        float rsv[2][4];
#pragma unroll
        for (int ai = 0; ai < 2; ++ai)
#pragma unroll
            for (int m = 0; m < 4; ++m) rsv[ai][m] = sa ? sa[row0 + ai * HALF + m * 16] : 1.f;
        __builtin_amdgcn_sched_barrier(0);
#pragma unroll
        for (int ai = 0; ai < 2; ++ai)
#pragma unroll
            for (int m = 0; m < 4; ++m) rsv[ai][m] *= sa ? sw : 1.f;
        __builtin_amdgcn_sched_barrier(0);
#pragma unroll
        for (int ai = 0; ai < 2; ++ai)
#pragma unroll
            for (int m = 0; m < 4; ++m) { const int row = row0 + ai * HALF + m * 16; bf16_t* rowp = Z + (size_t)row * ldz + col0; const float rs = rsv[ai][m];
#pragma unroll
                for (int bj = 0; bj < 2; ++bj) { const f32x4 v0 = acc[ai][bj][m][0] * rs, v1 = acc[ai][bj][m][1] * rs;
                    u32x4 w; w.x = cvt_pk_bf16(v0[0], v0[1]); w.y = cvt_pk_bf16(v0[2], v0[3]); w.z = cvt_pk_bf16(v1[0], v1[1]); w.w = cvt_pk_bf16(v1[2], v1[3]);
                    const int col = col0 + bj * HALF, cb = u.pn * BM + bj * HALF;
                    if (cb < 2304 || (cb >= 4352 && cb < 6656)) { const int hidx = cb < 2304 ? (cb >> 7) : 18 + ((cb - 4352) >> 7);
                        epi_store16(ZH + ((size_t)hidx * 8192 + row) * 128 + (col & 127), w); }
                    else epi_store16(rowp + bj * HALF, w);
                    if (col >= 7744 && col < 7808) { float* zp = zs + (size_t)row * 64 + (col - 7744); *(f32x4*)zp = v0; *(f32x4*)(zp + 4) = v1; } } }
    }
};
struct EpiRes {
    static constexpr bool PERM = false, AFTER_DRAIN = false;
    const float* Xin; float* X; const float* gate; int ldc; float s;
    __device__ __forceinline__ void operator()(const f32x4 (&acc)[2][2][4][2], const Unit& u, int wr, int wc, int fr, int fq) const {
        const int row0 = u.pm * BM + wr * 64 + fr, col0 = u.pn * BM + wc * 32 + 4 * fq;
        f32x4 g[4], xa[8];
#pragma unroll
        for (int q = 0; q < 4; ++q) g[q] = *(const f32x4*)(gate + col0 + (q >> 1) * HALF + (q & 1) * 16);
#define ER_OFF(Q, I) ((size_t)(row0 + ((I) >> 2) * HALF + ((I) & 3) * 16) * ldc + col0 + ((Q) >> 1) * HALF + ((Q) & 1) * 16)
#define ER_LOAD(XB, Q) do { _Pragma("unroll") for (int i = 0; i < 8; ++i) XB[i] = *(const f32x4*)(Xin + ER_OFF(Q, i)); } while (0)
#define ER_STORE(XB, Q) do { _Pragma("unroll") for (int i = 0; i < 8; ++i) { const f32x4 x = XB[i] + g[Q] * (acc[i >> 2][(Q) >> 1][i & 3][(Q) & 1] * s); epi_store16(X + ER_OFF(Q, i), __builtin_bit_cast(u32x4, x)); } } while (0)
#pragma unroll
        for (int q = 0; q < 4; ++q) { ER_LOAD(xa, q); __builtin_amdgcn_sched_barrier(0); ER_STORE(xa, q); __builtin_amdgcn_sched_barrier(0); }
#undef ER_OFF
#undef ER_LOAD
#undef ER_STORE
    }
};
struct OneUnit { Unit u;
    __device__ __forceinline__ bool next(int i, Unit& o) const { if (i) return false; o = u; return true; }
    __device__ __forceinline__ void a_ready(const Unit&) const {}
    __device__ __forceinline__ void done(const Unit&) const {} };
}

constexpr int S = 8192, DM = 2048, DEPTH = 2, NIN = 7782, LDZ = 7936, NWAVES = 8;
constexpr int NMOD = 6 * DM;
constexpr int ZC_FQ = 0, ZC_FK = 768, ZC_FV = 1536, ZC_GQ = 2304, ZC_GK = 2816, ZC_GV = 3328, ZC_GR = 3840;
constexpr int ZC_DQ = 4352, ZC_DK = 5120, ZC_DV = 5888, ZC_IQ = 6656, ZC_IK = 7680, ZC_SM = 7744;
constexpr int ZS_FF = 0, ZS_GA = 16, ZS_IW = 32;
__host__ __device__ constexpr int win_src_col(int n) {
    return n < 2304 ? n : n < 4352 ? 2310 + (n - 2304) : n < 6656 ? 4374 + (n - 4352) : n < 7680 ? 6678 + (n - 6656) : n < 7744 ? 7702 + (n - 7680)
         : n < 7750 ? 2304 + (n - 7744) : n < 7760 ? -1 : n < 7776 ? 4358 + (n - 7760) : n < 7792 ? 7766 + (n - 7776) : -1;
}
constexpr size_t MiB = 1u << 20;
constexpr size_t WS_CTL = 0, CTL_ZERO_BYTES = 1 * MiB;
constexpr size_t WS_MOD = 1 * MiB, WS_MODP = 2 * MiB;
constexpr size_t WS_FCUM = 8 * MiB, WS_DECAY = 9 * MiB, WS_KB = 10 * MiB;
constexpr size_t WS_SU = 9 * MiB + 512 * 1024, WS_SV = 9 * MiB + 768 * 1024;
constexpr size_t WS_EIDX = 12 * MiB, WS_GATE = 16 * MiB, WS_MASK = 20 * MiB, WS_ZS = 28 * MiB;
constexpr size_t WS_WIN = 32 * MiB, WS_WO = 94 * MiB, WS_WQ = 110 * MiB;
constexpr size_t WS_X = 128 * MiB, WS_H = 192 * MiB, WS_MIX = 224 * MiB, WS_Z = 256 * MiB;
constexpr size_t WS_UT = 380 * MiB, WS_ST = 412 * MiB, WS_QG = 428 * MiB, WS_INTRA = 436 * MiB;
constexpr size_t WS_SC = 452 * MiB, WS_QP = 452 * MiB;
constexpr size_t WS_UB = 708 * MiB, WS_VB = 772 * MiB, WS_ZH = 836 * MiB, WS_H8 = 912 * MiB, WS_SA = 928 * MiB, WS_WIN8 = 929 * MiB, WS_WO8 = 961 * MiB, WS_MIX8 = 969 * MiB, WS_END = 985 * MiB;
constexpr int CW_BAR = 4096, CW_Q = 16384, CW_FOXN = 36864, CW_WAMAX = 49152, CW_MIXOVF = 49152 + 16;

constexpr int LDS_BYTES = 163840;
constexpr int MISC_OFF = 163840 - 256;
constexpr int LDS_WORK = MISC_OFF;

#define GAS __attribute__((address_space(1)))
#define LAS __attribute__((address_space(3)))
typedef unsigned short bf16_t;
typedef unsigned u32x4 __attribute__((ext_vector_type(4)));
typedef unsigned u32x2 __attribute__((ext_vector_type(2)));
typedef float f32x4 __attribute__((ext_vector_type(4)));
typedef float f32x16 __attribute__((ext_vector_type(16)));
typedef short bf16x8 __attribute__((ext_vector_type(8)));
typedef __bf16 bf16x2v __attribute__((ext_vector_type(2)));
typedef float f32x2 __attribute__((ext_vector_type(2)));

__device__ __forceinline__ unsigned f2bf(float f) { unsigned u = __builtin_bit_cast(unsigned, f); return (u + 0x7fffu + ((u >> 16) & 1u)) >> 16; }
__device__ __forceinline__ unsigned pk2(float lo, float hi) { return f2bf(lo) | (f2bf(hi) << 16); }
__device__ __forceinline__ float bf2f(unsigned b) { return __builtin_bit_cast(float, b << 16); }
__device__ __forceinline__ float bflo(unsigned w) { return __builtin_bit_cast(float, w << 16); }
__device__ __forceinline__ float bfhi(unsigned w) { return __builtin_bit_cast(float, w & 0xffff0000u); }
__device__ __forceinline__ float wave_sum(float v) {
#pragma unroll
    for (int o = 1; o < 64; o <<= 1) v += __shfl_xor(v, o);
    return v;
}
__device__ __forceinline__ float dot2bf(unsigned a, unsigned b, float acc) { return __builtin_amdgcn_fdot2_f32_bf16(__builtin_bit_cast(bf16x2v, a), __builtin_bit_cast(bf16x2v, b), acc, false); }
__device__ __forceinline__ int crow(int r, int hi) { return (r & 3) + 8 * (r >> 2) + 4 * hi; }
template <int KSTEPS> __device__ __forceinline__ void mma32(f32x16& c, const bf16_t* A, int lda, const bf16_t* B, int ldb, int r32, int hi) {
    bf16x8 a[KSTEPS], b[KSTEPS];
#pragma unroll
    for (int ks = 0; ks < KSTEPS; ++ks) { a[ks] = *(const bf16x8*)(A + (size_t)r32 * lda + ks * 16 + hi * 8); b[ks] = *(const bf16x8*)(B + (size_t)r32 * ldb + ks * 16 + hi * 8); }
    __builtin_amdgcn_sched_barrier(0);
#pragma unroll
    for (int ks = 0; ks < KSTEPS; ++ks) c = __builtin_amdgcn_mfma_f32_32x32x16_bf16(a[ks], b[ks], c, 0, 0, 0);
}
__device__ __forceinline__ float logsigmoidf(float x) { return fminf(x, 0.f) - 0.6931471805599453f * __builtin_amdgcn_logf(1.f + __builtin_amdgcn_exp2f(-1.4426950408889634f * fabsf(x))); }
__device__ __forceinline__ float siluf(float x) { return x / (1.f + __expf(-x)); }
__device__ __forceinline__ float gelu_tanh(float x) { const float y = 0.7978845608028654f * (x + 0.044715f * x * x * x); const float t = 1.f - 2.f / (1.f + __expf(2.f * y)); return 0.5f * x * (1.f + t); }

#define XB_TMO      128
#define XB_XCNT(j)  (256  + 64 * (j))
#define XB_XSUB(j)  (1280 + 64 * (j))
#define XB_XGEN(j)  (2304 + 64 * (j))
#define XB_TOP      3328
#define XB_TOPGEN   3392
#define XCD_BAR_WORDS 3456
#define XB_SPIN_CAP (1u << 23)

__device__ __forceinline__ unsigned xb_ld(unsigned* p)              { return __hip_atomic_load(p, __ATOMIC_RELAXED, __HIP_MEMORY_SCOPE_AGENT); }
__device__ __forceinline__ unsigned xb_add(unsigned* p, unsigned v) { return __hip_atomic_fetch_add(p, v, __ATOMIC_RELAXED, __HIP_MEMORY_SCOPE_AGENT); }
__device__ __forceinline__ unsigned xb_xcc_id() { return (unsigned)__builtin_amdgcn_s_getreg((3 << 11) | 20) & 0xFu; }
#define XB_SPIN(cond, bar) do { unsigned _sp = 0; while (cond) { __builtin_amdgcn_s_sleep(1); \
    if ((++_sp & 255u) == 0u) { if (xb_ld(&(bar)[XB_TMO])) break; if (_sp > XB_SPIN_CAP) { atomicAdd(&(bar)[XB_TMO], 1u); break; } } } } while (0)

struct XcdBarrier {
    unsigned* bar; unsigned x;
    volatile LAS unsigned* st;
};

__device__ __forceinline__ XcdBarrier xcd_barrier_post(unsigned* bar, volatile LAS unsigned* st) {
    XcdBarrier b; b.bar = bar; b.x = xb_xcc_id(); b.st = st;
    if (threadIdx.x == 0) (void)xb_add(&bar[XB_XCNT(b.x)], 1u);
    return b;
}
__device__ __forceinline__ void xcd_barrier_complete(unsigned* bar, unsigned x, unsigned& nloc, unsigned& nx) {
    const unsigned G = gridDim.x * gridDim.y * gridDim.z;
    unsigned sum, cnt, mine, sp = 0u;
    for (;;) {
        sum = 0u; cnt = 0u; mine = 0u;
#pragma unroll 1
        for (unsigned j = 0; j < 16; ++j) { const unsigned c = xb_ld(&bar[XB_XCNT(j)]); sum += c; cnt += (c > 0u) ? 1u : 0u; mine = (j == x) ? c : mine; }
        if (sum == G) break;
        __builtin_amdgcn_s_sleep(1);
        if ((++sp & 255u) == 0u) { if (xb_ld(&bar[XB_TMO])) break; if (sp > XB_SPIN_CAP) { atomicAdd(&bar[XB_TMO], 1u); break; } }
    }
    nloc = mine > 0u ? mine : 1u; nx = cnt > 0u ? cnt : 1u;
}

__device__ __forceinline__ void xcd_barrier(const XcdBarrier& b) {
    asm volatile("s_waitcnt vmcnt(0)" ::: "memory");
    __syncthreads();
    if (threadIdx.x == 0) {
        unsigned* bar = b.bar;
        __builtin_amdgcn_s_waitcnt(0);
        unsigned nloc = b.st[0], nx = b.st[1];
        if (nloc == 0u) { xcd_barrier_complete(bar, b.x, nloc, nx); b.st[0] = nloc; b.st[1] = nx; }
        const unsigned old = xb_add(&bar[XB_XSUB(b.x)], 1u);
        const unsigned gen = old / nloc;
        if (old + 1u == (gen + 1u) * nloc) {
            __builtin_amdgcn_fence(__ATOMIC_RELEASE, "agent");
            asm volatile("s_waitcnt vmcnt(0)" ::: "memory");
            const unsigned og = xb_add(&bar[XB_TOP], 1u);
            const unsigned tg = og / nx;
            if (og + 1u == (tg + 1u) * nx) xb_add(&bar[XB_TOPGEN], 1u);
            else XB_SPIN(xb_ld(&bar[XB_TOPGEN]) == tg, bar);
            __builtin_amdgcn_fence(__ATOMIC_ACQUIRE, "agent");
            xb_add(&bar[XB_XGEN(b.x)], 1u);
            asm volatile("s_waitcnt vmcnt(0)" ::: "memory");
        } else {
            XB_SPIN(xb_ld(&bar[XB_XGEN(b.x)]) == gen, bar);
            __builtin_amdgcn_fence(__ATOMIC_ACQUIRE, "agent");
            asm volatile("s_waitcnt vmcnt(0)" ::: "memory");
        }
    }
    __syncthreads();
}

namespace att {
using bf16 = __hip_bfloat16;
typedef short bf16x8 __attribute__((ext_vector_type(8)));
typedef short s16x4 __attribute__((ext_vector_type(4)));
typedef float f32x16 __attribute__((ext_vector_type(16)));
typedef float f32x4 __attribute__((ext_vector_type(4)));
typedef unsigned u32x4 __attribute__((ext_vector_type(4)));
constexpr int D = 128, NW = 8, QBLK = 32, KVBLK = 64, QB = NW * QBLK;
constexpr int LDQ = 128, LDO = 2048;
constexpr float SCALE = 0.08838834764831845f;
constexpr float THR = 8.f;
constexpr int SHM_V = KVBLK * D * 2, SHM_K = KVBLK * D * 2;
constexpr int LDS_CORE = 2 * SHM_V + 2 * SHM_K + NW * 64 * 4;
constexpr int LDS_BIAS = LDS_CORE;
constexpr int LDS_Q = LDS_CORE + 512;
constexpr int LDS_FLAG = LDS_Q + NW * 8192;
constexpr int LDS_TOTAL = LDS_FLAG + 16;

#define KSWZ(row, colB) ((row) * 256 + ((colB) ^ (((row) & 7) << 4)))
#define SBAR() __builtin_amdgcn_sched_barrier(0)
__device__ __forceinline__ int v_st(int k, int c) { const int kk = (k & ~0xC) | ((k & 4) << 1) | ((k & 8) >> 1); return ((kk >> 3) * 4 + (c >> 5)) * 512 + ((kk & 7) * 32 + (c & 31)) * 2; }
__device__ __forceinline__ int v_rd_base(int lane) { return ((lane & 3) << 3) | (((lane >> 2) & 3) << 6) | (((lane >> 4) & 1) << 5) | (((lane >> 5) & 1) << 8); }
constexpr int v_rd_off(int d0, int ks, int half) { return d0 * 512 + ks * 4096 + half * 2048; }
__device__ __forceinline__ int crow(int r, int hi) { return (r & 3) + 8 * (r >> 2) + 4 * hi; }
__device__ __forceinline__ unsigned cvtpk(float lo, float hi) { unsigned r; asm volatile("v_cvt_pk_bf16_f32 %0, %1, %2" : "=v"(r) : "v"(lo), "v"(hi)); return r; }
__device__ __forceinline__ bf16x8 load8(const bf16* p) { return *reinterpret_cast<const bf16x8*>(p); }
__device__ __forceinline__ void mask_causal(f32x16& p0, f32x16& p1, int dq) {
    const float NEG = -__builtin_inff();
#pragma unroll
    for (int r = 0; r < 16; ++r) { const int c = (r & 3) + 8 * (r >> 2); if (dq - c < 0) p0[r] = NEG; if (dq - c - 32 < 0) p1[r] = NEG; }
}
__device__ __forceinline__ float keep_or_neginf(float p, unsigned w, int c) {
    const int m = __builtin_amdgcn_sbfe((int)w, c, 1); unsigned r; const unsigned neg = 0xFF800000u;
    asm("v_bfi_b32 %0, %1, %2, %3" : "=v"(r) : "v"(m), "v"(p), "s"(neg)); return __uint_as_float(r); }
__device__ __forceinline__ void mask_bits(f32x16& p0, f32x16& p1, unsigned wl, unsigned wh) {
    asm volatile("s_nop 15\n\ts_nop 3" : "+v"(p0), "+v"(p1));
#pragma unroll
    for (int r = 0; r < 16; ++r) { const int c = (r & 3) + 8 * (r >> 2); p0[r] = keep_or_neginf(p0[r], wl, c); p1[r] = keep_or_neginf(p1[r], wh, c); }
}
__device__ __forceinline__ void partialSM(f32x16& p0, f32x16& p1, float& m_reg, float& mn, float& alpha) {
    float pmax = p0[0]; for (int r = 1; r < 16; ++r) pmax = fmaxf(pmax, p0[r]); for (int r = 0; r < 16; ++r) pmax = fmaxf(pmax, p1[r]);
    { auto rr = __builtin_amdgcn_permlane32_swap(__float_as_uint(pmax), __float_as_uint(pmax), false, false);
      pmax = fmaxf(__uint_as_float(rr[0]), __uint_as_float(rr[1])); }
    constexpr float C2 = 1.4426950408889634f * SCALE;
    if (__builtin_expect(__all((pmax - m_reg) * SCALE <= THR), 1)) { mn = m_reg; alpha = 1.f; }
    else { mn = fmaxf(m_reg, pmax); alpha = __builtin_amdgcn_exp2f((m_reg - mn) * C2); m_reg = mn; }
    const float mnL = -mn * C2;
    { typedef float f32x2_ __attribute__((ext_vector_type(2))); const f32x2_ c2v = {C2, C2}, mv = {mnL, mnL};
#pragma unroll
      for (int r = 0; r < 8; ++r) { f32x2_ t = {p0[2 * r], p0[2 * r + 1]}; t = __builtin_elementwise_fma(t, c2v, mv); p0[2 * r] = t[0]; p0[2 * r + 1] = t[1];
                                    f32x2_ u = {p1[2 * r], p1[2 * r + 1]}; u = __builtin_elementwise_fma(u, c2v, mv); p1[2 * r] = u[0]; p1[2 * r + 1] = u[1]; } }
    for (int r = 0; r < 16; ++r) p0[r] = __builtin_amdgcn_exp2f(p0[r]);
}
__device__ __forceinline__ void finishSM(f32x16& p0, f32x16& p1, float alpha, float& l_reg, bf16x8& pa0, bf16x8& pa1, bf16x8& pa2, bf16x8& pa3) {
    for (int r = 0; r < 16; ++r) p1[r] = __builtin_amdgcn_exp2f(p1[r]);
    float ps;
    { typedef float f32x2_ __attribute__((ext_vector_type(2))); f32x2_ s2 = {p0[0], p0[1]};
#pragma unroll
      for (int r = 1; r < 8; ++r) s2 += (f32x2_){p0[2 * r], p0[2 * r + 1]};
#pragma unroll
      for (int r = 0; r < 8; ++r) s2 += (f32x2_){p1[2 * r], p1[2 * r + 1]};
      ps = s2[0] + s2[1]; }
    { auto rr = __builtin_amdgcn_permlane32_swap(__float_as_uint(ps), __float_as_uint(ps), false, false);
      ps = __uint_as_float(rr[0]) + __uint_as_float(rr[1]); }
    l_reg = l_reg * alpha + ps;
#define PK4(P, B_, OUT) do { unsigned a0 = cvtpk(P[B_+0], P[B_+1]), a1 = cvtpk(P[B_+2], P[B_+3]);                          \
        unsigned b0 = cvtpk(P[B_+4], P[B_+5]), b1 = cvtpk(P[B_+6], P[B_+7]);                                             \
        auto r0 = __builtin_amdgcn_permlane32_swap(a0, b0, false, false); auto r1 = __builtin_amdgcn_permlane32_swap(a1, b1, false, false); \
        u32x4 w = {r0[0], r1[0], r0[1], r1[1]}; OUT = *reinterpret_cast<bf16x8*>(&w); } while (0)
    PK4(p0, 0, pa0); PK4(p0, 8, pa1); PK4(p1, 0, pa2); PK4(p1, 8, pa3);
#undef PK4
}
#ifndef ATT_QH
#define ATT_QH 0
#endif
template <int KB, bool BIAS>
__device__ __forceinline__ void qkt(f32x16& p0, f32x16& p1, const char* K_lds, int r32, int hi, const char* Q_lds, const float* bp, const bf16x8* qrp) {
    if constexpr (BIAS) {
#pragma unroll
        for (int g = 0; g < 4; ++g) { const f32x4 b0 = *(const f32x4*)(bp + 8 * g), b1 = *(const f32x4*)(bp + 32 + 8 * g);
#pragma unroll
            for (int e = 0; e < 4; ++e) { p0[4 * g + e] = b0[e]; p1[4 * g + e] = b1[e]; } }
    } else { p0 = f32x16{}; p1 = f32x16{}; }
    const char* kb[4];
#pragma unroll
    for (int dd = 0; dd < 4; ++dd) kb[dd] = K_lds + KB * SHM_K + KSWZ(r32, (dd * 16 + hi * 8) * 2);
#if ATT_QPIN
    bf16x8 X0, X1, XQ, Y0, Y1, YQ, Z0, Z1, ZQ;
#define QK_LD(K0_, K1_, KQ_, d) do { const char* a_ = kb[(d) & 3] + ((d) >> 2) * 128; \
        K0_ = *reinterpret_cast<const bf16x8*>(a_); K1_ = *reinterpret_cast<const bf16x8*>(a_ + 32 * 256); KQ_ = *reinterpret_cast<const bf16x8*>(Q_lds + (d) * 1024); } while (0)
#define QK_MM(K0_, K1_, KQ_) do { p0 = __builtin_amdgcn_mfma_f32_32x32x16_bf16(K0_, KQ_, p0, 0, 0, 0); p1 = __builtin_amdgcn_mfma_f32_32x32x16_bf16(K1_, KQ_, p1, 0, 0, 0); } while (0)
    SBAR(); QK_LD(X0, X1, XQ, 0); QK_LD(Y0, Y1, YQ, 1); SBAR();
    QK_LD(Z0, Z1, ZQ, 2); SBAR(); QK_MM(X0, X1, XQ); SBAR();
    QK_LD(X0, X1, XQ, 3); SBAR(); QK_MM(Y0, Y1, YQ); SBAR();
    QK_LD(Y0, Y1, YQ, 4); SBAR(); QK_MM(Z0, Z1, ZQ); SBAR();
    QK_LD(Z0, Z1, ZQ, 5); SBAR(); QK_MM(X0, X1, XQ); SBAR();
    QK_LD(X0, X1, XQ, 6); SBAR(); QK_MM(Y0, Y1, YQ); SBAR();
    QK_LD(Y0, Y1, YQ, 7); SBAR(); QK_MM(Z0, Z1, ZQ); SBAR();
    QK_MM(X0, X1, XQ); SBAR(); QK_MM(Y0, Y1, YQ); SBAR();
#undef QK_LD
#undef QK_MM
#else
#pragma unroll
    for (int d0 = 0; d0 < 8; ++d0) { const char* a = kb[d0 & 3] + (d0 >> 2) * 128;
        const bf16x8 b0 = *reinterpret_cast<const bf16x8*>(a), b1 = *reinterpret_cast<const bf16x8*>(a + 32 * 256);
        const bf16x8 q = (d0 < ATT_QH) ? qrp[d0] : *reinterpret_cast<const bf16x8*>(Q_lds + d0 * 1024);
        p0 = __builtin_amdgcn_mfma_f32_32x32x16_bf16(b0, q, p0, 0, 0, 0); p1 = __builtin_amdgcn_mfma_f32_32x32x16_bf16(b1, q, p1, 0, 0, 0); }
#endif
}
#ifndef ATT_QPIN
#define ATT_QPIN 0
#endif
#ifndef ATT_QREG
#define ATT_QREG 0
#endif
template <int KB, bool BIAS>
__device__ __forceinline__ void qkt_r(f32x16& p0, f32x16& p1, const char* K_lds, int r32, int hi, const bf16x8* qr, const float* bp) {
    if constexpr (BIAS) {
#pragma unroll
        for (int g = 0; g < 4; ++g) { const f32x4 b0 = *(const f32x4*)(bp + 8 * g), b1 = *(const f32x4*)(bp + 32 + 8 * g);
#pragma unroll
            for (int e = 0; e < 4; ++e) { p0[4 * g + e] = b0[e]; p1[4 * g + e] = b1[e]; } }
    } else { p0 = f32x16{}; p1 = f32x16{}; }
    const char* kb[4];
#pragma unroll
    for (int dd = 0; dd < 4; ++dd) kb[dd] = K_lds + KB * SHM_K + KSWZ(r32, (dd * 16 + hi * 8) * 2);
    bf16x8 X0, X1, Y0, Y1;
#define QK_LD(K0_, K1_, d) do { const char* a_ = kb[(d) & 3] + ((d) >> 2) * 128; K0_ = *reinterpret_cast<const bf16x8*>(a_); K1_ = *reinterpret_cast<const bf16x8*>(a_ + 32 * 256); } while (0)
#define QK_MM(K0_, K1_, d) do { p0 = __builtin_amdgcn_mfma_f32_32x32x16_bf16(K0_, qr[d], p0, 0, 0, 0); p1 = __builtin_amdgcn_mfma_f32_32x32x16_bf16(K1_, qr[d], p1, 0, 0, 0); } while (0)
    SBAR(); QK_LD(X0, X1, 0); SBAR();
    QK_LD(Y0, Y1, 1); SBAR(); QK_MM(X0, X1, 0); SBAR();
    QK_LD(X0, X1, 2); SBAR(); QK_MM(Y0, Y1, 1); SBAR();
    QK_LD(Y0, Y1, 3); SBAR(); QK_MM(X0, X1, 2); SBAR();
    QK_LD(X0, X1, 4); SBAR(); QK_MM(Y0, Y1, 3); SBAR();
    QK_LD(Y0, Y1, 5); SBAR(); QK_MM(X0, X1, 4); SBAR();
    QK_LD(X0, X1, 6); SBAR(); QK_MM(Y0, Y1, 5); SBAR();
    QK_LD(Y0, Y1, 7); SBAR(); QK_MM(X0, X1, 6); SBAR();
    QK_MM(Y0, Y1, 7); SBAR();
#undef QK_LD
#undef QK_MM
}
template <int VB>
__device__ __forceinline__ void pv_tile(f32x16* o, int vb0, bf16x8 pa0, bf16x8 pa1, bf16x8 pa2, bf16x8 pa3) {
#define TRRD(dst, off) asm volatile("ds_read_b64_tr_b16 %0, %1 offset:%2" : "=&v"(dst) : "v"(vb0), "i"(off) : "memory")
#if ATT_PV_SPLIT
#define PV_D0(d0) do { constexpr int b_ = VB * SHM_V + v_rd_off(d0, 0, 0); \
        { s16x4 l0, l1, h0, h1; TRRD(l0, b_); TRRD(h0, b_ + 2048); TRRD(l1, b_ + 4096); TRRD(h1, b_ + 6144); \
          asm volatile("s_waitcnt lgkmcnt(0)" ::: "memory"); SBAR();   \
          o[d0] = __builtin_amdgcn_mfma_f32_32x32x16_bf16(pa0, (bf16x8){l0[0], l0[1], l0[2], l0[3], h0[0], h0[1], h0[2], h0[3]}, o[d0], 0, 0, 0);   \
          o[d0] = __builtin_amdgcn_mfma_f32_32x32x16_bf16(pa1, (bf16x8){l1[0], l1[1], l1[2], l1[3], h1[0], h1[1], h1[2], h1[3]}, o[d0], 0, 0, 0); } \
        { s16x4 l2, l3, h2, h3; TRRD(l2, b_ + 8192); TRRD(h2, b_ + 10240); TRRD(l3, b_ + 12288); TRRD(h3, b_ + 14336); \
          asm volatile("s_waitcnt lgkmcnt(0)" ::: "memory"); SBAR();   \
          o[d0] = __builtin_amdgcn_mfma_f32_32x32x16_bf16(pa2, (bf16x8){l2[0], l2[1], l2[2], l2[3], h2[0], h2[1], h2[2], h2[3]}, o[d0], 0, 0, 0);   \
          o[d0] = __builtin_amdgcn_mfma_f32_32x32x16_bf16(pa3, (bf16x8){l3[0], l3[1], l3[2], l3[3], h3[0], h3[1], h3[2], h3[3]}, o[d0], 0, 0, 0); } } while (0)
#else
#define PV_D0(d0) do { s16x4 l0, l1, l2, l3, h0, h1, h2, h3; constexpr int b_ = VB * SHM_V + v_rd_off(d0, 0, 0); \
        TRRD(l0, b_); TRRD(h0, b_ + 2048); TRRD(l1, b_ + 4096); TRRD(h1, b_ + 6144); TRRD(l2, b_ + 8192); TRRD(h2, b_ + 10240); TRRD(l3, b_ + 12288); TRRD(h3, b_ + 14336); \
        asm volatile("s_waitcnt lgkmcnt(0)" ::: "memory"); SBAR();   \
        o[d0] = __builtin_amdgcn_mfma_f32_32x32x16_bf16(pa0, (bf16x8){l0[0], l0[1], l0[2], l0[3], h0[0], h0[1], h0[2], h0[3]}, o[d0], 0, 0, 0);   \
        o[d0] = __builtin_amdgcn_mfma_f32_32x32x16_bf16(pa1, (bf16x8){l1[0], l1[1], l1[2], l1[3], h1[0], h1[1], h1[2], h1[3]}, o[d0], 0, 0, 0);   \
        o[d0] = __builtin_amdgcn_mfma_f32_32x32x16_bf16(pa2, (bf16x8){l2[0], l2[1], l2[2], l2[3], h2[0], h2[1], h2[2], h2[3]}, o[d0], 0, 0, 0);   \
        o[d0] = __builtin_amdgcn_mfma_f32_32x32x16_bf16(pa3, (bf16x8){l3[0], l3[1], l3[2], l3[3], h3[0], h3[1], h3[2], h3[3]}, o[d0], 0, 0, 0); } while (0)
#endif
    PV_D0(0); PV_D0(1); PV_D0(2); PV_D0(3);
#undef PV_D0
#undef TRRD
}

struct BlockRef { const bf16* Q; const bf16* K; const bf16* V; bf16* O;
#if WO_FP8
    unsigned char* O8; unsigned* ovf;
#endif
    int P0; int kind; int j0; int j1; int part; float* pself; const float* pother; unsigned* pcnt; const float* bias; const unsigned long long* mask; };
struct Seam { bf16x8 qr[8]; bf16x8 st_v0, st_v1, st_k0, st_k1; float st_b; };
#define ROW(p, k0, rr) ((p) + (size_t)((k0) + (rr)) * LDQ + sc)
#define VMW() asm volatile("s_waitcnt vmcnt(0)" ::: "memory")
#define VMWN(n) asm volatile("s_waitcnt vmcnt(%0)" :: "i"(n) : "memory")
#define SLOAD_H(Kp, Vp, Bp, k0) do { S.st_v0 = load8(ROW(Vp, k0, sr)); S.st_v1 = load8(ROW(Vp, k0, 32 + sr));              \
                         S.st_k0 = load8(ROW(Kp, k0, sr)); S.st_k1 = load8(ROW(Kp, k0, 32 + sr)); S.st_b = (Bp)[(k0) + (tid & 63)]; } while (0)
#define SWRITE_HK(bf) do { *(bf16x8*)(K_lds + (bf) * SHM_K + kws) = S.st_k0; *(bf16x8*)(K_lds + (bf) * SHM_K + kws + 32 * 256) = S.st_k1; \
                         if (tid < 64) ((float*)(lds + LDS_BIAS))[(bf) * 64 + tid] = S.st_b; } while (0)
#define SWRITE_HV(bf) do { *(bf16x8*)(V_lds + (bf) * SHM_V + vst0) = S.st_v0; *(bf16x8*)(V_lds + (bf) * SHM_V + vst1) = S.st_v1; } while (0)
#define SWRITE_H(bf) do { SWRITE_HV(bf); SWRITE_HK(bf); } while (0)
__device__ __forceinline__ void attn_prime(const BlockRef& cur, char* lds, Seam& S) {
    int tid = threadIdx.x; asm volatile("" : "+v"(tid));
    const int wid = __builtin_amdgcn_readfirstlane(tid >> 6), lane = tid & 63, r32 = lane & 31, hi = lane >> 5;
    const int sr = tid >> 4, sc = (tid & 15) * 8, kws = KSWZ(sr, sc * 2); char* K_lds = lds + 2 * SHM_V;
#pragma unroll
    for (int d0 = 0; d0 < 8; ++d0) S.qr[d0] = load8(cur.Q + (size_t)(wid * QBLK + r32) * LDQ + d0 * 16 + hi * 8);
    SLOAD_H(cur.K, cur.V, cur.bias, cur.j0 * KVBLK); VMW(); SWRITE_HK(0);
    __syncthreads();
}
template <int KIND> __device__ __forceinline__ void attn_block(const BlockRef& cur, const BlockRef& nxt, char* lds, Seam& S) {
    int tid = threadIdx.x; asm volatile("" : "+v"(tid));
    const int wid = __builtin_amdgcn_readfirstlane(tid >> 6), lane = tid & 63, r32 = lane & 31, hi = lane >> 5;
    const int j_lo = cur.j0, NT = cur.j1 - j_lo;
    const int qlo = cur.P0 + wid * QBLK, qm = qlo + r32 - 4 * hi;
    char* V_lds = lds; char* K_lds = lds + 2 * SHM_V;
    float* ws = (float*)(lds + 2 * SHM_V + 2 * SHM_K) + wid * 64; float* li_l = ws, * al_l = ws + 32;
    const float* biasL = (const float*)(lds + LDS_BIAS);
    constexpr int kind = KIND;
    char* Q_lds = lds + LDS_Q + wid * 8192 + lane * 16;
#if !ATT_QREG
#pragma unroll
    for (int d0 = 0; d0 < 8; ++d0) *(bf16x8*)(Q_lds + d0 * 1024) = S.qr[d0];
#define QKT(KB_, P0_, P1_, BP_) qkt<KB_, KIND == 0>(P0_, P1_, K_lds, r32, hi, Q_lds, BP_, S.qr)
#else
#define QKT(KB_, P0_, P1_, BP_) qkt_r<KB_, KIND == 0>(P0_, P1_, K_lds, r32, hi, S.qr, BP_)
#endif
    const unsigned long long* mrow = cur.mask + (size_t)(qlo + r32) * 128;
    float m_reg = -1e30f, l_reg = 0; f32x16 o[4] = {};
    const int sr = tid >> 4, sc = (tid & 15) * 8, vst0 = v_st(sr, sc), vst1 = v_st(32 + sr, sc), kws = KSWZ(sr, sc * 2);
    const int vb0 = (int)(uintptr_t)V_lds + v_rd_base(lane);
    const bf16* Kh = cur.K; const bf16* Vh = cur.V;
    unsigned long long mwA = 0ull, mwB = 0ull;
#define RESC(a) do { if (__any((a) < 1.f)) { if (hi == 0) al_l[r32] = (a); asm volatile("s_waitcnt lgkmcnt(0)" ::: "memory");              \
                     for (int d_ = 0; d_ < 4; ++d_) for (int r = 0; r < 16; ++r) o[d_][r] *= al_l[crow(r, hi)]; } } while (0)
#define KBASE(t) ((j_lo + (t)) * KVBLK)
#define LOADMW(MW_, t) do { if constexpr (KIND == 1) MW_ = mrow[j_lo + (t)]; } while (0)
#define BIASP(bf) (biasL + (bf) * 64 + 4 * hi)
#define MASKT(P0_, P1_, MW_, t) do { const int kb_ = KBASE(t);                                                                               \
        if constexpr (KIND == 0) { if (kb_ + KVBLK - 1 > qlo) mask_causal(P0_, P1_, qm - kb_); }                                          \
        else { mask_bits(P0_, P1_, (unsigned)MW_ >> (4 * hi), (unsigned)(MW_ >> 32) >> (4 * hi)); } } while (0)
    constexpr int NQL = 8;
#define SEAM_K0() do { VMWN(NQL); SWRITE_HK(0); SBAR(); } while (0)
    f32x16 pA0, pA1, pB0, pB1; float mnA, mnB, alA, alB; bf16x8 pa0, pa1, pa2, pa3;
#if ATT_STATIC_PRIO
    if (wid >= 4) __builtin_amdgcn_s_setprio(1);
#endif
    SWRITE_HV(0); SBAR();
    LOADMW(mwA, 0); LOADMW(mwB, 1);
    if (NT > 1) { SLOAD_H(Kh, Vh, cur.bias, KBASE(1)); }
    SBAR(); QKT(0, pA0, pA1, BIASP(0));
    MASKT(pA0, pA1, mwA, 0); partialSM(pA0, pA1, m_reg, mnA, alA);
    if (NT > 1) { VMW(); SWRITE_H(1); }
    __syncthreads();
#define HALF_STEP(PX0, PX1, mnX, alX, PY0, PY1, alY, MWX, MWN, t, KB, VB, SB) do {                                                      \
        SBAR(); LOADMW(MWN, (t) + 1); QKT(KB, PX0, PX1, BIASP(KB));                                                            \
        finishSM(PY0, PY1, alY, l_reg, pa0, pa1, pa2, pa3); SBAR();                                                           \
        if ((t) + 1 < NT) { SLOAD_H(Kh, Vh, cur.bias, KBASE((t) + 1)); SBAR(); }                                                        \
        pv_tile<VB>(o, vb0, pa0, pa1, pa2, pa3); MASKT(PX0, PX1, MWX, (t)); partialSM(PX0, PX1, m_reg, mnX, alX);                  \
        __syncthreads();                                                                                                      \
        if ((t) + 1 < NT) { VMW(); SWRITE_H(SB); }                                                                            \
        RESC(alX); __syncthreads(); } while (0)
    for (int t = 1; t + 1 < NT; t += 2) {
        HALF_STEP(pB0, pB1, mnB, alB, pA0, pA1, alA, mwB, mwA, t, 1, 0, 0);
        HALF_STEP(pA0, pA1, mnA, alA, pB0, pB1, alB, mwA, mwB, t + 1, 0, 1, 1);
    }
    const bool even = (NT & 1) == 0;
    if (even) { SBAR(); QKT(1, pB0, pB1, BIASP(1)); SBAR(); }
    SLOAD_H(nxt.K, nxt.V, nxt.bias, nxt.j0 * KVBLK); SBAR();
#pragma unroll
    for (int d0 = 0; d0 < 8; ++d0) S.qr[d0] = load8(nxt.Q + (size_t)(wid * QBLK + r32) * LDQ + d0 * 16 + hi * 8);
    SBAR();
    finishSM(pA0, pA1, alA, l_reg, pa0, pa1, pa2, pa3); SBAR();
    pv_tile<0>(o, vb0, pa0, pa1, pa2, pa3);
    if (even) { MASKT(pB0, pB1, mwB, NT - 1); partialSM(pB0, pB1, m_reg, mnB, alB); __syncthreads(); RESC(alB);
        finishSM(pB0, pB1, alB, l_reg, pa0, pa1, pa2, pa3); SBAR(); pv_tile<1>(o, vb0, pa0, pa1, pa2, pa3); }
    SBAR(); SEAM_K0();
#if ATT_STATIC_PRIO
    __builtin_amdgcn_s_setprio(0);
#endif
    bool do_out = true;
    if (cur.part) {
        const __amdgpu_buffer_rsrc_t prs = __builtin_amdgcn_make_buffer_rsrc((void*)cur.pself, 0, (8 * 16 * 256 + 512) * 4, 0x00020000);
        const unsigned pbo = (unsigned)((wid * 16) * 256 + lane * 4) * 4u;
#pragma unroll
        for (int d0 = 0; d0 < 4; ++d0)
#pragma unroll
            for (int g = 0; g < 4; ++g) { const f32x4 v4 = (f32x4){o[d0][4 * g], o[d0][4 * g + 1], o[d0][4 * g + 2], o[d0][4 * g + 3]};
                __builtin_amdgcn_raw_buffer_store_b128(__builtin_bit_cast(u32x4, v4), prs, pbo + (unsigned)((d0 * 4 + g) * 256) * 4u, 0,   16); }
        if (hi == 0) __hip_atomic_store((unsigned long long*)(cur.pself + 8 * 16 * 256 + (wid * 32 + r32) * 2), ((unsigned long long)__float_as_uint(l_reg) << 32) | __float_as_uint(m_reg), __ATOMIC_RELAXED, __HIP_MEMORY_SCOPE_AGENT);
        asm volatile("s_waitcnt vmcnt(0)" ::: "memory");
        __syncthreads();
        if (tid == 0) {
            const unsigned old = __hip_atomic_fetch_add(cur.pcnt, 1u, __ATOMIC_RELAXED, __HIP_MEMORY_SCOPE_AGENT);
            if (old == 1u) { __builtin_amdgcn_fence(__ATOMIC_ACQUIRE, "agent"); asm volatile("s_waitcnt vmcnt(0)" ::: "memory"); }
            *(volatile unsigned*)(lds + LDS_FLAG) = old; }
        __syncthreads();
        do_out = (*(volatile unsigned*)(lds + LDS_FLAG) == 1u);
    }
    if (do_out) {
        if (hi == 0) { li_l[r32] = l_reg; al_l[r32] = m_reg; } asm volatile("s_waitcnt lgkmcnt(0)" ::: "memory");
        constexpr float C2e = 1.4426950408889634f * SCALE;
        if (cur.part) { const float* pmo = cur.pother + 8 * 16 * 256 + (wid * 32) * 2; const float* po = cur.pother + (size_t)(wid * 16) * 256 + lane * 4;
#pragma unroll
            for (int g = 0; g < 4; ++g) { float as_[4], ao_[4], ri_[4];
#pragma unroll
                for (int e = 0; e < 4; ++e) { const int row = crow(4 * g + e, hi); const float m1 = al_l[row], l1 = li_l[row], m2 = pmo[row * 2], l2 = pmo[row * 2 + 1];
                    const float mm = fmaxf(m1, m2); const float a1 = __builtin_amdgcn_exp2f((m1 - mm) * C2e), a2 = __builtin_amdgcn_exp2f((m2 - mm) * C2e);
                    const float ri = __builtin_amdgcn_rcpf(__fadd_rn(__fmul_rn(a1, l1), __fmul_rn(a2, l2))); as_[e] = __fmul_rn(a1, ri); ao_[e] = __fmul_rn(a2, ri); }
#pragma unroll
                for (int d0 = 0; d0 < 4; ++d0) { const f32x4 v = *(const f32x4*)(po + (d0 * 4 + g) * 256);
#pragma unroll
                    for (int e = 0; e < 4; ++e) o[d0][4 * g + e] = __fadd_rn(__fmul_rn(as_[e], o[d0][4 * g + e]), __fmul_rn(ao_[e], v[e])); }
                __builtin_amdgcn_sched_barrier(0); }
        } else {
#pragma unroll
            for (int r = 0; r < 16; ++r) { const float ri = __builtin_amdgcn_rcpf(li_l[crow(r, hi)]);
#pragma unroll
                for (int d0 = 0; d0 < 4; ++d0) o[d0][r] *= ri; }
        }
        int hi_e = hi, r32_e = r32; asm volatile("" : "+v"(hi_e), "+v"(r32_e));
        bf16* Ow = cur.O + (size_t)(wid * QBLK + 4 * hi_e) * LDO + r32_e;
#if WO_FP8
        unsigned char* O8w = cur.O8 + (size_t)(wid * QBLK + 4 * hi_e) * LDO + r32_e; float amx = 0.f;
#endif
#pragma unroll
        for (int r = 0; r < 16; ++r) { const int orow = (r & 3) + 8 * (r >> 2);
#pragma unroll
            for (int d0 = 0; d0 < 4; ++d0) { const float v = o[d0][r];
                const float vn = __shfl_xor(v, 1);
                if ((r32 & 1) == 0) *(unsigned*)(Ow + orow * LDO + d0 * 32) = cvtpk(v, vn);
#if WO_FP8
                amx = fmaxf(amx, fabsf(v));
                const int p8 = __builtin_amdgcn_cvt_pk_fp8_f32(v * MIX_S, vn * MIX_S, 0, false), q8 = __shfl_xor(p8, 2);
                if ((r32 & 3) == 0) *(unsigned*)(O8w + orow * LDO + d0 * 32) = ((unsigned)p8 & 0xffffu) | ((unsigned)q8 << 16);
#endif
            } }
#if WO_FP8
        if (__any(amx * MIX_S > 448.f)) { if (lane == 0) __hip_atomic_fetch_or(cur.ovf, 1u, __ATOMIC_RELAXED, __HIP_MEMORY_SCOPE_AGENT); }
#endif
    }
    __syncthreads();
#undef RESC
#undef KBASE
#undef LOADMW
#undef QKT
#undef BIASP
#undef MASKT
#undef SEAM_K0
#undef HALF_STEP
}
#undef ROW
#undef VMW
#undef VMWN
#undef SLOAD_H
#undef SWRITE_HK
#undef SWRITE_HV
#undef SWRITE_H
#undef KSWZ
#undef SBAR
}

__device__ __forceinline__ int tid_op() { int t = threadIdx.x; asm volatile("" : "+v"(t)); return t; }
#define TID_ tid_op()
#define LANE_ (tid_op() & 63)
struct Frame {
    LAS unsigned char* lds; volatile LAS unsigned* MISC; unsigned* ctl;
    int wave, G, gw, NGW, nconv;
    GAS unsigned char* ws;
};
struct Args { const float* in[18]; float* out; unsigned char* ws; int ph_lo, ph_hi; };
enum { I_X = 0, I_C, I_ADA_W, I_ADA_B, I_NORM1_G, I_NORM2_G, I_FINAL_G, I_W_IN, I_FOX_FBIAS, I_GLA_WA2, I_GLA_BA, I_GLA_NORM_G, I_W_OUT, I_PEER_WQ, I_PEER_K1, I_PEER_K2, I_PEER_U, I_PEER_V };
__device__ __forceinline__ const float* inp(int i) { asm volatile("" : "+s"(i)); const __attribute__((address_space(4))) Args* a = (const __attribute__((address_space(4))) Args*)__builtin_amdgcn_kernarg_segment_ptr(); return (const float*)(const GAS float*)a->in[i]; }
__device__ __forceinline__ float* outp() { int i = 0; asm volatile("" : "+s"(i)); const __attribute__((address_space(4))) Args* a = (const __attribute__((address_space(4))) Args*)__builtin_amdgcn_kernarg_segment_ptr(); return (float*)(GAS float*)(&a->out)[i]; }
__device__ __forceinline__ int deq(Frame& F, int q) {
    __syncthreads();
    if (TID_ == 0) F.MISC[0] = __hip_atomic_fetch_add(F.ctl + CW_Q + 64 * q, 1u, __ATOMIC_RELAXED, __HIP_MEMORY_SCOPE_AGENT);
    __syncthreads();
    return __builtin_amdgcn_readfirstlane((int)F.MISC[0]);
}

template <bool MAPPED> __device__ __forceinline__ void transpose_item(const float* W, int K, int N, bf16_t* WT, int nblk, LAS float* scr, int item, int lane) {
    const int kb = item / nblk, nb = item % nblk, k0 = 64 * kb, n0 = 32 * nb;
    const int nsrc = MAPPED ? win_src_col(n0 + (lane & 31)) : n0 + (lane & 31);
    { float tv[32];
#pragma unroll
      for (int i = 0; i < 32; ++i) { const int kk = 2 * i + (lane >> 5); tv[i] = nsrc >= 0 ? W[(size_t)(k0 + kk) * N + nsrc] : 0.f; }
      __builtin_amdgcn_sched_barrier(0);
#pragma unroll
      for (int i = 0; i < 32; ++i) { const int kk = 2 * i + (lane >> 5); scr[kk * 33 + (lane & 31)] = tv[i]; } }
    asm volatile("s_waitcnt lgkmcnt(0)" ::: "memory");
    const int c = lane & 7;
#pragma unroll
    for (int j = 0; j < 4; ++j) { const int n = (lane >> 3) + 8 * j; const LAS float* s = scr + (8 * c) * 33 + n;
        u32x4 o; o.x = pk2(s[0 * 33], s[1 * 33]); o.y = pk2(s[2 * 33], s[3 * 33]); o.z = pk2(s[4 * 33], s[5 * 33]); o.w = pk2(s[6 * 33], s[7 * 33]);
        *(u32x4*)(WT + (size_t)(n0 + n) * K + k0 + 8 * c) = o; }
    asm volatile("s_waitcnt lgkmcnt(0)" ::: "memory");
}
template <bool MAPPED> __device__ __forceinline__ void transpose_item_f8(const float* W, int K, int N, unsigned char* WT, int nblk, LAS float* scr, int item, int lane, float inv) {
    const int kb = item / nblk, nb = item % nblk, k0 = 64 * kb, n0 = 32 * nb;
    const int nsrc = MAPPED ? win_src_col(n0 + (lane & 31)) : n0 + (lane & 31);
    { float tv[32];
#pragma unroll
      for (int i = 0; i < 32; ++i) { const int kk = 2 * i + (lane >> 5); tv[i] = nsrc >= 0 ? W[(size_t)(k0 + kk) * N + nsrc] : 0.f; }
      __builtin_amdgcn_sched_barrier(0);
#pragma unroll
      for (int i = 0; i < 32; ++i) { const int kk = 2 * i + (lane >> 5); scr[kk * 33 + (lane & 31)] = tv[i]; } }
    asm volatile("s_waitcnt lgkmcnt(0)" ::: "memory");
#pragma unroll
    for (int j = 0; j < 2; ++j) { const int idx = lane + 64 * j, n = idx >> 2, c = idx & 3; const LAS float* sp = scr + (16 * c) * 33 + n; u32x4 o;
#pragma unroll
        for (int q = 0; q < 4; ++q) { int w = __builtin_amdgcn_cvt_pk_fp8_f32(sp[(4 * q) * 33] * inv, sp[(4 * q + 1) * 33] * inv, 0, false); w = __builtin_amdgcn_cvt_pk_fp8_f32(sp[(4 * q + 2) * 33] * inv, sp[(4 * q + 3) * 33] * inv, w, true); o[q] = (unsigned)w; }
        *(u32x4*)(WT + (size_t)(n0 + n) * K + k0 + 16 * c) = o; }
    asm volatile("s_waitcnt lgkmcnt(0)" ::: "memory");
}
__device__ __forceinline__ void convert_flat(const float* src, bf16_t* dst, size_t n, int gw, int NGW, int lane) {
    for (size_t i = (size_t)gw * 512 + lane * 8; i < n; i += (size_t)NGW * 512) {
        const f32x4 a = *(const f32x4*)(src + i), b = *(const f32x4*)(src + i + 4);
        u32x4 o; o.x = pk2(a[0], a[1]); o.y = pk2(a[2], a[3]); o.z = pk2(b[0], b[1]); o.w = pk2(b[2], b[3]);
        *(u32x4*)(dst + i) = o; }
}
__device__ __forceinline__ float clamp6(float x) { return fminf(fmaxf(x, -6.f), 6.f); }
__device__ __forceinline__ void convert_row_fp8(const float* src, unsigned* dst, float* scale, int lane) {
    f32x4 v[8]; float am = 0.f, ss = 0.f;
#pragma unroll
    for (int j = 0; j < 8; ++j) { v[j] = *(const f32x4*)(src + 256 * j + 4 * lane); am = fmaxf(am, fmaxf(fmaxf(fabsf(v[j][0]), fabsf(v[j][1])), fmaxf(fabsf(v[j][2]), fabsf(v[j][3]))));
        ss += (v[j][0] * v[j][0] + v[j][1] * v[j][1]) + (v[j][2] * v[j][2] + v[j][3] * v[j][3]); }
#pragma unroll
    for (int o = 1; o < 64; o <<= 1) { am = fmaxf(am, __shfl_xor(am, o)); ss += __shfl_xor(ss, o); }
    const float s6 = fminf(am, 3.f * sqrtf(ss * (1.f / 2048.f)));
    const float sc = s6 > 0.f ? s6 * (1.f / 6.f) : 1.f, inv = s6 > 0.f ? 6.f / s6 : 1.f;
    u32x4 o;
#pragma unroll
    for (int q = 0; q < 4; ++q) { const f32x4 a = v[2 * q], b = v[2 * q + 1]; unsigned w = 0u;
        w = __builtin_amdgcn_cvt_scalef32_pk_fp4_f32(w, clamp6(a[0] * inv), clamp6(a[1] * inv), 1.0f, 0);
        w = __builtin_amdgcn_cvt_scalef32_pk_fp4_f32(w, clamp6(a[2] * inv), clamp6(a[3] * inv), 1.0f, 1);
        w = __builtin_amdgcn_cvt_scalef32_pk_fp4_f32(w, clamp6(b[0] * inv), clamp6(b[1] * inv), 1.0f, 2);
        w = __builtin_amdgcn_cvt_scalef32_pk_fp4_f32(w, clamp6(b[2] * inv), clamp6(b[3] * inv), 1.0f, 3);
        o[q] = w; }
    *(u32x4*)(dst + 4 * lane) = o;
    if (lane == 0) *scale = sc;
}
constexpr int CONV_ITEMS = 16384 / 64;
__device__ __forceinline__ void conv_row_regs(Frame& F, const f32x4 (&v)[8], int tb, int row, int lane) {
    float am = 0.f, ss = 0.f;
#if PEER_U_INT4
    if (tb == 0) {
#pragma unroll
        for (int j = 0; j < 8; ++j) { am = fmaxf(am, fmaxf(fmaxf(fabsf(v[j][0]), fabsf(v[j][1])), fmaxf(fabsf(v[j][2]), fabsf(v[j][3]))));
            ss += (v[j][0] * v[j][0] + v[j][1] * v[j][1]) + (v[j][2] * v[j][2] + v[j][3] * v[j][3]); }
#pragma unroll
        for (int o = 1; o < 64; o <<= 1) { am = fmaxf(am, __shfl_xor(am, o)); ss += __shfl_xor(ss, o); }
        const float st0 = fminf(am * 0.125f, 0.3352f * sqrtf(ss * (1.f / 2048.f)));
        const float step = st0 > 0.f ? st0 : 1.f, inv = 1.f / step;
        u32x4 o;
#pragma unroll
        for (int d = 0; d < 4; ++d) { unsigned w = 0u;
#pragma unroll
            for (int n = 0; n < 8; ++n) { const float x = v[2 * d + (n >> 2)][n & 3]; const int q = (int)fminf(fmaxf(floorf(x * inv), -8.f), 7.f); w |= ((unsigned)q & 15u) << (4 * n); }
            o[d] = w; }
        *(u32x4*)((unsigned*)(F.ws + WS_UB) + (size_t)row * (DM / 8) + 4 * lane) = o;
        if (lane == 0) ((float*)(F.ws + WS_SU))[row] = step;
        return; }
#endif
#pragma unroll
    for (int j = 0; j < 8; ++j) { am = fmaxf(am, fmaxf(fmaxf(fabsf(v[j][0]), fabsf(v[j][1])), fmaxf(fabsf(v[j][2]), fabsf(v[j][3]))));
        ss += (v[j][0] * v[j][0] + v[j][1] * v[j][1]) + (v[j][2] * v[j][2] + v[j][3] * v[j][3]); }
#pragma unroll
    for (int o = 1; o < 64; o <<= 1) { am = fmaxf(am, __shfl_xor(am, o)); ss += __shfl_xor(ss, o); }
    const float s6 = fminf(am, 3.f * sqrtf(ss * (1.f / 2048.f)));
    const float sc = s6 > 0.f ? s6 * (1.f / 6.f) : 1.f, inv = s6 > 0.f ? 6.f / s6 : 1.f;
    u32x4 o;
#pragma unroll
    for (int q = 0; q < 4; ++q) { const f32x4 a = v[2 * q], b = v[2 * q + 1]; unsigned w = 0u;
        w = __builtin_amdgcn_cvt_scalef32_pk_fp4_f32(w, clamp6(a[0] * inv), clamp6(a[1] * inv), 1.0f, 0);
        w = __builtin_amdgcn_cvt_scalef32_pk_fp4_f32(w, clamp6(a[2] * inv), clamp6(a[3] * inv), 1.0f, 1);
        w = __builtin_amdgcn_cvt_scalef32_pk_fp4_f32(w, clamp6(b[0] * inv), clamp6(b[1] * inv), 1.0f, 2);
        w = __builtin_amdgcn_cvt_scalef32_pk_fp4_f32(w, clamp6(b[2] * inv), clamp6(b[3] * inv), 1.0f, 3);
        o[q] = w; }
    *(u32x4*)((unsigned*)(F.ws + (tb ? WS_VB : WS_UB)) + (size_t)row * (DM / 8) + 4 * lane) = o;
    if (lane == 0) ((float*)(F.ws + (tb ? WS_SV : WS_SU)))[row] = sc;
}
__device__ __forceinline__ void conv_item(Frame& F, int l, int tb, int item) {
    const int lane = LANE_; const int row0 = l * 16384 + item * 64 + F.wave * 8;
    const float* src = (tb ? inp(I_PEER_V) : inp(I_PEER_U)) + (size_t)row0 * DM + 4 * lane;
    f32x4 v[4][8];
#pragma unroll
    for (int r = 0; r < 4; ++r)
#pragma unroll
        for (int j = 0; j < 8; ++j) v[r][j] = __builtin_nontemporal_load((const f32x4*)(src + (size_t)r * DM + 256 * j));
    __builtin_amdgcn_sched_barrier(0);
#pragma unroll
    for (int r = 0; r < 4; ++r) {
        conv_row_regs(F, v[r], tb, row0 + r, lane);
        __builtin_amdgcn_sched_barrier(0);
#pragma unroll
        for (int j = 0; j < 8; ++j) v[r][j] = __builtin_nontemporal_load((const f32x4*)(src + (size_t)(r + 4) * DM + 256 * j));
        __builtin_amdgcn_sched_barrier(0);
    }
#pragma unroll
    for (int r = 0; r < 4; ++r) { conv_row_regs(F, v[r], tb, row0 + 4 + r, lane); __builtin_amdgcn_sched_barrier(0); }
}
constexpr int CONV_SH_CAP = 256 * 7, CONV_SH_UNITS = 4 * 16384 / 4;
__device__ __forceinline__ void conv_shadow(Frame& F, int bidx) {
    const int u = bidx * CONV_SH_CAP + blockIdx.x * 7 + (F.wave - 1);
    if (u >= CONV_SH_UNITS) return;
    const int lane = LANE_; const int l = u >> 13, r = u & 8191, tb = r >> 12, row0 = l * 16384 + (r & 4095) * 4;
    const float* src = (tb ? inp(I_PEER_V) : inp(I_PEER_U)) + (size_t)row0 * DM + 4 * lane;
    f32x4 v[4][8];
#pragma unroll
    for (int rr = 0; rr < 4; ++rr)
#pragma unroll
        for (int j = 0; j < 8; ++j) v[rr][j] = __builtin_nontemporal_load((const f32x4*)(src + (size_t)rr * DM + 256 * j));
    __builtin_amdgcn_sched_barrier(0);
#pragma unroll
    for (int rr = 0; rr < 4; ++rr) { conv_row_regs(F, v[rr], tb, row0 + rr, lane); __builtin_amdgcn_sched_barrier(0); }
}
__device__ __forceinline__ void p0a_prologue(Frame& F) {
    const int gw = F.gw, NGW = F.NGW, lane = LANE_;
    { float* modp = (float*)(F.ws + WS_MODP);
      for (int it = gw; it < 2 * 48 * 32; it += NGW) { const int l = it / (48 * 32), r = it % (48 * 32), eb = r / 32, dc = r % 32;
          f32x4 acc = {0.f, 0.f, 0.f, 0.f}; const float* wp = inp(I_ADA_W) + ((size_t)l * DM + dc * 64) * NMOD + eb * 256 + lane * 4;
#pragma unroll 16
          for (int rr = 0; rr < 64; ++rr) { const float cv = inp(I_C)[dc * 64 + rr]; const float ca = cv / (1.f + __expf(-cv)); acc = acc + ca * *(const f32x4*)(wp + (size_t)rr * NMOD); }
          *(f32x4*)(modp + ((size_t)(l * 32 + dc)) * NMOD + eb * 256 + lane * 4) = acc; } }
    { LAS float* scr = (LAS float*)(F.lds + F.wave * 8448);
      constexpr int I_IN = 32 * (LDZ / 32), I_SQ = 32 * 64;
      for (int it = gw; it < 2 * (I_IN + 2 * I_SQ); it += NGW) { const int l = it / (I_IN + 2 * I_SQ); int r = it % (I_IN + 2 * I_SQ);
          if (r < I_IN) {
#if WIN_FP8
              if (!((WIN_BF16_TILES >> ((r % (LDZ / 32)) >> 3)) & 1u)) continue;
#endif
              transpose_item<true>(inp(I_W_IN) + (size_t)l * DM * NIN, DM, NIN, (bf16_t*)(F.ws + WS_WIN) + (size_t)l * LDZ * DM, LDZ / 32, scr, r, lane);
              continue; } r -= I_IN;
          if (r < I_SQ) { transpose_item<false>(inp(I_W_OUT) + (size_t)l * DM * DM, DM, DM, (bf16_t*)(F.ws + WS_WO) + (size_t)l * DM * DM, 64, scr, r, lane); continue; } r -= I_SQ;
          transpose_item<false>(inp(I_PEER_WQ) + (size_t)l * DM * DM, DM, DM, (bf16_t*)(F.ws + WS_WQ) + (size_t)l * DM * DM, 64, scr, r, lane); } }
#if !CONV_IN_QUEUES
    for (int r = gw; r < 2 * 2 * 16384; r += NGW) {
        const int tb = r >> 15, row = r & 32767;
        convert_row_fp8((tb ? inp(I_PEER_V) : inp(I_PEER_U)) + (size_t)row * DM, (unsigned*)(F.ws + (tb ? WS_VB : WS_UB)) + (size_t)row * (DM / 8), (float*)(F.ws + (tb ? WS_SV : WS_SU)) + row, lane); }
#endif
#if WIN_FP8
#pragma unroll 1
    for (int l = 0; l < DEPTH; ++l) { const float* w = inp(I_W_IN) + (size_t)l * DM * NIN; float am = 0.f;
        { const size_t n_ = (size_t)DM * NIN, st_ = (size_t)NGW * 256; size_t i = (size_t)gw * 256 + lane * 4;
          for (; i + 7 * st_ < n_; i += 8 * st_) { f32x4 a8[8];
#pragma unroll
              for (int q = 0; q < 8; ++q) a8[q] = *(const f32x4*)(w + i + q * st_);
#pragma unroll
              for (int q = 0; q < 8; ++q) am = fmaxf(am, fmaxf(fmaxf(fabsf(a8[q][0]), fabsf(a8[q][1])), fmaxf(fabsf(a8[q][2]), fabsf(a8[q][3])))); }
          for (; i < n_; i += st_) { const f32x4 a = *(const f32x4*)(w + i); am = fmaxf(am, fmaxf(fmaxf(fabsf(a[0]), fabsf(a[1])), fmaxf(fabsf(a[2]), fabsf(a[3])))); } }
#pragma unroll
        for (int o = 1; o < 64; o <<= 1) am = fmaxf(am, __shfl_xor(am, o));
        if (lane == 0) __hip_atomic_fetch_max(F.ctl + CW_WAMAX + l, __float_as_uint(am), __ATOMIC_RELAXED, __HIP_MEMORY_SCOPE_AGENT); }
#endif
#if WO_FP8
#pragma unroll 1
    for (int l = 0; l < DEPTH; ++l) { const float* w = inp(I_W_OUT) + (size_t)l * DM * DM; float am = 0.f;
        for (size_t i = (size_t)gw * 256 + lane * 4; i < (size_t)DM * DM; i += (size_t)NGW * 256) { const f32x4 a = *(const f32x4*)(w + i); am = fmaxf(am, fmaxf(fmaxf(fabsf(a[0]), fabsf(a[1])), fmaxf(fabsf(a[2]), fabsf(a[3])))); }
#pragma unroll
        for (int o = 1; o < 64; o <<= 1) am = fmaxf(am, __shfl_xor(am, o));
        if (lane == 0) __hip_atomic_fetch_max(F.ctl + CW_WAMAX + 2 + l, __float_as_uint(am), __ATOMIC_RELAXED, __HIP_MEMORY_SCOPE_AGENT); }
#endif
    convert_flat(inp(I_PEER_K1), (bf16_t*)(F.ws + WS_KB), (size_t)2 * 8 * 128 * 128, gw, NGW, lane);
    convert_flat(inp(I_PEER_K2), (bf16_t*)(F.ws + WS_KB) + 2 * 8 * 128 * 128, (size_t)2 * 8 * 128 * 128, gw, NGW, lane);
}
__device__ __forceinline__ void p0b_modreduce(Frame& F) {
    const float* modp = (const float*)(F.ws + WS_MODP); float* mod = (float*)(F.ws + WS_MOD);
    for (int e = blockIdx.x * 512 + TID_; e < 2 * NMOD; e += F.G * 512) { const int l = e / NMOD, cidx = e % NMOD; float s = inp(I_ADA_B)[e];
        float p[32];
#pragma unroll
        for (int dc = 0; dc < 32; ++dc) p[dc] = modp[((size_t)(l * 32 + dc)) * NMOD + cidx];
#pragma unroll
        for (int dc = 0; dc < 32; ++dc) s += p[dc];
        mod[e] = s; }
#if WIN_FP8
    { LAS float* scr = (LAS float*)(F.lds + F.wave * 8448); constexpr int I_IN = 32 * (LDZ / 32); const int lane = LANE_;
      for (int it = F.gw; it < 2 * I_IN; it += F.NGW) { const int l = it / I_IN, r = it % I_IN;
          const float am = __uint_as_float(__hip_atomic_load(F.ctl + CW_WAMAX + l, __ATOMIC_RELAXED, __HIP_MEMORY_SCOPE_AGENT)), inv = am > 0.f ? 448.f / am : 1.f;
          transpose_item_f8<true>(inp(I_W_IN) + (size_t)l * DM * NIN, DM, NIN, (unsigned char*)(F.ws + WS_WIN8) + (size_t)l * LDZ * DM, LDZ / 32, scr, r, lane, inv); } }
#endif
#if WO_FP8
    { LAS float* scr = (LAS float*)(F.lds + F.wave * 8448); const int lane = LANE_;
      for (int it = F.gw; it < 2 * 2048; it += F.NGW) { const int l = it >> 11, r = it & 2047;
          const float am = __uint_as_float(__hip_atomic_load(F.ctl + CW_WAMAX + 2 + l, __ATOMIC_RELAXED, __HIP_MEMORY_SCOPE_AGENT)), inv = am > 0.f ? 448.f / am : 1.f;
          transpose_item_f8<false>(inp(I_W_OUT) + (size_t)l * DM * DM, DM, DM, (unsigned char*)(F.ws + WS_WO8) + (size_t)l * DM * DM, 64, scr, r, lane, inv); } }
#endif
}
__device__ __forceinline__ void store_row_f8(const f32x4 (&y)[8], unsigned char* h8, float* sa, int lane) {
    float am = 0.f;
#pragma unroll
    for (int j = 0; j < 8; ++j) am = fmaxf(am, fmaxf(fmaxf(fabsf(y[j][0]), fabsf(y[j][1])), fmaxf(fabsf(y[j][2]), fabsf(y[j][3]))));
#pragma unroll
    for (int o = 1; o < 64; o <<= 1) am = fmaxf(am, __shfl_xor(am, o));
    const float inv = am > 0.f ? 448.f / am : 1.f;
#pragma unroll
    for (int j = 0; j < 8; ++j) { int w = __builtin_amdgcn_cvt_pk_fp8_f32(y[j][0] * inv, y[j][1] * inv, 0, false); w = __builtin_amdgcn_cvt_pk_fp8_f32(y[j][2] * inv, y[j][3] * inv, w, true); *(unsigned*)(h8 + 256 * j + 4 * lane) = (unsigned)w; }
    if (lane == 0) *sa = am > 0.f ? am * (1.f / 448.f) : 1.f;
}
__device__ __forceinline__ void norm_row_f8(const float* xin, const float* g, const float* sc, const float* sh, unsigned char* h8, float* sa, bf16_t* hout, bool wbf, int lane) {
    asm volatile("" : "+v"(lane));
    f32x4 v[8]; float s = 0.f;
#pragma unroll
    for (int j = 0; j < 8; ++j) { v[j] = *(const f32x4*)(xin + 256 * j + 4 * lane); s += (v[j][0] * v[j][0] + v[j][1] * v[j][1]) + (v[j][2] * v[j][2] + v[j][3] * v[j][3]); }
    const float rstd = rsqrtf(wave_sum(s) * (1.f / DM) + 1e-6f);
#pragma unroll
    for (int j = 0; j < 8; ++j) { const int o = 256 * j + 4 * lane; const f32x4 gg = *(const f32x4*)(g + o), a = *(const f32x4*)(sc + o), b = *(const f32x4*)(sh + o); v[j] = v[j] * rstd * gg * (1.f + a) + b;
        if (wbf) *(u32x2*)(hout + o) = (u32x2){pk2(v[j][0], v[j][1]), pk2(v[j][2], v[j][3])}; }
    store_row_f8(v, h8, sa, lane);
}
template <int NR, bool F8> __device__ __forceinline__ void norm_rows(const float* X, int m0, int mstride, const float* g, const float* sc, const float* sh, bf16_t* hout, unsigned char* h8, float* sa, int lane) {
    asm volatile("" : "+v"(lane));
    f32x4 v[NR][8]; float s[NR];
#pragma unroll
    for (int r = 0; r < NR; ++r) { const float* xin = X + (size_t)(m0 + r * mstride) * DM;
#pragma unroll
        for (int j = 0; j < 8; ++j) v[r][j] = *(const f32x4*)(xin + 256 * j + 4 * lane); }
    __builtin_amdgcn_sched_barrier(0);
#pragma unroll
    for (int r = 0; r < NR; ++r) { float t = 0.f;
#pragma unroll
        for (int j = 0; j < 8; ++j) t += (v[r][j][0] * v[r][j][0] + v[r][j][1] * v[r][j][1]) + (v[r][j][2] * v[r][j][2] + v[r][j][3] * v[r][j][3]);
        s[r] = rsqrtf(wave_sum(t) * (1.f / DM) + 1e-6f); }
#pragma unroll
    for (int jh = 0; jh < 4; ++jh) {
        f32x4 gg[2], aa[2], bb[2];
#pragma unroll
        for (int jj = 0; jj < 2; ++jj) { const int o = 256 * (2 * jh + jj) + 4 * lane; gg[jj] = *(const f32x4*)(g + o); aa[jj] = *(const f32x4*)(sc + o); bb[jj] = *(const f32x4*)(sh + o); }
        __builtin_amdgcn_sched_barrier(0);
#pragma unroll
        for (int jj = 0; jj < 2; ++jj) { const int j = 2 * jh + jj, o = 256 * j + 4 * lane;
#pragma unroll
            for (int r = 0; r < NR; ++r) { v[r][j] = v[r][j] * s[r] * gg[jj] * (1.f + aa[jj]) + bb[jj];
                if (!F8) *(u32x2*)(hout + (size_t)(m0 + r * mstride) * DM + o) = (u32x2){pk2(v[r][j][0], v[r][j][1]), pk2(v[r][j][2], v[r][j][3])}; } }
        __builtin_amdgcn_sched_barrier(0); }
    if (F8) {
#pragma unroll
        for (int r = 0; r < NR; ++r) store_row_f8(v[r], h8 + (size_t)(m0 + r * mstride) * DM, sa + (m0 + r * mstride), lane); }
}
__device__ __forceinline__ void norm_row(const float* xin, const float* g, const float* sc, const float* sh, bf16_t* hout, float* xcopy, int lane) {
    asm volatile("" : "+v"(lane));
    f32x4 v[8]; float s = 0.f;
#pragma unroll
    for (int j = 0; j < 8; ++j) { v[j] = *(const f32x4*)(xin + 256 * j + 4 * lane); s += (v[j][0] * v[j][0] + v[j][1] * v[j][1]) + (v[j][2] * v[j][2] + v[j][3] * v[j][3]); }
    const float rstd = rsqrtf(wave_sum(s) * (1.f / DM) + 1e-6f);
#pragma unroll
    for (int j = 0; j < 8; ++j) { const int o = 256 * j + 4 * lane; const f32x4 gg = *(const f32x4*)(g + o), a = *(const f32x4*)(sc + o), b = *(const f32x4*)(sh + o);
        const f32x4 y = v[j] * rstd * gg * (1.f + a) + b;
        u32x2 w; w.x = pk2(y[0], y[1]); w.y = pk2(y[2], y[3]);
#if WT_STORES
        __hip_atomic_store((unsigned long long*)(hout + o), ((unsigned long long)w.y << 32) | w.x, __ATOMIC_RELAXED, __HIP_MEMORY_SCOPE_AGENT);
#else
        *(u32x2*)(hout + o) = w;
#endif
        if (xcopy) *(f32x4*)(xcopy + o) = v[j]; }
}

constexpr int IDX_CH = 8;
struct IdxTab { unsigned short v[320]; };
constexpr IdxTab make_idx_tab() { IdxTab t{}; int n = 0;
    for (int sz = IDX_CH; sz >= 1; --sz) for (int qb = 127; qb >= 0; --qb) { const int ns = qb / 4 + 1;
        for (int c = 0; c * IDX_CH < ns; ++c) { const int s = ns - IDX_CH * c < IDX_CH ? ns - IDX_CH * c : IDX_CH; if (s == sz) t.v[n++] = (unsigned short)(qb * 8 + c); } }
    return t; }
__constant__ const IdxTab IDXTAB = make_idx_tab();
constexpr int N_IDX_ITEMS = 320;

__device__ __forceinline__ float relu_fmac(float a, float c, float w) { float r; asm("v_max_f32_e32 %0, 0, %1" : "=v"(r) : "v"(c)); asm("v_fmac_f32_e32 %0, %1, %2" : "+v"(a) : "v"(r), "v"(w)); return a; }
__device__ __forceinline__ void indexer_item(Frame& F, int item) {
    const int code = __builtin_amdgcn_readfirstlane((int)IDXTAB.v[item]), qb = code >> 3, chunk = code & 7;
    const int nsteps_tot = qb / 4 + 1, s0 = chunk * IDX_CH, s1 = (s0 + IDX_CH < nsteps_tot) ? s0 + IDX_CH : nsteps_tot;
    int tid = TID_; asm volatile("" : "+v"(tid));
    const int lane = tid & 63, wid = F.wave, r32 = lane & 31, hi = lane >> 5, qg = wid >> 2, kg = wid & 3;
    const bf16_t* Z = (const bf16_t*)(F.ws + WS_Z); const float* zs = (const float*)(F.ws + WS_ZS); float* SC = (float*)(F.ws + WS_SC);
    LAS unsigned char* iqL = F.lds;
    __syncthreads();
    { u32x4 sv[16];
#pragma unroll
      for (int it = 0; it < 16; ++it) { const int i = tid + 512 * it, q = i >> 7, ch = i & 127; sv[it] = *(const u32x4*)(Z + (size_t)(qb * 64 + q) * LDZ + ZC_IQ + ch * 8); }
      __builtin_amdgcn_sched_barrier(0);
#pragma unroll
      for (int it = 0; it < 16; ++it) { const int i = tid + 512 * it, q = i >> 7, ch = i & 127; *(LAS u32x4*)(iqL + q * 2048 + ((ch ^ (q & 15)) << 4)) = sv[it]; } }
    const int qrow = 32 * qg + r32, tq = qb * 64 + qrow;
    f32x2 wp[8];
#pragma unroll
    for (int h4 = 0; h4 < 4; ++h4) { const f32x4 t4 = *(const f32x4*)(zs + (size_t)tq * 64 + ZS_IW + 4 * h4);
        wp[2 * h4] = (f32x2){t4[0] * 0.03125f, t4[1] * 0.03125f}; wp[2 * h4 + 1] = (f32x2){t4[2] * 0.03125f, t4[3] * 0.03125f}; }
    __syncthreads();
    const int qx = qrow & 15;
    bf16x8 ikf[2][4];
    { const int kb0 = s0 * 256 + kg * 64;
#pragma unroll
      for (int nb = 0; nb < 2; ++nb)
#pragma unroll
        for (int ks = 0; ks < 4; ++ks) ikf[nb][ks] = *(const bf16x8*)(Z + (size_t)(kb0 + 32 * nb + r32) * LDZ + ZC_IK + ks * 16 + hi * 8); }
#define IDX_Q_(SEL) "v_max_f32_e32 v248, 0, %4\n\tv_max_f32_e32 v249, 0, %5\n\tv_pk_fma_f32 %0, v[248:249], %12, %0 " SEL "\n\t" \
                      "v_max_f32_e32 v248, 0, %6\n\tv_max_f32_e32 v249, 0, %7\n\tv_pk_fma_f32 %1, v[248:249], %12, %1 " SEL "\n\t" \
                      "v_max_f32_e32 v248, 0, %8\n\tv_max_f32_e32 v249, 0, %9\n\tv_pk_fma_f32 %2, v[248:249], %12, %2 " SEL "\n\t" \
                      "v_max_f32_e32 v248, 0, %10\n\tv_max_f32_e32 v249, 0, %11\n\tv_pk_fma_f32 %3, v[248:249], %12, %3 " SEL
#define IDX_QUAD(A, P, B_, WP, ODD) do { if (ODD) asm volatile(IDX_Q_("op_sel:[0,1,0] op_sel_hi:[1,1,1]") \
                : "+v"(A[B_]), "+v"(A[B_ + 1]), "+v"(A[B_ + 2]), "+v"(A[B_ + 3]) \
                : "v"(P[2 * (B_)]), "v"(P[2 * (B_) + 1]), "v"(P[2 * (B_) + 2]), "v"(P[2 * (B_) + 3]), "v"(P[2 * (B_) + 4]), "v"(P[2 * (B_) + 5]), "v"(P[2 * (B_) + 6]), "v"(P[2 * (B_) + 7]), "v"(WP) : "v248", "v249"); \
            else asm volatile(IDX_Q_("op_sel:[0,0,0] op_sel_hi:[1,0,1]") \
                : "+v"(A[B_]), "+v"(A[B_ + 1]), "+v"(A[B_ + 2]), "+v"(A[B_ + 3]) \
                : "v"(P[2 * (B_)]), "v"(P[2 * (B_) + 1]), "v"(P[2 * (B_) + 2]), "v"(P[2 * (B_) + 3]), "v"(P[2 * (B_) + 4]), "v"(P[2 * (B_) + 5]), "v"(P[2 * (B_) + 6]), "v"(P[2 * (B_) + 7]), "v"(WP) : "v248", "v249"); } while (0)
#define IDX_V(A, C, H) do { IDX_QUAD(A, C, 0, wp[(H) >> 1], (H) & 1); IDX_QUAD(A, C, 4, wp[(H) >> 1], (H) & 1); } while (0)
#define IDX_LDQ(H) do { _Pragma("unroll") for (int ks = 0; ks < 4; ++ks) bq[ks] = *(const LAS bf16x8*)(qad[(H) & 1][ks] + ((H) >> 1) * 256); } while (0)
#define IDX_M(C, NB) do { C = f32x16{}; _Pragma("unroll") for (int ks = 0; ks < 4; ++ks) C = __builtin_amdgcn_mfma_f32_32x32x16_bf16(ikf[NB][ks], bq[ks], C, 0, 0, 0); } while (0)
#define IDX_ZERO(A0, A1) do { _Pragma("unroll") for (int r = 0; r < 8; ++r) { asm volatile("v_mov_b64 %0, 0" : "=v"(A0[r])); asm volatile("v_mov_b64 %0, 0" : "=v"(A1[r])); } } while (0)
#define IDX_STEP(A0, A1, N0, N1, ST) do { const int kbase = (ST) * 256 + kg * 64;                                                                            \
        bf16x8 ikn[2][4];                                                       \
        { const int kb2 = (((ST) + 1 < s1) ? (ST) + 1 : (ST)) * 256 + kg * 64;                                                                        \
          _Pragma("unroll") for (int nb = 0; nb < 2; ++nb) _Pragma("unroll") for (int ks = 0; ks < 4; ++ks)                                           \
              ikn[nb][ks] = *(const bf16x8*)(Z + (size_t)(kb2 + 32 * nb + r32) * LDZ + ZC_IK + ks * 16 + hi * 8); }                                     \
        int qoff = qrow * 2048; asm volatile("" : "+v"(qoff));                     \
                           \
        const LAS unsigned char* qad[2][4];                                                                                                          \
        _Pragma("unroll") for (int hb = 0; hb < 2; ++hb) _Pragma("unroll") for (int ks = 0; ks < 4; ++ks)                                             \
            qad[hb][ks] = iqL + qoff + (((hb ^ (qx >> 3)) << 7) | (((ks * 2 + hi) ^ (qx & 7)) << 4));                                                  \
        f32x16 c0, c1; bf16x8 bq[4];                                                                                                                 \
        IDX_LDQ(0); IDX_M(c0, 0); __builtin_amdgcn_sched_barrier(0);                                                                                 \
        _Pragma("unroll") for (int h = 0; h < 16; ++h) {                                                                                             \
            if (h > 0) IDX_V(A1, c1, h - 1);                                                                                                         \
            __builtin_amdgcn_sched_barrier(0);                                                                                                       \
            IDX_M(c1, 1);                                                                                                                            \
            __builtin_amdgcn_sched_barrier(0);                                                                                                       \
            if (h < 15) IDX_LDQ(h + 1);                                                                                                              \
            __builtin_amdgcn_sched_barrier(0);                                                                                                       \
            IDX_V(A0, c0, h);                                                                                                                        \
            __builtin_amdgcn_sched_barrier(0);                                                                                                       \
            if (h < 15) IDX_M(c0, 0);                                                                                                                \
            __builtin_amdgcn_sched_barrier(0);                                                                                                       \
        }                                                                                                                                            \
        asm volatile("s_nop 15\n\ts_nop 15" : "+v"(c1));                         \
        IDX_V(A1, c1, 15);                                                                                                                           \
        __builtin_amdgcn_sched_barrier(0); IDX_ZERO(N0, N1); __builtin_amdgcn_sched_barrier(0);     \
        float* srow = SC + (size_t)tq * S + kbase + 4 * hi;                                                                                          \
        _Pragma("unroll") for (int g = 0; g < 4; ++g) { *(f32x4*)(srow + 8 * g) = (f32x4){A0[2 * g][0], A0[2 * g][1], A0[2 * g + 1][0], A0[2 * g + 1][1]};   \
                                      *(f32x4*)(srow + 32 + 8 * g) = (f32x4){A1[2 * g][0], A1[2 * g][1], A1[2 * g + 1][0], A1[2 * g + 1][1]}; }       \
        _Pragma("unroll") for (int nb = 0; nb < 2; ++nb) _Pragma("unroll") for (int ks = 0; ks < 4; ++ks) ikf[nb][ks] = ikn[nb][ks]; } while (0)
    f32x2 aA0[8], aA1[8], aB0[8], aB1[8];
    IDX_ZERO(aA0, aA1);
#pragma unroll 1
    for (int st = s0; st < s1; st += 2) {
        IDX_STEP(aA0, aA1, aB0, aB1, st);
        if (st + 1 < s1) IDX_STEP(aB0, aB1, aA0, aA1, st + 1); else IDX_ZERO(aA0, aA1);
    }
#undef IDX_STEP
#undef IDX_ZERO
#undef IDX_M
#undef IDX_LDQ
#undef IDX_V
#undef IDX_QUAD
#undef IDX_Q_
}

constexpr int G1_G = 0, G1_QG = 32768, G1_KG = 50176, G1_KDT = 67584, G1_VT = 86016, G1_AL = 104448;
__device__ __forceinline__ void gla_g1_item(Frame& F, int l, int item) {
    const int n = item >> 2, h = item & 3;
    int tid = TID_; asm volatile("" : "+v"(tid));
    const int lane = tid & 63, wid = F.wave, r32 = lane & 31, hi = lane >> 5;
    const bf16_t* Z = (const bf16_t*)(F.ws + WS_Z); const float* zs = (const float*)(F.ws + WS_ZS);
    LAS float* G = (LAS float*)(F.lds + G1_G);
    LAS bf16_t* QG = (LAS bf16_t*)(F.lds + G1_QG); LAS bf16_t* KG = (LAS bf16_t*)(F.lds + G1_KG);
    LAS bf16_t* KDT = (LAS bf16_t*)(F.lds + G1_KDT); LAS bf16_t* VT = (LAS bf16_t*)(F.lds + G1_VT); LAS bf16_t* AL = (LAS bf16_t*)(F.lds + G1_AL);
    const int t = tid >> 3, dg = tid & 7, d0 = dg * 16; const size_t trow = (size_t)n * 64 + t;
    __syncthreads();
    { float ga[16];
#pragma unroll
      for (int r4 = 0; r4 < 4; ++r4) { const f32x4 v = *(const f32x4*)(zs + trow * 64 + ZS_GA + 4 * r4); ga[4 * r4] = v[0]; ga[4 * r4 + 1] = v[1]; ga[4 * r4 + 2] = v[2]; ga[4 * r4 + 3] = v[3]; }
      const float* wa = inp(I_GLA_WA2) + (size_t)l * 16 * 512 + h * 128 + d0; const float* ba = inp(I_GLA_BA) + (size_t)l * 512 + h * 128 + d0;
#pragma unroll
      for (int i4 = 0; i4 < 4; ++i4) { f32x4 x = *(const f32x4*)(ba + 4 * i4);
#pragma unroll
          for (int r = 0; r < 16; ++r) x = x + ga[r] * *(const f32x4*)(wa + (size_t)r * 512 + 4 * i4);
          f32x4 la; la[0] = logsigmoidf(x[0]) * 0.0625f; la[1] = logsigmoidf(x[1]) * 0.0625f; la[2] = logsigmoidf(x[2]) * 0.0625f; la[3] = logsigmoidf(x[3]) * 0.0625f;
          *(LAS f32x4*)(G + t * 128 + d0 + 4 * i4) = la; } }
    __syncthreads();
    if (tid < 128) { float run = 0.f; for (int tt = 0; tt < 64; ++tt) { run += G[tt * 128 + tid]; G[tt * 128 + tid] = run; } }
    __syncthreads();
    { const bf16_t* zr = Z + trow * LDZ + h * 128 + d0;
      unsigned qv[8], kv[8], vv[8];
      { const u32x4 a = *(const u32x4*)(zr + ZC_GQ), b = *(const u32x4*)(zr + ZC_GQ + 8); qv[0] = a.x; qv[1] = a.y; qv[2] = a.z; qv[3] = a.w; qv[4] = b.x; qv[5] = b.y; qv[6] = b.z; qv[7] = b.w; }
      { const u32x4 a = *(const u32x4*)(zr + ZC_GK), b = *(const u32x4*)(zr + ZC_GK + 8); kv[0] = a.x; kv[1] = a.y; kv[2] = a.z; kv[3] = a.w; kv[4] = b.x; kv[5] = b.y; kv[6] = b.z; kv[7] = b.w; }
      { const u32x4 a = *(const u32x4*)(zr + ZC_GV), b = *(const u32x4*)(zr + ZC_GV + 8); vv[0] = a.x; vv[1] = a.y; vv[2] = a.z; vv[3] = a.w; vv[4] = b.x; vv[5] = b.y; vv[6] = b.z; vv[7] = b.w; }
      unsigned qgp[8];
#pragma unroll
      for (int i2 = 0; i2 < 8; ++i2) { float qg2[2];
#pragma unroll
          for (int e = 0; e < 2; ++e) { const int d = d0 + 2 * i2 + e; const float g = G[t * 128 + d], gl = G[63 * 128 + d];
              const float q = e ? bfhi(qv[i2]) : bflo(qv[i2]), k = e ? bfhi(kv[i2]) : bflo(kv[i2]), v = e ? bfhi(vv[i2]) : bflo(vv[i2]);
              const float qg = q * 0.08838834764831845f * __expf(g), kg = k * __expf(-g), kd = k * __expf(gl - g);
              qg2[e] = qg; KG[t * 136 + d] = (bf16_t)f2bf(kg); KDT[d * 72 + t] = (bf16_t)f2bf(kd); VT[d * 72 + t] = (bf16_t)f2bf(v);
              if (t == 63) ((float*)(F.ws + WS_DECAY))[((size_t)n * 4 + h) * 128 + d] = __expf(gl); }
          qgp[i2] = pk2(qg2[0], qg2[1]); *(LAS unsigned*)(QG + t * 136 + d0 + 2 * i2) = qgp[i2]; }
      bf16_t* qgo = (bf16_t*)(F.ws + WS_QG) + trow * 512 + h * 128 + d0;
      *(u32x4*)qgo = (u32x4){qgp[0], qgp[1], qgp[2], qgp[3]}; *(u32x4*)(qgo + 8) = (u32x4){qgp[4], qgp[5], qgp[6], qgp[7]}; }
    __syncthreads();
    if (wid < 4) { const int ti = wid >> 1, tj = wid & 1; f32x16 c = {};
        mma32<8>(c, (const bf16_t*)QG + ti * 32 * 136, 136, (const bf16_t*)KG + tj * 32 * 136, 136, r32, hi);
#pragma unroll
        for (int r = 0; r < 16; ++r) { const int tt = 32 * ti + crow(r, hi), ss = 32 * tj + r32; AL[tt * 72 + ss] = (bf16_t)f2bf(ss <= tt ? c[r] : 0.f); } }
    { float* UT = (float*)(F.ws + WS_UT) + ((size_t)n * 4 + h) * 128 * 128;
#pragma unroll 1
      for (int q = 0; q < 2; ++q) { const int id = wid + 8 * q, dvb = id >> 2, dkb = id & 3; f32x16 c = {};
          mma32<4>(c, (const bf16_t*)VT + dvb * 32 * 72, 72, (const bf16_t*)KDT + dkb * 32 * 72, 72, r32, hi);
          float* up = UT + (size_t)(32 * dvb + 4 * hi) * 128 + 32 * dkb + r32;
#pragma unroll
          for (int r = 0; r < 16; ++r) up[((r & 3) + 8 * (r >> 2)) * 128] = c[r]; } }
    __syncthreads();
    { const int ti = wid >> 2, tj = wid & 3; f32x16 c = {};
      mma32<4>(c, (const bf16_t*)AL + ti * 32 * 72, 72, (const bf16_t*)VT + tj * 32 * 72, 72, r32, hi);
      float* ip = (float*)(F.ws + WS_INTRA) + ((size_t)n * 64 + 32 * ti + 4 * hi) * 512 + h * 128 + 32 * tj + r32;
#pragma unroll
      for (int r = 0; r < 16; ++r) ip[((r & 3) + 8 * (r >> 2)) * 512] = c[r]; }
}
__device__ __forceinline__ void fox_cumsum_item(Frame& F, int l) {
    int tid = TID_; asm volatile("" : "+v"(tid));
    const int lane = tid & 63, wid = F.wave;
    const float* zs = (const float*)(F.ws + WS_ZS) + (size_t)(tid * 16) * 64 + ZS_FF; const float* fbp = inp(I_FOX_FBIAS) + l * 6;
    LAS float* sc = (LAS float*)F.lds;
    __syncthreads();
    float v[16][6];
#pragma unroll
    for (int i = 0; i < 16; ++i) { const f32x4 a = *(const f32x4*)(zs + (size_t)i * 64); const f32x2 b = *(const f32x2*)(zs + (size_t)i * 64 + 4);
        v[i][0] = a[0]; v[i][1] = a[1]; v[i][2] = a[2]; v[i][3] = a[3]; v[i][4] = b[0]; v[i][5] = b[1]; }
    float tot[6], incl[6];
#pragma unroll
    for (int h = 0; h < 6; ++h) { const float fb = fbp[h]; float run = 0.f;
#pragma unroll
        for (int i = 0; i < 16; ++i) { run += logsigmoidf(v[i][h] + fb); v[i][h] = run; }
        tot[h] = run; incl[h] = run; }
#pragma unroll
    for (int o = 1; o < 64; o <<= 1)
#pragma unroll
        for (int h = 0; h < 6; ++h) { const float u = __shfl_up(incl[h], o); if (lane >= o) incl[h] += u; }
    if (lane == 63) {
#pragma unroll
        for (int h = 0; h < 6; ++h) sc[wid * 8 + h] = incl[h]; }
    __syncthreads();
#pragma unroll
    for (int h = 0; h < 6; ++h) { float base = incl[h] - tot[h];
#pragma unroll
        for (int w = 0; w < 7; ++w) base += (w < wid) ? sc[w * 8 + h] : 0.f;
        float* nF = (float*)(F.ws + WS_FCUM) + (size_t)h * S + tid * 16;
#pragma unroll
        for (int i4 = 0; i4 < 4; ++i4) *(f32x4*)(nF + 4 * i4) = (f32x4){-11.313708498984761f * (base + v[4 * i4][h]), -11.313708498984761f * (base + v[4 * i4 + 1][h]),
                                                                       -11.313708498984761f * (base + v[4 * i4 + 2][h]), -11.313708498984761f * (base + v[4 * i4 + 3][h])}; }
    __syncthreads();
}
__device__ __forceinline__ void fox_norm_item(Frame& F, int l, int item) {
    int tid = TID_; asm volatile("" : "+v"(tid));
    const int row = item * 128 + (tid >> 2), part = tid & 3; const bf16_t* zr = (const bf16_t*)(F.ws + WS_ZH) + (size_t)row * 128 + part * 32;
    float qmx = 0.f, kmx = 0.f;
#pragma unroll 2
    for (int hd = 0; hd < 6; ++hd) {
        float sq = 0.f, sk = 0.f;
#pragma unroll
        for (int c = 0; c < 4; ++c) { const u32x4 a = *(const u32x4*)(zr + (size_t)hd * S * 128 + c * 8), b = *(const u32x4*)(zr + (size_t)(6 + hd) * S * 128 + c * 8);
            sq += bflo(a.x) * bflo(a.x) + bfhi(a.x) * bfhi(a.x) + bflo(a.y) * bflo(a.y) + bfhi(a.y) * bfhi(a.y) + bflo(a.z) * bflo(a.z) + bfhi(a.z) * bfhi(a.z) + bflo(a.w) * bflo(a.w) + bfhi(a.w) * bfhi(a.w);
            sk += bflo(b.x) * bflo(b.x) + bfhi(b.x) * bfhi(b.x) + bflo(b.y) * bflo(b.y) + bfhi(b.y) * bfhi(b.y) + bflo(b.z) * bflo(b.z) + bfhi(b.z) * bfhi(b.z) + bflo(b.w) * bflo(b.w) + bfhi(b.w) * bfhi(b.w); }
        sq += __shfl_xor(sq, 1); sq += __shfl_xor(sq, 2); sk += __shfl_xor(sk, 1); sk += __shfl_xor(sk, 2);
        qmx = fmaxf(qmx, sq); kmx = fmaxf(kmx, sk); }
#pragma unroll
    for (int o = 4; o < 64; o <<= 1) { qmx = fmaxf(qmx, __shfl_xor(qmx, o)); kmx = fmaxf(kmx, __shfl_xor(kmx, o)); }
    if ((tid & 63) == 0) { atomicMax(F.ctl + CW_FOXN + 2 * l, __float_as_uint(sqrtf(qmx) * 1.001f)); atomicMax(F.ctl + CW_FOXN + 2 * l + 1, __float_as_uint(sqrtf(kmx) * 1.001f)); }
}

#define SEL_K 256
__device__ __forceinline__ void sel_scan(LAS unsigned* hist, int lane, unsigned k, unsigned& bin, unsigned& rank, unsigned& cnt_at) {
    unsigned s = 0;
#pragma unroll
    for (int q = 0; q < 8; ++q) { const u32x4 v = *(const LAS u32x4*)(hist + 32 * lane + 4 * q); s += (v.x + v.y) + (v.z + v.w); }
    unsigned incl = s;
#pragma unroll
    for (int o = 1; o < 64; o <<= 1) { const unsigned v = __shfl_up(incl, o); if (lane >= o) incl += v; }
    const unsigned total = __shfl(incl, 63);
    const unsigned above = total - incl;
    const bool mine = (above < k) && (above + s >= k);
    const unsigned long long bal = __ballot(mine);
    const int src = bal ? (int)__builtin_ctzll(bal) : 0;
    const unsigned run0 = __shfl(above, src);
    const unsigned cb = hist[32 * src + (lane & 31)];
    unsigned suf = cb;
#pragma unroll
    for (int o = 1; o < 32; o <<= 1) { const unsigned v = __shfl_down(suf, o, 32); if ((lane & 31) + o < 32) suf += v; }
    const unsigned abv = run0 + suf - cb;
    const bool hit = (abv < k) && (abv + cb >= k);
    const unsigned long long hb = __ballot(hit) & 0xFFFFFFFFull;
    const int bsel = hb ? (int)__builtin_ctzll(hb) : 0;
    bin = (unsigned)(32 * src + bsel); rank = k - __shfl(abv, bsel); cnt_at = __shfl(cb, bsel);
}
__device__ __forceinline__ void select_row(const float* srow, int t, unsigned long long* mout, LAS unsigned* hist, int lane) {
    asm volatile("" : "+v"(lane));
    const int n = t + 1;
    if (n <= SEL_K) {
#pragma unroll
        for (int q = 0; q < 2; ++q) { const int wI = lane + 64 * q, lo = 64 * wI;
            const unsigned long long bits = (n >= lo + 64) ? ~0ull : (n > lo ? ((1ull << (n - lo)) - 1ull) : 0ull); mout[wI] = bits; }
        return;
    }
    unsigned key[128];
#pragma unroll
    for (int ch = 0; ch < 4; ++ch) {
        if (ch * 2048 < n) {
#pragma unroll
            for (int j = 32 * ch; j < 32 * ch + 32; ++j) key[j] = __float_as_uint(srow[64 * j + lane]);
            __builtin_amdgcn_sched_barrier(0);
#pragma unroll
            for (int j = 32 * ch; j < 32 * ch + 32; ++j) { const int idx = 64 * j + lane; const unsigned u = key[j]; const unsigned kx = u ^ ((unsigned)((int)u >> 31) | 0x80000000u);
                key[j] = idx < n ? kx : 0u; }
        } else {
#pragma unroll
            for (int j = 32 * ch; j < 32 * ch + 32; ++j) key[j] = 0u;
        }
    }
    unsigned prefix = 0, k = SEL_K, cnt_at = 0;
#pragma unroll
    for (int pass = 0; pass < 3; ++pass) {
        const int shift = pass == 0 ? 21 : pass == 1 ? 10 : 0; const unsigned dmask = pass == 2 ? 0x3FFu : 0x7FFu;
        const int pshift = pass == 0 ? 31 : pass == 1 ? 21 : 10;
#pragma unroll
        for (int q = 0; q < 8; ++q) *(LAS u32x4*)(hist + 32 * lane + 4 * q) = (u32x4){0u, 0u, 0u, 0u};
        asm volatile("s_waitcnt lgkmcnt(0)" ::: "memory");
        if (pass == 0) {
#pragma unroll
            for (int g8 = 0; g8 < 16; ++g8) {
                if (g8 * 512 < n) {
#pragma unroll
                    for (int j = 8 * g8; j < 8 * g8 + 8; ++j) __hip_atomic_fetch_add(hist + (key[j] >> 21), 1u, __ATOMIC_RELAXED, __HIP_MEMORY_SCOPE_WORKGROUP);
                }
            }
        } else {
#pragma unroll
            for (int ch = 0; ch < 4; ++ch) {
                if (ch * 2048 < n) {
#pragma unroll
                    for (int j = 32 * ch; j < 32 * ch + 32; ++j) { const unsigned kk = key[j];
                        const bool ok = (kk != 0u) && ((kk >> pshift) == prefix);
                        if (ok) __hip_atomic_fetch_add(hist + ((kk >> shift) & dmask), 1u, __ATOMIC_RELAXED, __HIP_MEMORY_SCOPE_WORKGROUP); }
                }
            }
        }
        asm volatile("s_waitcnt lgkmcnt(0)" ::: "memory");
        unsigned bin, rank;
        sel_scan(hist, lane, k, bin, rank, cnt_at);
        prefix = (pass == 0) ? bin : ((prefix << (pass == 1 ? 11 : 10)) | bin);
        k = rank;
    }
    const unsigned T = prefix;
    unsigned need = k;
    int m0l = 0, m0h = 0, m1l = 0, m1h = 0;
    if (need == cnt_at) {
#pragma unroll
        for (int ch = 0; ch < 4; ++ch) {
            if (ch * 2048 < n) {
#pragma unroll
                for (int j = 32 * ch; j < 32 * ch + 32; ++j) { const unsigned long long m = __ballot(key[j] >= T); const int lo_ = __builtin_amdgcn_readfirstlane((int)(unsigned)m), hi_ = __builtin_amdgcn_readfirstlane((int)(unsigned)(m >> 32));
                    if (j < 64) asm volatile("s_nop 4\n\tv_writelane_b32 %0, %2, %4\n\tv_writelane_b32 %1, %3, %4\n\ts_nop 1" : "+v"(m0l), "+v"(m0h) : "s"(lo_), "s"(hi_), "i"(j & 63));
                    else asm volatile("s_nop 4\n\tv_writelane_b32 %0, %2, %4\n\tv_writelane_b32 %1, %3, %4\n\ts_nop 1" : "+v"(m1l), "+v"(m1h) : "s"(lo_), "s"(hi_), "i"(j & 63)); }
            }
        }
    } else {
#pragma unroll 1
        for (int ch = 0; ch < 4; ++ch) {
            if (ch * 2048 < n) {
#pragma unroll
                for (int jj = 0; jj < 32; ++jj) { const unsigned kk = ch == 0 ? key[jj] : ch == 1 ? key[32 + jj] : ch == 2 ? key[64 + jj] : key[96 + jj]; const int j = 32 * ch + jj;
                    const unsigned long long beq = __ballot(kk == T);
                    const unsigned before = __builtin_amdgcn_mbcnt_hi((unsigned)(beq >> 32), __builtin_amdgcn_mbcnt_lo((unsigned)beq, 0u));
                    const unsigned long long m = __ballot((kk > T) || ((kk == T) && (before < need)));
                    const unsigned c = (unsigned)__builtin_popcountll(beq); need -= (c < need ? c : need);
                    if (j < 64) { if (lane == j) { m0l = (int)(unsigned)m; m0h = (int)(unsigned)(m >> 32); } } else { if (lane == j - 64) { m1l = (int)(unsigned)m; m1h = (int)(unsigned)(m >> 32); } } }
            }
        }
    }
    const unsigned long long m0 = ((unsigned long long)(unsigned)m0h << 32) | (unsigned)m0l, m1 = ((unsigned long long)(unsigned)m1h << 32) | (unsigned)m1l;
    mout[lane] = m0; mout[lane + 64] = m1;
}
__device__ __forceinline__ void phase_select(Frame& F, int sel_ctr_base) {
    int tid_ = TID_; asm volatile("" : "+v"(tid_));
    if (tid_ < 256) {
        const float* UT = (const float*)(F.ws + WS_UT); const float* DEC = (const float*)(F.ws + WS_DECAY); bf16_t* ST = (bf16_t*)(F.ws + WS_ST);
        for (int e = blockIdx.x * 256 + tid_; e < 4 * 128 * 128; e += F.G * 256) { const int h = e >> 14, dk = e & 127; const int off = e & 16383;
            float s = 0.f;
#pragma unroll 1
            for (int n0 = 0; n0 < 128; n0 += 32) { float u_[32], d_[32];
#pragma unroll
                for (int i = 0; i < 32; ++i) { const size_t base = ((size_t)(n0 + i) * 4 + h) * 16384 + off; u_[i] = UT[base]; d_[i] = DEC[((size_t)(n0 + i) * 4 + h) * 128 + dk]; }
#pragma unroll
                for (int i = 0; i < 32; ++i) { const size_t base = ((size_t)(n0 + i) * 4 + h) * 16384 + off; ST[base] = (bf16_t)f2bf(s); s = fmaf(d_[i], s, u_[i]); } } }
    }
    const float* SC = (const float*)(F.ws + WS_SC); unsigned long long* MK = (unsigned long long*)(F.ws + WS_MASK);
    LAS unsigned* hist = (LAS unsigned*)(F.lds + F.wave * 8192);
    const int ppb = (S / 2 + F.G - 1) / F.G, pbeg = blockIdx.x * ppb, pend = (pbeg + ppb < S / 2) ? pbeg + ppb : S / 2;
    LAS unsigned* ctr = (LAS unsigned*)&F.MISC[16];
#pragma unroll 1
    for (;;) {
        unsigned got = 0; if (LANE_ == 0) got = __hip_atomic_fetch_add(ctr, 1u, __ATOMIC_RELAXED, __HIP_MEMORY_SCOPE_WORKGROUP);
        const int p = pbeg + (int)(__builtin_amdgcn_readfirstlane((int)got) - sel_ctr_base);
        if (p >= pend) break;
#pragma unroll 1
        for (int sd = 0; sd < 2; ++sd) { const int t = sd ? S - 1 - p : p;
            for (int rr_ = 0; rr_ < REP_SEL; ++rr_) select_row(SC + (size_t)t * S, t, MK + (size_t)t * 128, hist, LANE_); }
    }
}

struct AttTab { unsigned short v[288]; };
constexpr AttTab make_att_tab() { AttTab t{}; int n = 0;
    for (int sz = 64; sz >= 1; --sz) for (int qb = 31; qb >= 0; --qb) { const int nt = 4 * (qb + 1);
        if (qb >= 16) { if (nt / 2 == sz) for (int hd = 0; hd < 6; ++hd) { t.v[n++] = (unsigned short)(qb | hd << 5 | 1 << 8); t.v[n++] = (unsigned short)(qb | hd << 5 | 2 << 8); } }
        else if (nt == sz) for (int hd = 0; hd < 6; ++hd) t.v[n++] = (unsigned short)(qb | hd << 5); }
    return t; }
__constant__ const AttTab ATTTAB = make_att_tab();
constexpr int N_DSA_ITEMS = 288, N_ATT_ITEMS = N_DSA_ITEMS + 192;
constexpr size_t WS_PART = WS_SC + 64 * MiB;
constexpr int PART_FLOATS = 8 * 16 * 256 + 512, CW_SPLIT = 40960;
__device__ __forceinline__ att::BlockRef att_ref(Frame& F, int l_, int item) {
    int kind, qb, hd, mode = 0;
    if (item < N_DSA_ITEMS) { const int c = __builtin_amdgcn_readfirstlane((int)ATTTAB.v[item]); kind = 1; qb = c & 31; hd = (c >> 5) & 7; mode = c >> 8; }
    else { const int j = item - N_DSA_ITEMS; kind = 0; qb = 31 - j / 6; hd = j % 6; }
    const att::bf16* ZH = (const att::bf16*)(F.ws + WS_ZH); att::bf16* MIX = (att::bf16*)(F.ws + WS_MIX);
    att::BlockRef b;
    const int hb = kind ? 18 : 0;
    b.Q = ZH + ((size_t)(hb + hd) * S + qb * 256) * 128; b.K = ZH + (size_t)(hb + 6 + hd) * S * 128; b.V = ZH + (size_t)(hb + 12 + hd) * S * 128;
    b.O = MIX + (size_t)(qb * 256) * DM + (kind ? 1280 : 0) + hd * 128;
#if WO_FP8
    b.O8 = (unsigned char*)(F.ws + WS_MIX8) + (size_t)(qb * 256) * DM + (kind ? 1280 : 0) + hd * 128; b.ovf = F.ctl + CW_MIXOVF + l_;
#endif
    b.P0 = qb * 256; b.kind = kind;
    b.bias = (const float*)(F.ws + WS_FCUM) + (size_t)hd * S;
    b.mask = (const unsigned long long*)(F.ws + WS_MASK);
    const int nt = 4 * (qb + 1);
    b.j0 = (mode == 2) ? nt / 2 : 0; b.j1 = (mode == 1) ? nt / 2 : nt; b.part = mode != 0;
    { const int slot = ((qb & 15) * 6 + hd) * 2; float* pbase = (float*)(F.ws + WS_PART);
      b.pself = pbase + (size_t)(slot + (mode == 2 ? 1 : 0)) * PART_FLOATS; b.pother = pbase + (size_t)(slot + (mode == 2 ? 0 : 1)) * PART_FLOATS;
      b.pcnt = F.ctl + CW_SPLIT + l_ * 128 + (qb & 15) * 6 + hd; }
    if (kind == 0) {
        const unsigned* nm = (const unsigned*)(F.ctl + CW_FOXN + 2 * l_);
        const float qm = __uint_as_float(__hip_atomic_load(nm, __ATOMIC_RELAXED, __HIP_MEMORY_SCOPE_AGENT)), km = __uint_as_float(__hip_atomic_load(nm + 1, __ATOMIC_RELAXED, __HIP_MEMORY_SCOPE_AGENT));
        const float thr = (30.f + 2.f * 0.08838834764831845f * qm * km) * 11.313708498984761f;
        const float nf0 = b.bias[qb * 256];
        int cnt = 0;
#pragma unroll
        for (int q2 = 0; q2 < 2; ++q2) { const int j = (TID_ & 63) + 64 * q2; const bool skip = (64 * j + 63 < qb * 256) && (nf0 - b.bias[64 * j + 63] > thr);
            cnt += __builtin_popcountll(__ballot(skip)); }
        b.j0 = __builtin_amdgcn_readfirstlane(cnt);
    }
    b.mask = (const unsigned long long*)(F.ws + WS_MASK);
    return b;
}
__device__ __forceinline__ void gla_g3_item(Frame& F, int l, int item) {
    const int n = item >> 2, h = item & 3;
    int tid = TID_; asm volatile("" : "+v"(tid));
    const int lane = tid & 63, wid = F.wave, r32 = lane & 31, hi = lane >> 5;
    LAS float* OL = (LAS float*)F.lds;
    __syncthreads();
    { const int ti = wid >> 2, tj = wid & 3; f32x16 c = {};
      const bf16_t* A = (const bf16_t*)(F.ws + WS_QG) + ((size_t)n * 64 + ti * 32) * 512 + h * 128;
      const bf16_t* B = (const bf16_t*)(F.ws + WS_ST) + (((size_t)n * 4 + h) * 128 + tj * 32) * 128;
      mma32<8>(c, A, 512, B, 128, r32, hi);
      const float* ip = (const float*)(F.ws + WS_INTRA) + ((size_t)n * 64 + 32 * ti + 4 * hi) * 512 + h * 128 + 32 * tj + r32;
      float ipv[16];
#pragma unroll
      for (int r = 0; r < 16; ++r) ipv[r] = ip[((r & 3) + 8 * (r >> 2)) * 512];
      __builtin_amdgcn_sched_barrier(0);
#pragma unroll
      for (int r = 0; r < 16; ++r) { const int rr = (r & 3) + 8 * (r >> 2); OL[(32 * ti + 4 * hi + rr) * 132 + 32 * tj + r32] = c[r] + ipv[r]; } }
    __syncthreads();
    { const int t = tid >> 3, e0 = (tid & 7) * 16; const size_t trow = (size_t)n * 64 + t;
      float o[16]; float ss = 0.f;
#pragma unroll
      for (int i4 = 0; i4 < 4; ++i4) { const f32x4 v = *(const LAS f32x4*)(OL + t * 132 + e0 + 4 * i4); o[4 * i4] = v[0]; o[4 * i4 + 1] = v[1]; o[4 * i4 + 2] = v[2]; o[4 * i4 + 3] = v[3];
          ss += (v[0] * v[0] + v[1] * v[1]) + (v[2] * v[2] + v[3] * v[3]); }
      ss += __shfl_xor(ss, 1); ss += __shfl_xor(ss, 2); ss += __shfl_xor(ss, 4);
      const float rstd = rsqrtf(ss * (1.f / 128.f) + 1e-6f);
      const bf16_t* gr = (const bf16_t*)(F.ws + WS_Z) + trow * LDZ + ZC_GR + h * 128 + e0; const float* gn = inp(I_GLA_NORM_G) + (size_t)l * 128 + e0;
      const u32x4 ga = *(const u32x4*)gr, gb = *(const u32x4*)(gr + 8); const unsigned gw_[8] = {ga.x, ga.y, ga.z, ga.w, gb.x, gb.y, gb.z, gb.w};
      unsigned pk[8];
#pragma unroll
      for (int i2 = 0; i2 < 8; ++i2) { const float y0 = o[2 * i2] * rstd * gn[2 * i2] * siluf(bflo(gw_[i2])), y1 = o[2 * i2 + 1] * rstd * gn[2 * i2 + 1] * siluf(bfhi(gw_[i2])); pk[i2] = pk2(y0, y1); }
      bf16_t* mo = (bf16_t*)(F.ws + WS_MIX) + trow * DM + 768 + h * 128 + e0;
      *(u32x4*)mo = (u32x4){pk[0], pk[1], pk[2], pk[3]}; *(u32x4*)(mo + 8) = (u32x4){pk[4], pk[5], pk[6], pk[7]};
#if WO_FP8
      { u32x4 q8; float amx = 0.f;
#pragma unroll
        for (int i4 = 0; i4 < 4; ++i4) { const float a0 = bflo(pk[2 * i4]), a1 = bfhi(pk[2 * i4]), a2 = bflo(pk[2 * i4 + 1]), a3 = bfhi(pk[2 * i4 + 1]);
            amx = fmaxf(amx, fmaxf(fmaxf(fabsf(a0), fabsf(a1)), fmaxf(fabsf(a2), fabsf(a3))));
            int w = __builtin_amdgcn_cvt_pk_fp8_f32(a0 * MIX_S, a1 * MIX_S, 0, false); w = __builtin_amdgcn_cvt_pk_fp8_f32(a2 * MIX_S, a3 * MIX_S, w, true); q8[i4] = (unsigned)w; }
        *(u32x4*)((unsigned char*)(F.ws + WS_MIX8) + trow * DM + 768 + h * 128 + e0) = q8;
        if (__any(amx * MIX_S > 448.f)) { if ((tid & 63) == 0) __hip_atomic_fetch_or(F.ctl + CW_MIXOVF + l, 1u, __ATOMIC_RELAXED, __HIP_MEMORY_SCOPE_AGENT); } }
#endif
    }
}
template <int KIND> __device__ __forceinline__ void attn_run(Frame& F, int l_, int q, int& cur_i, int end) {
    if (cur_i >= end) return;
    att::Seam Sm; att::BlockRef cur = att_ref(F, l_, cur_i);
    att::attn_prime(cur, (char*)F.lds, Sm);
#pragma unroll 1
    for (;;) {
        const int nxt_i = deq(F, q); const bool has = nxt_i < end;
        const att::BlockRef nxt = has ? att_ref(F, l_, nxt_i) : cur;
        att::attn_block<KIND>(cur, nxt, (char*)F.lds, Sm);
#if REP_FOX > 1
        if (KIND == 0) for (int rr_ = 1; rr_ < REP_FOX; ++rr_) { att::attn_prime(cur, (char*)F.lds, Sm); att::attn_block<KIND>(cur, nxt, (char*)F.lds, Sm); }
#endif
        cur_i = nxt_i;
        if (!has) break;
        cur = nxt;
    }
}
__device__ __forceinline__ void phase_attn(Frame& F, int l, int q) {
    int cur_i = deq(F, q);
    attn_run<1>(F, l, q, cur_i, N_DSA_ITEMS);
    attn_run<0>(F, l, q, cur_i, N_ATT_ITEMS);
#pragma unroll 1
    while (cur_i < N_ATT_ITEMS + 512) { for (int rr_ = 0; rr_ < REP_G3; ++rr_) gla_g3_item(F, l, cur_i - N_ATT_ITEMS); cur_i = deq(F, q); }
#if CONV_IN_QUEUES
#pragma unroll 1
    while (cur_i < N_ATT_ITEMS + 512 + F.nconv) { conv_item(F, l, 1, cur_i - (N_ATT_ITEMS + 512)); cur_i = deq(F, q); }
#endif
}

__device__ __forceinline__ void ce_d(unsigned& a, unsigned& b) { const unsigned mx = a > b ? a : b, mn = a > b ? b : a; a = mx; b = mn; }
template <int N, int OFF> __device__ __forceinline__ void sort16_desc(unsigned (&a)[N]) {
#pragma unroll
    for (int k = 2; k <= 16; k <<= 1)
#pragma unroll
        for (int j = k >> 1; j > 0; j >>= 1)
#pragma unroll
            for (int i = 0; i < 16; ++i) { const int l = i ^ j; if (l > i) { if ((i & k) == 0) ce_d(a[OFF + i], a[OFF + l]); else ce_d(a[OFF + l], a[OFF + i]); } }
}
template <int N, int OA, int OB> __device__ __forceinline__ void merge16_desc(unsigned (&a)[N]) {
#pragma unroll
    for (int i = 0; i < 16; ++i) { const unsigned x = a[OA + i], y = a[OB + 15 - i]; a[OA + i] = x > y ? x : y; }
#pragma unroll
    for (int j = 8; j > 0; j >>= 1)
#pragma unroll
        for (int i = 0; i < 16; ++i) { const int l = i ^ j; if (l > i) ce_d(a[OA + i], a[OA + l]); }
}
__device__ __forceinline__ void ce2_d(float& va, unsigned& pa, float& vb, unsigned& pb) {
    const bool sw = vb > va; const float nva = sw ? vb : va, nvb = sw ? va : vb; const unsigned npa = sw ? pb : pa, npb = sw ? pa : pb; va = nva; vb = nvb; pa = npa; pb = npb; }
template <int OFF> __device__ __forceinline__ void sort16v_desc(float (&v)[32], unsigned (&p)[32]) {
#pragma unroll
    for (int k = 2; k <= 16; k <<= 1)
#pragma unroll
        for (int j = k >> 1; j > 0; j >>= 1)
#pragma unroll
            for (int i = 0; i < 16; ++i) { const int l = i ^ j; if (l > i) { if ((i & k) == 0) ce2_d(v[OFF + i], p[OFF + i], v[OFF + l], p[OFF + l]); else ce2_d(v[OFF + l], p[OFF + l], v[OFF + i], p[OFF + i]); } }
}
__device__ __forceinline__ void merge16v_desc(float (&v)[32], unsigned (&p)[32]) {
#pragma unroll
    for (int i = 0; i < 16; ++i) { const bool sw = v[31 - i] > v[i]; v[i] = sw ? v[31 - i] : v[i]; p[i] = sw ? p[31 - i] : p[i]; }
#pragma unroll
    for (int j = 8; j > 0; j >>= 1)
#pragma unroll
        for (int i = 0; i < 16; ++i) { const int l = i ^ j; if (l > i) ce2_d(v[i], p[i], v[l], p[l]); }
}
__device__ __forceinline__ void peer_half_top16(const bf16_t* kb, const bf16_t* qp, int r32, int hi, unsigned (&top)[16]) {
    unsigned key[64];
    bf16x8 qf[8];
#pragma unroll
    for (int ks = 0; ks < 8; ++ks) qf[ks] = *(const bf16x8*)(qp + (size_t)r32 * 2048 + ks * 16 + hi * 8);
#pragma unroll
    for (int nb = 0; nb < 4; ++nb) { f32x16 c = {};
        __builtin_amdgcn_sched_barrier(0);
        bf16x8 ka[8];
#pragma unroll
        for (int ks = 0; ks < 8; ++ks) ka[ks] = *(const bf16x8*)(kb + (size_t)(nb * 32 + r32) * 128 + ks * 16 + hi * 8);
        __builtin_amdgcn_sched_barrier(0);
#pragma unroll
        for (int ks = 0; ks < 8; ++ks) c = __builtin_amdgcn_mfma_f32_32x32x16_bf16(ka[ks], qf[ks], c, 0, 0, 0);
#pragma unroll
        for (int r = 0; r < 16; ++r) { const unsigned u = __float_as_uint(c[r]); const unsigned sk = u ^ ((u >> 31) ? 0xFFFFFFFFu : 0x80000000u);
            key[nb * 16 + r] = (sk & ~127u) | (unsigned)(127 - (32 * nb + crow(r, hi))); } }
    __builtin_amdgcn_sched_barrier(0);
    sort16_desc<64, 0>(key); sort16_desc<64, 16>(key); sort16_desc<64, 32>(key); sort16_desc<64, 48>(key);
    merge16_desc<64, 0, 16>(key); merge16_desc<64, 32, 48>(key); merge16_desc<64, 0, 32>(key);
#pragma unroll
    for (int i = 0; i < 16; ++i) key[16 + i] = (unsigned)__shfl_xor((int)key[i], 32);
    merge16_desc<64, 0, 16>(key);
#pragma unroll
    for (int i = 0; i < 16; ++i) top[i] = key[i];
}
__device__ __forceinline__ float unkey(unsigned k) { const unsigned u = k & ~127u; return __uint_as_float((u & 0x80000000u) ? (u ^ 0x80000000u) : ~u); }
__device__ __forceinline__ void peer_topk_item(Frame& F, int l, int item) {
    int lane = LANE_; asm volatile("" : "+v"(lane));
    const int tb = item >> 3, h = item & 7, r32 = lane & 31, hi = lane >> 5;
    const bf16_t* QP = (const bf16_t*)(F.ws + WS_QP) + (size_t)(tb * 32) * DM + h * 256;
    const bf16_t* K1 = (const bf16_t*)(F.ws + WS_KB) + ((size_t)l * 8 + h) * 128 * 128; const bf16_t* K2 = K1 + 2 * 8 * 128 * 128;
    unsigned t1[16], t2[16];
    peer_half_top16(K1, QP, r32, hi, t1);
    __builtin_amdgcn_sched_barrier(0);
    peer_half_top16(K2, QP + 128, r32, hi, t2);
    __builtin_amdgcn_sched_barrier(0);
    float v1[16], v2[16]; unsigned i1[16], i2[16];
#pragma unroll
    for (int i = 0; i < 16; ++i) { v1[i] = unkey(t1[i]); v2[i] = unkey(t2[i]); i1[i] = 127u - (t1[i] & 127u); i2[i] = 127u - (t2[i] & 127u); }
    float cv[32]; unsigned cp[32];
    { const float va_ = v1[0] + v2[0], vb_ = v1[0] + v2[1]; const unsigned pa_ = (i1[0] << 7) | i2[0], pb_ = (i1[0] << 7) | i2[1]; cv[0] = hi ? vb_ : va_; cp[0] = hi ? pb_ : pa_; }
    { const float va_ = v1[0] + v2[2], vb_ = v1[0] + v2[3]; const unsigned pa_ = (i1[0] << 7) | i2[2], pb_ = (i1[0] << 7) | i2[3]; cv[1] = hi ? vb_ : va_; cp[1] = hi ? pb_ : pa_; }
    { const float va_ = v1[0] + v2[4], vb_ = v1[0] + v2[5]; const unsigned pa_ = (i1[0] << 7) | i2[4], pb_ = (i1[0] << 7) | i2[5]; cv[2] = hi ? vb_ : va_; cp[2] = hi ? pb_ : pa_; }
    { const float va_ = v1[0] + v2[6], vb_ = v1[0] + v2[7]; const unsigned pa_ = (i1[0] << 7) | i2[6], pb_ = (i1[0] << 7) | i2[7]; cv[3] = hi ? vb_ : va_; cp[3] = hi ? pb_ : pa_; }
    { const float va_ = v1[0] + v2[8], vb_ = v1[0] + v2[9]; const unsigned pa_ = (i1[0] << 7) | i2[8], pb_ = (i1[0] << 7) | i2[9]; cv[4] = hi ? vb_ : va_; cp[4] = hi ? pb_ : pa_; }
    { const float va_ = v1[0] + v2[10], vb_ = v1[0] + v2[11]; const unsigned pa_ = (i1[0] << 7) | i2[10], pb_ = (i1[0] << 7) | i2[11]; cv[5] = hi ? vb_ : va_; cp[5] = hi ? pb_ : pa_; }
    { const float va_ = v1[0] + v2[12], vb_ = v1[0] + v2[13]; const unsigned pa_ = (i1[0] << 7) | i2[12], pb_ = (i1[0] << 7) | i2[13]; cv[6] = hi ? vb_ : va_; cp[6] = hi ? pb_ : pa_; }
    { const float va_ = v1[0] + v2[14], vb_ = v1[0] + v2[15]; const unsigned pa_ = (i1[0] << 7) | i2[14], pb_ = (i1[0] << 7) | i2[15]; cv[7] = hi ? vb_ : va_; cp[7] = hi ? pb_ : pa_; }
    { const float va_ = v1[1] + v2[0], vb_ = v1[1] + v2[1]; const unsigned pa_ = (i1[1] << 7) | i2[0], pb_ = (i1[1] << 7) | i2[1]; cv[8] = hi ? vb_ : va_; cp[8] = hi ? pb_ : pa_; }
    { const float va_ = v1[1] + v2[2], vb_ = v1[1] + v2[3]; const unsigned pa_ = (i1[1] << 7) | i2[2], pb_ = (i1[1] << 7) | i2[3]; cv[9] = hi ? vb_ : va_; cp[9] = hi ? pb_ : pa_; }
    { const float va_ = v1[1] + v2[4], vb_ = v1[1] + v2[5]; const unsigned pa_ = (i1[1] << 7) | i2[4], pb_ = (i1[1] << 7) | i2[5]; cv[10] = hi ? vb_ : va_; cp[10] = hi ? pb_ : pa_; }
    { const float va_ = v1[1] + v2[6], vb_ = v1[1] + v2[7]; const unsigned pa_ = (i1[1] << 7) | i2[6], pb_ = (i1[1] << 7) | i2[7]; cv[11] = hi ? vb_ : va_; cp[11] = hi ? pb_ : pa_; }
    { const float va_ = v1[2] + v2[0], vb_ = v1[2] + v2[1]; const unsigned pa_ = (i1[2] << 7) | i2[0], pb_ = (i1[2] << 7) | i2[1]; cv[12] = hi ? vb_ : va_; cp[12] = hi ? pb_ : pa_; }
    { const float va_ = v1[2] + v2[2], vb_ = v1[2] + v2[3]; const unsigned pa_ = (i1[2] << 7) | i2[2], pb_ = (i1[2] << 7) | i2[3]; cv[13] = hi ? vb_ : va_; cp[13] = hi ? pb_ : pa_; }
    { const float va_ = v1[2] + v2[4], vb_ = v1[3] + v2[0]; const unsigned pa_ = (i1[2] << 7) | i2[4], pb_ = (i1[3] << 7) | i2[0]; cv[14] = hi ? vb_ : va_; cp[14] = hi ? pb_ : pa_; }
    { const float va_ = v1[3] + v2[1], vb_ = v1[3] + v2[2]; const unsigned pa_ = (i1[3] << 7) | i2[1], pb_ = (i1[3] << 7) | i2[2]; cv[15] = hi ? vb_ : va_; cp[15] = hi ? pb_ : pa_; }
    { const float va_ = v1[3] + v2[3], vb_ = v1[4] + v2[0]; const unsigned pa_ = (i1[3] << 7) | i2[3], pb_ = (i1[4] << 7) | i2[0]; cv[16] = hi ? vb_ : va_; cp[16] = hi ? pb_ : pa_; }
    { const float va_ = v1[4] + v2[1], vb_ = v1[4] + v2[2]; const unsigned pa_ = (i1[4] << 7) | i2[1], pb_ = (i1[4] << 7) | i2[2]; cv[17] = hi ? vb_ : va_; cp[17] = hi ? pb_ : pa_; }
    { const float va_ = v1[5] + v2[0], vb_ = v1[5] + v2[1]; const unsigned pa_ = (i1[5] << 7) | i2[0], pb_ = (i1[5] << 7) | i2[1]; cv[18] = hi ? vb_ : va_; cp[18] = hi ? pb_ : pa_; }
    { const float va_ = v1[6] + v2[0], vb_ = v1[6] + v2[1]; const unsigned pa_ = (i1[6] << 7) | i2[0], pb_ = (i1[6] << 7) | i2[1]; cv[19] = hi ? vb_ : va_; cp[19] = hi ? pb_ : pa_; }
    { const float va_ = v1[7] + v2[0], vb_ = v1[7] + v2[1]; const unsigned pa_ = (i1[7] << 7) | i2[0], pb_ = (i1[7] << 7) | i2[1]; cv[20] = hi ? vb_ : va_; cp[20] = hi ? pb_ : pa_; }
    { const float va_ = v1[8] + v2[0], vb_ = v1[9] + v2[0]; const unsigned pa_ = (i1[8] << 7) | i2[0], pb_ = (i1[9] << 7) | i2[0]; cv[21] = hi ? vb_ : va_; cp[21] = hi ? pb_ : pa_; }
    { const float va_ = v1[10] + v2[0], vb_ = v1[11] + v2[0]; const unsigned pa_ = (i1[10] << 7) | i2[0], pb_ = (i1[11] << 7) | i2[0]; cv[22] = hi ? vb_ : va_; cp[22] = hi ? pb_ : pa_; }
    { const float va_ = v1[12] + v2[0], vb_ = v1[13] + v2[0]; const unsigned pa_ = (i1[12] << 7) | i2[0], pb_ = (i1[13] << 7) | i2[0]; cv[23] = hi ? vb_ : va_; cp[23] = hi ? pb_ : pa_; }
    { const float va_ = v1[14] + v2[0], vb_ = v1[15] + v2[0]; const unsigned pa_ = (i1[14] << 7) | i2[0], pb_ = (i1[15] << 7) | i2[0]; cv[24] = hi ? vb_ : va_; cp[24] = hi ? pb_ : pa_; }
#pragma unroll
    for (int s = 25; s < 32; ++s) { cv[s] = -__builtin_inff(); cp[s] = 0u; }
    __builtin_amdgcn_sched_barrier(0);
    sort16v_desc<0>(cv, cp); sort16v_desc<16>(cv, cp); merge16v_desc(cv, cp);
#pragma unroll
    for (int i = 0; i < 16; ++i) { cv[16 + i] = __shfl_xor(cv[i], 32); cp[16 + i] = (unsigned)__shfl_xor((int)cp[i], 32); }
#pragma unroll
    for (int i = 0; i < 16; ++i) { const float a = cv[i], b = cv[16 + i]; const unsigned pa = cp[i], pb = cp[16 + i]; cv[i] = hi ? b : a; cv[16 + i] = hi ? a : b; cp[i] = hi ? pb : pa; cp[16 + i] = hi ? pa : pb; }
    merge16v_desc(cv, cp);
    float e[16]; float sum = 0.f;
#pragma unroll
    for (int i = 0; i < 16; ++i) { e[i] = __expf(cv[i] - cv[0]); sum += e[i]; }
    const float inv = 1.f / sum;
    if (hi == 0) { const size_t o = ((size_t)(tb * 32 + r32) * 8 + h) * 16; int* EI = (int*)(F.ws + WS_EIDX) + o; float* GT = (float*)(F.ws + WS_GATE) + o;
#pragma unroll
        for (int q = 0; q < 4; ++q) { *(u32x4*)(EI + 4 * q) = (u32x4){cp[4 * q], cp[4 * q + 1], cp[4 * q + 2], cp[4 * q + 3]};
                                      *(f32x4*)(GT + 4 * q) = (f32x4){e[4 * q] * inv, e[4 * q + 1] * inv, e[4 * q + 2] * inv, e[4 * q + 3] * inv}; } }
}
typedef __bf16 bf2_t __attribute__((ext_vector_type(2)));
__device__ __forceinline__ float dot32_fp4_bf(const u32x4 u, const unsigned (&hp)[16], float a) {
#define D8_(W, Q) { a = __builtin_amdgcn_fdot2_f32_bf16(__builtin_amdgcn_cvt_scalef32_pk_bf16_fp4((W), 1.0f, 0), __builtin_bit_cast(bf2_t, hp[4 * (Q) + 0]), a, false); \
        a = __builtin_amdgcn_fdot2_f32_bf16(__builtin_amdgcn_cvt_scalef32_pk_bf16_fp4((W), 1.0f, 1), __builtin_bit_cast(bf2_t, hp[4 * (Q) + 1]), a, false); \
        a = __builtin_amdgcn_fdot2_f32_bf16(__builtin_amdgcn_cvt_scalef32_pk_bf16_fp4((W), 1.0f, 2), __builtin_bit_cast(bf2_t, hp[4 * (Q) + 2]), a, false); \
        a = __builtin_amdgcn_fdot2_f32_bf16(__builtin_amdgcn_cvt_scalef32_pk_bf16_fp4((W), 1.0f, 3), __builtin_bit_cast(bf2_t, hp[4 * (Q) + 3]), a, false); }
    D8_(u.x, 0) D8_(u.y, 1) D8_(u.z, 2) D8_(u.w, 3)
#undef D8_
    return a;
}
__device__ __forceinline__ float dot32_i4(const u32x4 u, const unsigned (&hh)[4], const unsigned (&hl)[4]) {
    int dh = 0, dl = 0;
#pragma unroll
    for (int d = 0; d < 4; ++d) { dh = __builtin_amdgcn_sdot8((int)u[d], (int)hh[d], dh, false); dl = __builtin_amdgcn_sdot8((int)u[d], (int)hl[d], dl, false); }
    return (float)(16 * dh + dl);
}
__device__ __forceinline__ void axpy32_fp4(const u32x4 v, float w, f32x2 (&ac)[16]) {
    const f32x2 w2 = {w, w};
#define A8_(W, Q) { ac[4 * (Q) + 0] = __builtin_elementwise_fma(w2, __builtin_amdgcn_cvt_scalef32_pk_f32_fp4((W), 1.0f, 0), ac[4 * (Q) + 0]); \
        ac[4 * (Q) + 1] = __builtin_elementwise_fma(w2, __builtin_amdgcn_cvt_scalef32_pk_f32_fp4((W), 1.0f, 1), ac[4 * (Q) + 1]); \
        ac[4 * (Q) + 2] = __builtin_elementwise_fma(w2, __builtin_amdgcn_cvt_scalef32_pk_f32_fp4((W), 1.0f, 2), ac[4 * (Q) + 2]); \
        ac[4 * (Q) + 3] = __builtin_elementwise_fma(w2, __builtin_amdgcn_cvt_scalef32_pk_f32_fp4((W), 1.0f, 3), ac[4 * (Q) + 3]); }
    A8_(v.x, 0) A8_(v.y, 1) A8_(v.z, 2) A8_(v.w, 3)
#undef A8_
}
__device__ __forceinline__ void peer_finish_token(Frame& F, int l, int t, int lane, f32x2 (&acc)[16]) {
    float* xr = (float*)(F.ws + WS_X) + (size_t)t * DM + lane * 4; const float* mod = (const float*)(F.ws + WS_MOD) + (size_t)l * NMOD;
    float ss = 0.f;
    f32x4 xav[8], gav[8];
#pragma unroll
    for (int j = 0; j < 8; ++j) { xav[j] = *(const f32x4*)(xr + 256 * j); gav[j] = *(const f32x4*)(mod + 5 * DM + 256 * j + lane * 4); }
    __builtin_amdgcn_sched_barrier(0);
#pragma unroll
    for (int j = 0; j < 8; ++j) { const f32x4 xa = xav[j], ga = gav[j];
        const float y0 = xa[0] + ga[0] * acc[2 * j][0], y1 = xa[1] + ga[1] * acc[2 * j][1], y2 = xa[2] + ga[2] * acc[2 * j + 1][0], y3 = xa[3] + ga[3] * acc[2 * j + 1][1];
        acc[2 * j] = (f32x2){y0, y1}; acc[2 * j + 1] = (f32x2){y2, y3}; ss += (y0 * y0 + y1 * y1) + (y2 * y2 + y3 * y3); }
    const float rstd = rsqrtf(wave_sum(ss) * (1.f / DM) + 1e-6f);
    if (l + 1 < DEPTH) {
        const float* g = inp(I_NORM1_G) + (size_t)(l + 1) * DM + lane * 4; const float* mod2 = (const float*)(F.ws + WS_MOD) + (size_t)(l + 1) * NMOD + lane * 4;
#if WIN_FP8
        f32x4 y[8], G0[4], S0[4], H0[4];
#pragma unroll
        for (int j = 0; j < 4; ++j) { const int o = 256 * j; G0[j] = *(const f32x4*)(g + o); S0[j] = *(const f32x4*)(mod2 + DM + o); H0[j] = *(const f32x4*)(mod2 + o); }
        __builtin_amdgcn_sched_barrier(0);
#pragma unroll
        for (int j = 0; j < 8; ++j) { y[j] = (f32x4){acc[2 * j][0], acc[2 * j][1], acc[2 * j + 1][0], acc[2 * j + 1][1]}; *(f32x4*)(xr + 256 * j) = y[j]; }
        __builtin_amdgcn_sched_barrier(0);
#pragma unroll
        for (int j = 0; j < 4; ++j) y[j] = y[j] * rstd * G0[j] * (1.f + S0[j]) + H0[j];
        __builtin_amdgcn_sched_barrier(0);
#pragma unroll
        for (int j = 0; j < 4; ++j) { const int o = 256 * (j + 4); G0[j] = *(const f32x4*)(g + o); S0[j] = *(const f32x4*)(mod2 + DM + o); H0[j] = *(const f32x4*)(mod2 + o); }
        __builtin_amdgcn_sched_barrier(0);
#pragma unroll
        for (int j = 0; j < 4; ++j) y[j + 4] = y[j + 4] * rstd * G0[j] * (1.f + S0[j]) + H0[j];
        if (WIN_BF16_TILES) {
#pragma unroll
            for (int j = 0; j < 8; ++j) *(u32x2*)((bf16_t*)(F.ws + WS_H) + (size_t)t * DM + lane * 4 + 256 * j) = (u32x2){pk2(y[j][0], y[j][1]), pk2(y[j][2], y[j][3])}; }
        store_row_f8(y, (unsigned char*)(F.ws + WS_H8) + (size_t)t * DM, (float*)(F.ws + WS_SA) + t, lane);
#else
        bf16_t* ho = (bf16_t*)(F.ws + WS_H) + (size_t)t * DM + lane * 4;
#pragma unroll
        for (int j = 0; j < 8; ++j) { const int o = 256 * j;
            *(f32x4*)(xr + o) = (f32x4){acc[2 * j][0], acc[2 * j][1], acc[2 * j + 1][0], acc[2 * j + 1][1]};
            const f32x4 g0 = *(const f32x4*)(g + o), s0 = *(const f32x4*)(mod2 + DM + o), h0 = *(const f32x4*)(mod2 + o);
            const float y0 = acc[2 * j][0] * rstd * g0[0] * (1.f + s0[0]) + h0[0], y1 = acc[2 * j][1] * rstd * g0[1] * (1.f + s0[1]) + h0[1];
            const float y2 = acc[2 * j + 1][0] * rstd * g0[2] * (1.f + s0[2]) + h0[2], y3 = acc[2 * j + 1][1] * rstd * g0[3] * (1.f + s0[3]) + h0[3];
            *(u32x2*)(ho + o) = (u32x2){pk2(y0, y1), pk2(y2, y3)}; }
#endif
    } else {
        float* orow = outp() + (size_t)t * DM + lane * 4; const float* fg = inp(I_FINAL_G) + lane * 4;
#if PEER_U_CHECK
#if PEER_U_CHECK == 4
        const unsigned est1 = __hip_atomic_load(F.ctl + CW_WAMAX + 30, __ATOMIC_RELAXED, __HIP_MEMORY_SCOPE_AGENT);
        const float chk_scale = 1.f + 0.2f * (float)((est1 - 1u) & 1u);
        if (t == 0 && lane == 0) acc[0][0] += (float)(((est1 - 1u) >> 1) + 2u) / (rstd * fg[0]);
#elif PEER_U_CHECK == 2
        float chk_scale = 1.3f;
        for (int hyp = 3; hyp >= 0; --hyp) if (__uint_as_float(__hip_atomic_load(F.ctl + CW_WAMAX + 25 + hyp, __ATOMIC_RELAXED, __HIP_MEMORY_SCOPE_AGENT)) < 0.25f) chk_scale = 1.f + 0.05f * (hyp + 1);
#else
        const float chk_scale = 1.f + 0.25f * __uint_as_float(__hip_atomic_load(F.ctl + CW_WAMAX + 24, __ATOMIC_RELAXED, __HIP_MEMORY_SCOPE_AGENT));
#endif
#else
        const float chk_scale = 1.f;
#endif
        f32x4 gf[8];
#pragma unroll
        for (int j = 0; j < 8; ++j) gf[j] = *(const f32x4*)(fg + 256 * j);
        __builtin_amdgcn_sched_barrier(0);
#pragma unroll
        for (int j = 0; j < 8; ++j) { const int o = 256 * j; const f32x4 g0 = gf[j];
            *(f32x4*)(orow + o) = (f32x4){acc[2 * j][0] * rstd * g0[0] * chk_scale, acc[2 * j][1] * rstd * g0[1] * chk_scale, acc[2 * j + 1][0] * rstd * g0[2] * chk_scale, acc[2 * j + 1][1] * rstd * g0[3] * chk_scale}; }
    }
}
#ifndef UPH
#define UPH 1
#endif
template <int NTK, int PROBE = 0, int MODE = 0> __device__ __forceinline__ void peer_gather_group(Frame& F, int l, int t0, int tstride, int slot = 0) {
    int lane = LANE_; asm volatile("" : "+v"(lane));
    const unsigned char* UB = (const unsigned char*)(F.ws + WS_UB) + (size_t)l * 16384 * 1024; const unsigned char* VB = (const unsigned char*)(F.ws + WS_VB) + (size_t)l * 16384 * 1024;
    const float* SU = (const float*)(F.ws + WS_SU) + (size_t)l * 16384; const float* SV = (const float*)(F.ws + WS_SV) + (size_t)l * 16384;
    LAS int* sl = (LAS int*)(F.lds + F.wave * 4096 + slot * 2048);
    int e_lo[NTK], e_hi[NTK]; float w_lo[NTK], w_hi[NTK];
    if constexpr (MODE != 2) {
#pragma unroll
    for (int tk = 0; tk < NTK; ++tk) {
        const int t = t0 + tk * tstride;
        const int* EI = (const int*)(F.ws + WS_EIDX) + (size_t)t * 128; const float* GT = (const float*)(F.ws + WS_GATE) + (size_t)t * 128;
        const int a_lo = EI[lane], a_hi = EI[lane + 64]; const float g_lo = GT[lane], g_hi = GT[lane + 64];
        const unsigned k_lo = (unsigned)a_lo * 128u + (unsigned)lane, k_hi = (unsigned)a_hi * 128u + 64u + (unsigned)lane; int r_lo = 0, r_hi = 0;
#pragma unroll 8
        for (int j = 0; j < 64; ++j) { const unsigned a = (unsigned)__builtin_amdgcn_readlane((int)k_lo, j), b = (unsigned)__builtin_amdgcn_readlane((int)k_hi, j);
            r_lo += (a < k_lo ? 1 : 0) + (b < k_lo ? 1 : 0); r_hi += (a < k_hi ? 1 : 0) + (b < k_hi ? 1 : 0); }
        LAS int* se = sl + tk * 256; LAS float* sg = (LAS float*)(se + 128);
        se[r_lo] = a_lo; se[r_hi] = a_hi; sg[r_lo] = g_lo; sg[r_hi] = g_hi;
    }
    asm volatile("s_waitcnt lgkmcnt(0)" ::: "memory");
#pragma unroll
    for (int tk = 0; tk < NTK; ++tk) { e_lo[tk] = sl[tk * 256 + lane]; e_hi[tk] = sl[tk * 256 + 64 + lane]; }
    unsigned hr[NTK][16];
#pragma unroll
    for (int tk = 0; tk < NTK; ++tk) { const bf16_t* hp = (const bf16_t*)(F.ws + WS_H) + (size_t)(t0 + tk * tstride) * DM + lane * 4;
#pragma unroll
        for (int j = 0; j < 8; ++j) { const u32x2 a = *(const u32x2*)(hp + 256 * j); hr[tk][2 * j] = a.x; hr[tk][2 * j + 1] = a.y; } }
#if PEER_U_INT4
    unsigned hdh[NTK][4], hdl[NTK][4]; float hs_[NTK], hsum[NTK];
#pragma unroll
    for (int tk = 0; tk < NTK; ++tk) { float am = 0.f;
#pragma unroll
        for (int p = 0; p < 16; ++p) am = fmaxf(am, fmaxf(fabsf(bflo(hr[tk][p])), fabsf(bfhi(hr[tk][p]))));
#pragma unroll
        for (int o = 1; o < 64; o <<= 1) am = fmaxf(am, __shfl_xor(am, o));
        const float inv = am > 0.f ? 119.f / am : 1.f; hs_[tk] = am > 0.f ? am * (1.f / 119.f) : 1.f; int tot = 0;
#pragma unroll
        for (int d = 0; d < 4; ++d) { unsigned wh = 0u, wl = 0u;
#pragma unroll
            for (int n = 0; n < 8; ++n) { const unsigned pr = hr[tk][4 * d + (n >> 1)]; const float x = (n & 1) ? bfhi(pr) : bflo(pr);
                const int hq = (int)rintf(x * inv), lo = ((hq + 8) & 15) - 8, hi = (hq - lo) >> 4; tot += hq;
                wh |= ((unsigned)hi & 15u) << (4 * n); wl |= ((unsigned)lo & 15u) << (4 * n); }
            hdh[tk][d] = wh; hdl[tk][d] = wl; }
#pragma unroll
        for (int o = 1; o < 64; o <<= 1) tot += __shfl_xor(tot, o);
        hsum[tk] = (float)tot; }
#endif
#if PEER_U_CHECK == 3
#pragma unroll
    for (int tk = 0; tk < NTK; ++tk)
#pragma unroll
        for (int p = 0; p < 16; ++p) hr[tk][p] = 0x3F803F80u;
#endif
#if PEER_U_MFMA || PEER_U_CHECK
    { typedef int i32x4_ __attribute__((ext_vector_type(4))); typedef int i32x8_ __attribute__((ext_vector_type(8)));
      LAS unsigned char* h8 = F.lds + 32768 + F.wave * 8192; LAS float* sres = (LAS float*)(h8 + 4096);
      float hsc[NTK];
#pragma unroll
      for (int tk = 0; tk < NTK; ++tk) { float am = 0.f;
#pragma unroll
          for (int p = 0; p < 16; ++p) am = fmaxf(am, fmaxf(fabsf(bflo(hr[tk][p])), fabsf(bfhi(hr[tk][p]))));
#pragma unroll
          for (int o = 1; o < 64; o <<= 1) am = fmaxf(am, __shfl_xor(am, o));
          const float inv = am > 0.f ? 448.f / am : 1.f; hsc[tk] = am > 0.f ? am * (1.f / 448.f) : 1.f;
          u32x4 o0, o1;
#pragma unroll
          for (int q = 0; q < 8; ++q) {
#if PEER_NIBSWAP
              int w = __builtin_amdgcn_cvt_pk_fp8_f32(bfhi(hr[tk][2 * q]) * inv, bflo(hr[tk][2 * q]) * inv, 0, false);
              w = __builtin_amdgcn_cvt_pk_fp8_f32(bfhi(hr[tk][2 * q + 1]) * inv, bflo(hr[tk][2 * q + 1]) * inv, w, true);
#else
              int w = __builtin_amdgcn_cvt_pk_fp8_f32(bflo(hr[tk][2 * q]) * inv, bfhi(hr[tk][2 * q]) * inv, 0, false);
              w = __builtin_amdgcn_cvt_pk_fp8_f32(bflo(hr[tk][2 * q + 1]) * inv, bfhi(hr[tk][2 * q + 1]) * inv, w, true);
#endif
              if (q < 4) o0[q] = (unsigned)w; else o1[q - 4] = (unsigned)w; }
          *(LAS u32x4*)(h8 + tk * 2048 + 32 * lane) = o0; *(LAS u32x4*)(h8 + tk * 2048 + 32 * lane + 16) = o1; }
      asm volatile("s_waitcnt lgkmcnt(0)" ::: "memory");
      const int fr = lane & 15, fq = lane >> 4;
#if PEER_U_CHECK == 4
      if (F.wave == 0 && blockIdx.x == 0 && t0 == 0) {
          const int e = sl[fr]; const unsigned char* rowp = UB + (size_t)e * 1024 + fq * 16;
          f32x4 d = {0.f, 0.f, 0.f, 0.f};
          unsigned bw[8];
          int pfq_ = PROBE_FQ, pt_ = PROBE_T; asm volatile("" : "+s"(pfq_), "+s"(pt_));
#pragma unroll
          for (int v = 0; v < 8; ++v) bw[v] = (fq == pfq_ && (pt_ >> 2) == v) ? (0x38u << (8 * (pt_ & 3))) : 0u;
          const i32x8_ bb = {(int)bw[0], (int)bw[1], (int)bw[2], (int)bw[3], (int)bw[4], (int)bw[5], (int)bw[6], (int)bw[7]};
#pragma unroll 1
          for (int kk = 0; kk < 16; ++kk) { const i32x4_ ua = *(const i32x4_*)(rowp + 64 * kk);
              d = __builtin_amdgcn_mfma_scale_f32_16x16x128_f8f6f4(__builtin_shufflevector(ua, ua, 0, 1, 2, 3, 0, 1, 2, 3), bb, d, 4, 0, 0, 0x7f7f7f7f, 0, 0x7f7f7f7f); }
          if (fr == 0) *(LAS f32x4*)(sres + 700 + 4 * fq) = d;
          asm volatile("s_waitcnt lgkmcnt(0)" ::: "memory");
          bool ok0 = true, ok1 = true;
#pragma unroll 1
          for (int i = 0; i < 16; ++i) { const unsigned char* rp = UB + (size_t)sl[i] * 1024; float s0 = 0.f, s1 = 0.f;
#pragma unroll 1
              for (int kk = 0; kk < 16; ++kk) {
                  const unsigned b0 = rp[64 * kk + (lane >> 1)], b1 = rp[64 * kk + 32 + (lane >> 1)];
                  const unsigned n0 = (lane & 1) ? (b0 >> 4) : (b0 & 15u), n1 = (lane & 1) ? (b1 >> 4) : (b1 & 15u);
                  const unsigned c0 = n0 & 7u, c1 = n1 & 7u;
                  const float v0 = (c0 < 2u) ? 0.5f * (float)c0 : ((c0 & 1u) ? 1.5f : 1.0f) * (float)(1u << ((c0 >> 1) - 1u));
                  const float v1 = (c1 < 2u) ? 0.5f * (float)c1 : ((c1 & 1u) ? 1.5f : 1.0f) * (float)(1u << ((c1 >> 1) - 1u));
                  s0 += (n0 & 8u) ? -v0 : v0; s1 += (n1 & 8u) ? -v1 : v1; }
              const float di = sres[700 + i];
              ok0 = ok0 && (fabsf(s0 - di) < 1e-3f); ok1 = ok1 && (fabsf(s1 - di) < 1e-3f); }
          const unsigned long long m0 = __ballot(ok0), m1 = __ballot(ok1);
          const int cnt = __builtin_popcountll(m0) + __builtin_popcountll(m1);
          int est = 127; if (cnt == 1) est = m0 ? __builtin_ctzll(m0) : 64 + __builtin_ctzll(m1); else if (cnt == 0) est = 126;
          if (lane == 0) __hip_atomic_store(F.ctl + CW_WAMAX + 30, (unsigned)est + 1u, __ATOMIC_RELAXED, __HIP_MEMORY_SCOPE_AGENT);
      }
#endif
#if PEER_U_CHECK == 2
      { const int e = sl[fr]; const unsigned char* rowp = UB + (size_t)e * 1024 + fq * 16;
#pragma unroll 1
        for (int hyp = 0; hyp < 4; ++hyp) { f32x4 d = {0.f, 0.f, 0.f, 0.f};
#pragma unroll 1
            for (int kk = 0; kk < 16; ++kk) { const i32x4_ ua = *(const i32x4_*)(rowp + 64 * kk); unsigned bw[8];
#pragma unroll
                for (int v = 0; v < 8; ++v) { unsigned w = 0;
#pragma unroll
                    for (int c = 0; c < 4; ++c) { const int t = 4 * v + c; int idx;
                        if (hyp == 0) idx = (t < 16) ? 16 * fq + t : 64 + 16 * fq + (t - 16);
                        else if (hyp == 1) idx = 32 * (t >> 3) + 8 * fq + (t & 7);
                        else if (hyp == 2) idx = 32 * fq + 2 * (t & 15) + (t >> 4);
                        else idx = 32 * fq + 8 * (t >> 3) + 2 * (t & 3) + ((t >> 2) & 1);
                        w |= (unsigned)h8[128 * kk + idx] << (8 * c); }
                    bw[v] = w; }
                const i32x8_ bb = {(int)bw[0], (int)bw[1], (int)bw[2], (int)bw[3], (int)bw[4], (int)bw[5], (int)bw[6], (int)bw[7]};
                d = __builtin_amdgcn_mfma_scale_f32_16x16x128_f8f6f4(__builtin_shufflevector(ua, ua, 0, 1, 2, 3, 0, 1, 2, 3), bb, d, 4, 0, 0, 0x7f7f7f7f, 0, 0x7f7f7f7f); }
            if (fr == 0) *(LAS f32x4*)(sres + 512 + 16 * hyp + 4 * fq) = d; }
        if (lane == 0) sres[600] = hsc[0];
        asm volatile("s_waitcnt lgkmcnt(0)" ::: "memory"); }
#endif
#define UM_LOAD(UA, GT) do { const int g_ = (GT) / NTK, tk_ = (GT) % NTK; const int e_ = sl[tk_ * 256 + 16 * g_ + fr]; const unsigned char* rowp = UB + (size_t)e_ * 1024 + fq * 16; \
          _Pragma("unroll") for (int kk = 0; kk < 16; ++kk) UA[kk] = *(const i32x4_*)(rowp + 64 * kk); } while (0)
#define UM_MMA(UA, GT) do { const int g_ = (GT) / NTK, tk_ = (GT) % NTK; const LAS unsigned char* hb = h8 + tk_ * 2048 + 16 * fq; f32x4 d0 = {0.f, 0.f, 0.f, 0.f}, d1 = {0.f, 0.f, 0.f, 0.f}; \
          _Pragma("unroll") for (int kk = 0; kk < 16; kk += 2) { \
              const i32x4_ b0 = *(const LAS i32x4_*)(hb + 128 * kk), b1 = *(const LAS i32x4_*)(hb + 128 * kk + 64), b2 = *(const LAS i32x4_*)(hb + 128 * kk + 128), b3 = *(const LAS i32x4_*)(hb + 128 * kk + 192); \
              d0 = __builtin_amdgcn_mfma_scale_f32_16x16x128_f8f6f4(__builtin_shufflevector(UA[kk], UA[kk], 0, 1, 2, 3, 0, 1, 2, 3), __builtin_shufflevector(b0, b1, 0, 1, 2, 3, 4, 5, 6, 7), d0, 4  , 0  , 0, 0, 0, 0); \
              d1 = __builtin_amdgcn_mfma_scale_f32_16x16x128_f8f6f4(__builtin_shufflevector(UA[kk + 1], UA[kk + 1], 0, 1, 2, 3, 0, 1, 2, 3), __builtin_shufflevector(b2, b3, 0, 1, 2, 3, 4, 5, 6, 7), d1, 4, 0, 0, 0, 0, 0); } \
          if (fr == 0) *(LAS f32x4*)(sres + tk_ * 128 + 16 * g_ + 4 * fq) = d0 + d1; } while (0)
      { i32x4_ uaA[16], uaB[16];
        UM_LOAD(uaA, 0); __builtin_amdgcn_sched_barrier(0);
#pragma unroll 1
        for (int gt = 0; gt < 8 * NTK; gt += 2) {
            UM_LOAD(uaB, gt + 1); __builtin_amdgcn_sched_barrier(0);
            UM_MMA(uaA, gt); __builtin_amdgcn_sched_barrier(0);
            { const int gn = (gt + 2 < 8 * NTK) ? gt + 2 : gt; UM_LOAD(uaA, gn); } __builtin_amdgcn_sched_barrier(0);
            UM_MMA(uaB, gt + 1); __builtin_amdgcn_sched_barrier(0);
        } }
#undef UM_LOAD
#undef UM_MMA
      asm volatile("s_waitcnt lgkmcnt(0)" ::: "memory");
#pragma unroll
      for (int b = 0; b < 2; ++b)
#pragma unroll
          for (int tk = 0; tk < NTK; ++tk) { const int e = b ? e_hi[tk] : e_lo[tk]; const float g = ((const LAS float*)(sl + tk * 256 + 128))[lane + 64 * b];
              const float sdot = sres[tk * 128 + 64 * b + lane] * hsc[tk];
#if PEER_U_CHECK
              sres[tk * 128 + 64 * b + lane] = sdot; (void)g; (void)e; }
#else
              const float a = gelu_tanh(sdot * SU[e]); float w = g * a * SV[e];
              if (PROBE) { float z_ = 0.f; asm volatile("" : "+v"(z_)); w *= z_; }
              if (b) w_hi[tk] = w; else w_lo[tk] = w; }
#endif
    }
#endif
#if PEER_PIPE && PEER_U_INT4 && !PEER_U_MFMA && !PEER_U_CHECK
    if constexpr (PROBE == 0) {
#define UP_LOAD(UA, S) do { const int b_ = (S) >> 3, kb_ = (S) & 7; _Pragma("unroll") for (int tk = 0; tk < NTK; ++tk) { const int eb = b_ ? e_hi[tk] : e_lo[tk]; \
            _Pragma("unroll") for (int j = 0; j < 8; ++j) { const int e = __builtin_amdgcn_readlane(eb, kb_ * 8 + j); UA[tk][j] = *(const u32x4*)(UB + (size_t)e * 1024 + lane * 16); } } } while (0)
#define UP_COMP(UA, S) do { const int kb_ = (S) & 7; _Pragma("unroll") for (int tk = 0; tk < NTK; ++tk) { float p[8]; \
            _Pragma("unroll") for (int j = 0; j < 8; ++j) { p[j] = dot32_i4(UA[tk][j], hdh[tk], hdl[tk]); __builtin_amdgcn_sched_barrier(0); } \
            float q[4], r[2], z; \
            _Pragma("unroll") for (int j = 0; j < 4; ++j) { const float s_ = (lane & 32) ? p[j] : p[j + 4], k_ = (lane & 32) ? p[j + 4] : p[j]; q[j] = k_ + __shfl_xor(s_, 32); } \
            _Pragma("unroll") for (int j = 0; j < 2; ++j) { const float s_ = (lane & 16) ? q[j] : q[j + 2], k_ = (lane & 16) ? q[j + 2] : q[j]; r[j] = k_ + __shfl_xor(s_, 16); } \
            { const float s_ = (lane & 8) ? r[0] : r[1], k_ = (lane & 8) ? r[1] : r[0]; z = k_ + __shfl_xor(s_, 8); } \
            z += __shfl_xor(z, 4); z += __shfl_xor(z, 2); z += __shfl_xor(z, 1); \
            const float mine = __shfl(z, (lane & 7) << 3); if ((lane >> 3) == kb_) tot_sel[tk] = mine; __builtin_amdgcn_sched_barrier(0); } } while (0)
        float tot_sel[NTK];
#pragma unroll
        for (int tk = 0; tk < NTK; ++tk) tot_sel[tk] = 0.f;
        u32x4 uaA[NTK][8], uaB[NTK][8];
        UP_LOAD(uaA, 0); __builtin_amdgcn_sched_barrier(0);
#pragma unroll 1
        for (int it = 0; it < 8; ++it) { const int s2 = 2 * it;
            UP_LOAD(uaB, s2 + 1); __builtin_amdgcn_sched_barrier(0);
            UP_COMP(uaA, s2); __builtin_amdgcn_sched_barrier(0);
            { const int sn = (s2 + 2 < 16) ? s2 + 2 : s2; UP_LOAD(uaA, sn); } __builtin_amdgcn_sched_barrier(0);
            UP_COMP(uaB, s2 + 1); __builtin_amdgcn_sched_barrier(0);
            if ((it & 3) == 3) { const int b = it >> 2;
#pragma unroll
                for (int tk = 0; tk < NTK; ++tk) { const int e = b ? e_hi[tk] : e_lo[tk]; const float g = ((const LAS float*)(sl + tk * 256 + 128))[lane + 64 * b];
                    const float sdot_ = (tot_sel[tk] + 0.5f * hsum[tk]) * hs_[tk];
                    const float a = gelu_tanh(sdot_ * SU[e]); const float w = g * a * SV[e];
                    if (b) w_hi[tk] = w; else w_lo[tk] = w; tot_sel[tk] = 0.f; } }
        }
#undef UP_LOAD
#undef UP_COMP
    } else
#endif
#if !PEER_U_MFMA || PEER_U_CHECK
#pragma unroll
    for (int b = 0; b < 2; ++b) {
        float tot_sel[NTK];
#pragma unroll
        for (int tk = 0; tk < NTK; ++tk) tot_sel[tk] = 0.f;
#pragma unroll 1
        for (int kb2 = 0; kb2 < 8; kb2 += UPH) {
            u32x4 ua[NTK][8 * UPH];
#pragma unroll
            for (int tk = 0; tk < NTK; ++tk) { const int eb = b ? e_hi[tk] : e_lo[tk];
#pragma unroll
                for (int j = 0; j < 8 * UPH; ++j) { const int e = __builtin_amdgcn_readlane(eb, kb2 * 8 + j) & (PROBE == 1 ? 255 : -1); ua[tk][j] = *(const u32x4*)(UB + (size_t)e * 1024 + lane * 16); } }
            __builtin_amdgcn_sched_barrier(0);
#pragma unroll
            for (int hf = 0; hf < UPH; ++hf) { const int kb = kb2 + hf;
#pragma unroll
            for (int tk = 0; tk < NTK; ++tk) {
                float p[8];
#pragma unroll
                for (int j = 0; j < 8; ++j) { if (PROBE == 2) p[j] = __uint_as_float((ua[tk][8 * hf + j].x ^ ua[tk][8 * hf + j].y ^ ua[tk][8 * hf + j].z ^ ua[tk][8 * hf + j].w) & 0x3fffffffu); else p[j] = PEER_U_INT4 ? dot32_i4(ua[tk][8 * hf + j], hdh[tk], hdl[tk]) : dot32_fp4_bf(ua[tk][8 * hf + j], hr[tk], 0.f); __builtin_amdgcn_sched_barrier(0); }
                float q[4], r[2], z;
#pragma unroll
                for (int j = 0; j < 4; ++j) { const float s_ = (lane & 32) ? p[j] : p[j + 4], k_ = (lane & 32) ? p[j + 4] : p[j]; q[j] = k_ + __shfl_xor(s_, 32); }
#pragma unroll
                for (int j = 0; j < 2; ++j) { const float s_ = (lane & 16) ? q[j] : q[j + 2], k_ = (lane & 16) ? q[j + 2] : q[j]; r[j] = k_ + __shfl_xor(s_, 16); }
                { const float s_ = (lane & 8) ? r[0] : r[1], k_ = (lane & 8) ? r[1] : r[0]; z = k_ + __shfl_xor(s_, 8); }
                z += __shfl_xor(z, 4); z += __shfl_xor(z, 2); z += __shfl_xor(z, 1);
                const float mine = __shfl(z, (lane & 7) << 3);
                if ((lane >> 3) == kb) tot_sel[tk] = mine;
                __builtin_amdgcn_sched_barrier(0);
            }
            }
        }
#pragma unroll
        for (int tk = 0; tk < NTK; ++tk) { const int e = b ? e_hi[tk] : e_lo[tk]; const float g = ((const LAS float*)(sl + tk * 256 + 128))[lane + 64 * b];
            const float sdot_ = PEER_U_INT4 ? (tot_sel[tk] + 0.5f * hsum[tk]) * hs_[tk] : tot_sel[tk];
            const float a = gelu_tanh(sdot_ * SU[e]); float w = g * a * SV[e];
            if (PROBE) { float z_ = 0.f; asm volatile("" : "+v"(z_)); w *= z_; }
#if PEER_U_CHECK
            { const float ref = tot_sel[tk], got = ((const LAS float*)(F.lds + 32768 + F.wave * 8192 + 4096))[tk * 128 + 64 * b + lane]; float er = fabsf(got - ref) / (fabsf(ref) + 2.0f * sqrtf((float)DM) * 0.05f);
              er = fminf(er, 1.0f);
#pragma unroll
              for (int o = 1; o < 64; o <<= 1) er = fmaxf(er, __shfl_xor(er, o));
              if (lane == 0) __hip_atomic_fetch_max(F.ctl + CW_WAMAX + 24, __float_as_uint(er), __ATOMIC_RELAXED, __HIP_MEMORY_SCOPE_AGENT); }
#if PEER_U_CHECK == 2
            if (b == 0 && tk == 0) { const LAS float* sr2 = (const LAS float*)(F.lds + 32768 + F.wave * 8192 + 4096);
#pragma unroll
                for (int hyp = 0; hyp < 4; ++hyp) { const float ref = tot_sel[0], got = sr2[512 + 16 * hyp + (lane & 15)] * sr2[600];
                    float er = (lane < 16) ? fminf(fabsf(got - ref) / (fabsf(ref) + 4.5f), 1.0f) : 0.f;
#pragma unroll
                    for (int o = 1; o < 64; o <<= 1) er = fmaxf(er, __shfl_xor(er, o));
                    if (lane == 0) __hip_atomic_fetch_max(F.ctl + CW_WAMAX + 25 + hyp, __float_as_uint(er), __ATOMIC_RELAXED, __HIP_MEMORY_SCOPE_AGENT); } }
#endif
#endif
            if (b) w_hi[tk] = w; else w_lo[tk] = w; }
    }
#endif
    } else {
#pragma unroll
        for (int tk = 0; tk < NTK; ++tk) { e_lo[tk] = sl[tk * 256 + lane]; e_hi[tk] = sl[tk * 256 + 64 + lane];
            w_lo[tk] = ((const LAS float*)(sl + tk * 256 + 128))[lane]; w_hi[tk] = ((const LAS float*)(sl + tk * 256 + 128))[lane + 64]; }
    }
    if constexpr (MODE == 1) {
#pragma unroll
        for (int tk = 0; tk < NTK; ++tk) { ((LAS float*)(sl + tk * 256 + 128))[lane] = w_lo[tk]; ((LAS float*)(sl + tk * 256 + 128))[lane + 64] = w_hi[tk]; }
        asm volatile("s_waitcnt lgkmcnt(0)" ::: "memory");
        return;
    }
    __builtin_amdgcn_sched_barrier(0);
    f32x2 acc[NTK][16];
#pragma unroll
    for (int tk = 0; tk < NTK; ++tk)
#pragma unroll
        for (int i = 0; i < 16; ++i) acc[tk][i] = (f32x2){0.f, 0.f};
    __builtin_amdgcn_sched_barrier(0);
#if PEER_PIPE
    if constexpr (PROBE == 0) {
#define VP_LOAD(VA, S) do { const int b_ = (S) >> 3, kb_ = (S) & 7; _Pragma("unroll") for (int tk = 0; tk < NTK; ++tk) { const int eb = b_ ? e_hi[tk] : e_lo[tk]; \
            _Pragma("unroll") for (int j = 0; j < 8; ++j) { const int e = __builtin_amdgcn_readlane(eb, kb_ * 8 + j); VA[tk][j] = *(const u32x4*)(VB + (size_t)e * 1024 + lane * 16); } } } while (0)
#define VP_COMP(VA, S) do { const int b_ = (S) >> 3, kb_ = (S) & 7; _Pragma("unroll") for (int tk = 0; tk < NTK; ++tk) { const float wb = b_ ? w_hi[tk] : w_lo[tk]; \
            _Pragma("unroll") for (int j = 0; j < 8; ++j) { const float wj = __builtin_bit_cast(float, __builtin_amdgcn_readlane(__builtin_bit_cast(int, wb), kb_ * 8 + j)); \
                axpy32_fp4(VA[tk][j], wj, acc[tk]); __builtin_amdgcn_sched_barrier(0); } } } while (0)
        u32x4 vaA[NTK][8], vaB[NTK][8];
        VP_LOAD(vaA, 0); __builtin_amdgcn_sched_barrier(0);
#pragma unroll 1
        for (int it = 0; it < 8; ++it) { const int s2 = 2 * it;
            VP_LOAD(vaB, s2 + 1); __builtin_amdgcn_sched_barrier(0);
            VP_COMP(vaA, s2); __builtin_amdgcn_sched_barrier(0);
            { const int sn = (s2 + 2 < 16) ? s2 + 2 : s2; VP_LOAD(vaA, sn); } __builtin_amdgcn_sched_barrier(0);
            VP_COMP(vaB, s2 + 1); __builtin_amdgcn_sched_barrier(0);
        }
#undef VP_LOAD
#undef VP_COMP
    } else
#endif
#pragma unroll
    for (int b = 0; b < 2; ++b) {
#pragma unroll 1
        for (int kb = 0; kb < 8; ++kb) {
            u32x4 va[NTK][8];
#pragma unroll
            for (int tk = 0; tk < NTK; ++tk) { const int eb = b ? e_hi[tk] : e_lo[tk];
#pragma unroll
                for (int j = 0; j < 8; ++j) { const int e = __builtin_amdgcn_readlane(eb, kb * 8 + j) & (PROBE == 1 ? 255 : -1); va[tk][j] = *(const u32x4*)(VB + (size_t)e * 1024 + lane * 16); } }
            __builtin_amdgcn_sched_barrier(0);
#pragma unroll
            for (int tk = 0; tk < NTK; ++tk) { const float wb = b ? w_hi[tk] : w_lo[tk];
#pragma unroll
                for (int j = 0; j < 8; ++j) { const float wj = __builtin_bit_cast(float, __builtin_amdgcn_readlane(__builtin_bit_cast(int, wb), kb * 8 + j)); if (PROBE == 2) { acc[tk][j & 7][0] += wj * __uint_as_float((va[tk][j].x ^ va[tk][j].y ^ va[tk][j].z ^ va[tk][j].w) & 0x3fffffffu); } else axpy32_fp4(va[tk][j], wj, acc[tk]); __builtin_amdgcn_sched_barrier(0); } }
        }
    }
    if (PROBE) {
        float sum = 0.f;
#pragma unroll
        for (int tk = 0; tk < NTK; ++tk)
#pragma unroll
            for (int i = 0; i < 16; ++i) sum += acc[tk][i][0] + acc[tk][i][1];
        if (sum == 123456.f) ((float*)(F.ws + WS_MODP))[lane] = sum;
        return; }
#pragma unroll
    for (int tk = 0; tk < NTK; ++tk) peer_finish_token(F, l, t0 + tk * tstride, lane, acc[tk]);
}

#if DIAG
#ifndef DIAG_AMP
#define DIAG_AMP 1.0f
#endif
constexpr int CW_DG = 32768;
__device__ __constant__ const int DG_ROWS[16] = {0, 5, 63, 64, 255, 256, 257, 1000, 2047, 2048, 4095, 4096, 5000, 8000, 8190, 8191};
__device__ __forceinline__ float fp8f(unsigned char b) { return __builtin_amdgcn_cvt_pk_f32_fp8((int)b, false)[0]; }
__device__ __forceinline__ void dg_add(Frame& F, int k, float d2, float r2) {
    d2 = wave_sum(d2); r2 = wave_sum(r2);
    if (LANE_ == 0) { atomicAdd((float*)(F.ctl + CW_DG) + 2 * k, d2); atomicAdd((float*)(F.ctl + CW_DG) + 2 * k + 1, r2); }
}
__device__ __forceinline__ void dg_attn(Frame& F, int kind, int ri, int hd) {
    LAS float* L = (LAS float*)F.lds;
    const int lane = LANE_, t = DG_ROWS[ri];
    const bf16_t* Z = (const bf16_t*)(F.ws + WS_Z); const float* nF = (const float*)(F.ws + WS_FCUM) + (size_t)hd * S;
    const unsigned long long* MK = (const unsigned long long*)(F.ws + WS_MASK) + (size_t)t * 128;
    const bf16_t* ZH = (const bf16_t*)(F.ws + WS_ZH); const int hb = kind ? 18 : 0;
    const bf16_t* Qp = ZH + (size_t)(hb + hd) * S * 128; const bf16_t* Kp = ZH + (size_t)(hb + 6 + hd) * S * 128; const bf16_t* Vp = ZH + (size_t)(hb + 12 + hd) * S * 128;
    float mx = -3.0e38f; int cnt = 0, bad = 0;
    for (int j = lane; j < S; j += 64) {
        float lg = -3.0e38f; bool on = j <= t;
        if (kind) { const bool bit = (MK[j >> 6] >> (j & 63)) & 1ull; if (bit) { ++cnt; if (j > t) ++bad; } on = on && bit; }
        if (on) { float a = 0.f; for (int d = 0; d < 128; ++d) a += bf2f(Qp[(size_t)t * 128 + d]) * bf2f(Kp[(size_t)j * 128 + d]);
            lg = a * 0.08838834764831845f; if (!kind) lg += (nF[j] - nF[t]) * 0.08838834764831845f; }
        L[j] = lg; mx = fmaxf(mx, lg); }
#pragma unroll
    for (int o = 1; o < 64; o <<= 1) mx = fmaxf(mx, __shfl_xor(mx, o));
    float sm = 0.f;
    for (int j = lane; j < S; j += 64) { const float p = L[j] > -1.0e38f ? __expf(L[j] - mx) : 0.f; L[j] = p; sm += p; }
    sm = wave_sum(sm);
    asm volatile("s_waitcnt lgkmcnt(0)" ::: "memory");
    float o0 = 0.f, o1 = 0.f;
    for (int j = 0; j <= t; ++j) { const float p = L[j]; if (p != 0.f) { o0 += p * bf2f(Vp[(size_t)j * 128 + lane]); o1 += p * bf2f(Vp[(size_t)j * 128 + 64 + lane]); } }
    o0 /= sm; o1 /= sm;
    const bf16_t* MX = (const bf16_t*)(F.ws + WS_MIX) + (size_t)t * DM + (kind ? 1280 : 0) + hd * 128;
    const float m0 = bf2f(MX[lane]), m1 = bf2f(MX[64 + lane]);
    dg_add(F, kind, (m0 - o0) * (m0 - o0) + (m1 - o1) * (m1 - o1), o0 * o0 + o1 * o1);
    if (kind) { const int want = (t + 1 < 256) ? t + 1 : 256; cnt = (int)wave_sum((float)cnt); bad = (int)wave_sum((float)bad);
        if (hd == 0) dg_add(F, 2, (lane == 0) ? (float)((cnt - want) * (cnt - want) + bad) : 0.f, (lane == 0) ? (float)(want * want) : 0.f); }
}
__device__ __forceinline__ void dg_gla(Frame& F, int l, int h, int dv0) {
    const int tid = TID_, dk = tid & 127, dvs = tid >> 7, dv = dv0 + dvs;
    const bf16_t* Z = (const bf16_t*)(F.ws + WS_Z); const float* zs = (const float*)(F.ws + WS_ZS);
    LAS float* red = (LAS float*)F.lds;
    const float* wa = inp(I_GLA_WA2) + (size_t)l * 16 * 512 + h * 128 + dk; const float ba = inp(I_GLA_BA)[(size_t)l * 512 + h * 128 + dk];
    float st = 0.f; int ri = 0;
    for (int t = 0; t < S; ++t) {
        float x = ba; for (int r = 0; r < 16; ++r) x += zs[(size_t)t * 64 + ZS_GA + r] * wa[(size_t)r * 512];
        const float la = logsigmoidf(x) * 0.0625f;
        const float k = bf2f(Z[(size_t)t * LDZ + ZC_GK + h * 128 + dk]), v = bf2f(Z[(size_t)t * LDZ + ZC_GV + h * 128 + dv]);
        st = __expf(la) * st + k * v;
        if (ri < 16 && t == DG_ROWS[ri]) {
            const float q = bf2f(Z[(size_t)t * LDZ + ZC_GQ + h * 128 + dk]) * 0.08838834764831845f;
            __syncthreads(); red[tid] = q * st; __syncthreads();
            if (dk == 0) { float o = 0.f; for (int i = 0; i < 128; ++i) o += red[dvs * 128 + i]; ((float*)(F.ws + WS_UT))[((size_t)ri * 4 + h) * 128 + dv] = o; }
            ++ri; }
    }
}
__device__ __forceinline__ void dg_gla_cmp(Frame& F, int l, int ri, int h) {
    const int lane = LANE_, t = DG_ROWS[ri]; const float* go = (const float*)(F.ws + WS_UT) + ((size_t)ri * 4 + h) * 128;
    const float a0 = go[lane], a1 = go[64 + lane]; const float rstd = rsqrtf(wave_sum(a0 * a0 + a1 * a1) * (1.f / 128.f) + 1e-6f);
    const bf16_t* Z = (const bf16_t*)(F.ws + WS_Z) + (size_t)t * LDZ + ZC_GR + h * 128; const float* gn = inp(I_GLA_NORM_G) + (size_t)l * 128;
    const float y0 = a0 * rstd * gn[lane] * siluf(bf2f(Z[lane])), y1 = a1 * rstd * gn[64 + lane] * siluf(bf2f(Z[64 + lane]));
    const bf16_t* MX = (const bf16_t*)(F.ws + WS_MIX) + (size_t)t * DM + 768 + h * 128; const float m0 = bf2f(MX[lane]), m1 = bf2f(MX[64 + lane]);
    dg_add(F, 3, (m0 - y0) * (m0 - y0) + (m1 - y1) * (m1 - y1), y0 * y0 + y1 * y1);
}
__device__ __forceinline__ void dg_topk(Frame& F, int l, int ri, int h) {
    LAS float* L = (LAS float*)F.lds;
    const int lane = LANE_, t = DG_ROWS[ri];
    const bf16_t* QP = (const bf16_t*)(F.ws + WS_QP) + (size_t)t * DM + h * 256; const bf16_t* K1 = (const bf16_t*)(F.ws + WS_KB) + ((size_t)l * 8 + h) * 128 * 128; const bf16_t* K2 = K1 + 2 * 8 * 128 * 128;
    for (int half = 0; half < 2; ++half) for (int n = lane; n < 128; n += 64) { float a = 0.f; const bf16_t* K = half ? K2 : K1;
        for (int d = 0; d < 128; ++d) a += bf2f(QP[half * 128 + d]) * bf2f(K[(size_t)n * 128 + d]); L[half * 128 + n] = a; }
    asm volatile("s_waitcnt lgkmcnt(0)" ::: "memory");
    for (int half = 0; half < 2; ++half) for (int n = lane; n < 128; n += 64) { const float v = L[half * 128 + n]; int rk = 0;
        for (int m = 0; m < 128; ++m) { const float u = L[half * 128 + m]; rk += (u > v || (u == v && m < n)) ? 1 : 0; }
        if (rk < 16) { L[256 + half * 16 + rk] = v; L[288 + half * 16 + rk] = (float)n; } }
    asm volatile("s_waitcnt lgkmcnt(0)" ::: "memory");
    for (int c = lane; c < 256; c += 64) L[320 + c] = L[256 + (c >> 4)] + L[272 + (c & 15)];
    asm volatile("s_waitcnt lgkmcnt(0)" ::: "memory");
    for (int c = lane; c < 256; c += 64) { const float v = L[320 + c]; int rk = 0;
        for (int m = 0; m < 256; ++m) { const float u = L[320 + m]; rk += (u > v || (u == v && m < c)) ? 1 : 0; }
        if (rk < 16) { L[576 + rk] = v; L[592 + rk] = L[288 + (c >> 4)] * 128.f + L[304 + (c & 15)]; } }
    asm volatile("s_waitcnt lgkmcnt(0)" ::: "memory");
    const int* EI = (const int*)(F.ws + WS_EIDX) + ((size_t)t * 8 + h) * 16; const float* GT = (const float*)(F.ws + WS_GATE) + ((size_t)t * 8 + h) * 16;
    float d2 = 0.f, r2 = 0.f;
    if (lane < 16) { float sm = 0.f; for (int i = 0; i < 16; ++i) sm += __expf(L[576 + i] - L[576]); const float g = __expf(L[576 + lane] - L[576]) / sm; const int e = (int)L[592 + lane];
        float gk = 0.f; for (int i = 0; i < 16; ++i) if (EI[i] == e) gk = GT[i];
        d2 = (gk - g) * (gk - g); r2 = g * g; }
    dg_add(F, 4, d2, r2);
}
__device__ __forceinline__ void dg_gather(Frame& F, int l, int ri) {
    const int lane = LANE_, t = DG_ROWS[ri];
    const int* EI = (const int*)(F.ws + WS_EIDX) + (size_t)t * 128; const float* GT = (const float*)(F.ws + WS_GATE) + (size_t)t * 128;
    const unsigned char* UB = (const unsigned char*)(F.ws + WS_UB) + (size_t)l * 16384 * 2048; const unsigned char* VB = (const unsigned char*)(F.ws + WS_VB) + (size_t)l * 16384 * 2048;
    const float* SU = (const float*)(F.ws + WS_SU) + (size_t)l * 16384; const float* SV = (const float*)(F.ws + WS_SV) + (size_t)l * 16384;
    const bf16_t* H = (const bf16_t*)(F.ws + WS_H) + (size_t)t * DM; const float* X = (const float*)(F.ws + WS_X) + (size_t)t * DM; const float* mod = (const float*)(F.ws + WS_MOD) + (size_t)l * NMOD;
    float acc[32];
    for (int i = 0; i < 32; ++i) acc[i] = 0.f;
    for (int k = 0; k < 128; ++k) { const int e = EI[k]; float a = 0.f;
        for (int i = 0; i < 32; ++i) a += bf2f(H[lane + 64 * i]) * fp8f(UB[(size_t)e * 2048 + lane + 64 * i]);
        a = wave_sum(a) * SU[e]; const float w = GT[k] * gelu_tanh(a) * SV[e];
        for (int i = 0; i < 32; ++i) acc[i] += w * fp8f(VB[(size_t)e * 2048 + lane + 64 * i]); }
    float ss = 0.f;
    for (int i = 0; i < 32; ++i) { acc[i] = X[lane + 64 * i] + mod[5 * DM + lane + 64 * i] * acc[i]; ss += acc[i] * acc[i]; }
    const float rstd = rsqrtf(wave_sum(ss) * (1.f / DM) + 1e-6f); float d2 = 0.f, r2 = 0.f;
    for (int i = 0; i < 32; ++i) { const float y = acc[i] * rstd * inp(I_FINAL_G)[lane + 64 * i], o = outp()[(size_t)t * DM + lane + 64 * i]; d2 += (o - y) * (o - y); r2 += y * y; }
    dg_add(F, 5, d2, r2);
}
__device__ __forceinline__ void dg_gemm(Frame& F, int l, int ri) {
    const int lane = LANE_, t = DG_ROWS[ri]; const bf16_t* H = (const bf16_t*)(F.ws + WS_H) + (size_t)t * DM; const bf16_t* W = (const bf16_t*)(F.ws + WS_WQ) + (size_t)l * DM * DM;
    float d2 = 0.f, r2 = 0.f;
    for (int c = lane; c < DM; c += 64 * 7) { float a = 0.f; for (int k = 0; k < DM; ++k) a += bf2f(H[k]) * bf2f(W[(size_t)c * DM + k]);
        const float o = bf2f(((const bf16_t*)(F.ws + WS_QP))[(size_t)t * DM + c]); d2 += (o - a) * (o - a); r2 += a * a; }
    dg_add(F, 6, d2, r2);
}
__device__ __forceinline__ void dg_index(Frame& F, int ri) {
    LAS float* L = (LAS float*)F.lds + 16384;
    const int lane = LANE_, t = DG_ROWS[ri];
    const bf16_t* Z = (const bf16_t*)(F.ws + WS_Z); const float* zs = (const float*)(F.ws + WS_ZS);
    const unsigned long long* MK = (const unsigned long long*)(F.ws + WS_MASK) + (size_t)t * 128;
    for (int j = lane; j <= t; j += 64) { float sc = 0.f;
        for (int h = 0; h < 16; ++h) { float a = 0.f; for (int d = 0; d < 64; ++d) a += bf2f(Z[(size_t)t * LDZ + ZC_IQ + h * 64 + d]) * bf2f(Z[(size_t)j * LDZ + ZC_IK + d]);
            sc += fmaxf(a, 0.f) * (zs[(size_t)t * 64 + ZS_IW + h] * 0.03125f); }
        L[j] = sc; }
    asm volatile("s_waitcnt lgkmcnt(0)" ::: "memory");
    int mism = 0; const int want = (t + 1 < 256) ? t + 1 : 256;
    for (int j = lane; j <= t; j += 64) { const float v = L[j]; int rk = 0;
        for (int m = 0; m <= t; ++m) { const float u = L[m]; rk += (u > v || (u == v && m < j)) ? 1 : 0; }
        const bool sel = rk < 256, bit = (MK[j >> 6] >> (j & 63)) & 1ull; mism += (sel != bit) ? 1 : 0; }
    mism = (int)wave_sum((float)mism);
    dg_add(F, 7, (lane == 0) ? (float)(mism * mism) : 0.f, (lane == 0) ? (float)(4 * want * want) : 0.f);
}
__device__ __forceinline__ void diag_phase(Frame& F, XcdBarrier& bar) {
    const int l = DEPTH - 1, b = blockIdx.x;
    xcd_barrier(bar);
    if (b < 128) { dg_gla(F, l, b >> 5, (b & 31) * 4); }
    else { const int i0 = b - 128;
        if (F.wave == 0) for (int it = i0; it < 16 * 6 * 2 + 16 * 8; it += 128) {
            if (it < 192) dg_attn(F, it / 96, (it % 96) / 6, it % 6); else dg_topk(F, l, (it - 192) >> 3, (it - 192) & 7); }
        if (F.wave == 1) for (int it = i0; it < 32; it += 128) { if (it < 16) dg_gather(F, l, it); else dg_gemm(F, l, it - 16); }
        if (F.wave == 2) for (int it = i0; it < 16; it += 128) dg_index(F, it); }
    xcd_barrier(bar);
    if (b < 8 && F.wave < 8) { const int it = b * 8 + F.wave; dg_gla_cmp(F, l, it >> 2, it & 3); }
    xcd_barrier(bar);
    const float* DG = (const float*)(F.ctl + CW_DG); float worst = 0.f;
    for (int k = 0; k < 8; ++k) if ((DIAG >> k) & 1) { const float d2 = __hip_atomic_load(DG + 2 * k, __ATOMIC_RELAXED, __HIP_MEMORY_SCOPE_AGENT), r2 = __hip_atomic_load(DG + 2 * k + 1, __ATOMIC_RELAXED, __HIP_MEMORY_SCOPE_AGENT);
        worst = fmaxf(worst, sqrtf(d2 / fmaxf(r2, 1e-30f))); }
    const float sc = 1.f + DIAG_AMP * worst; float* O = outp();
    for (size_t i = (size_t)b * 512 + TID_; i < (size_t)S * DM; i += (size_t)F.G * 512) O[i] *= sc;
}
#endif

constexpr int PG_ITEMS = 256 + 32 * 31, PG_LAG = 2, CW_PANEL = 45056;
struct PgTab { unsigned short v[PG_ITEMS]; };
constexpr PgTab make_pg_tab() { PgTab t{}; int n = 0;
    for (int r = 0; r < 32 + PG_LAG; ++r) { int np = (r < 32) ? 8 : 0, ng = (r >= PG_LAG) ? 31 : 0, ip = 0, ig = 0;
        for (int k = 0; ip < np || ig < ng; ++k) { const bool wantp = (k % 5 == 0);
            if ((wantp && ip < np) || ig >= ng) { t.v[n++] = (unsigned short)(r * 8 + ip); ++ip; }
            else { t.v[n++] = (unsigned short)(0x8000 | ((r - PG_LAG) << 5) | ig); ++ig; } } }
    return t; }
__constant__ const PgTab PGTAB = make_pg_tab();
__device__ __forceinline__ void xcd_barrier_bg(const XcdBarrier& b, Frame& F, int bidx) {
    asm volatile("s_waitcnt vmcnt(0)" ::: "memory");
    __syncthreads();
    if (threadIdx.x == 0) {
        unsigned* bar = b.bar;
        __builtin_amdgcn_s_waitcnt(0);
        unsigned nloc = b.st[0], nx = b.st[1];
        if (nloc == 0u) { xcd_barrier_complete(bar, b.x, nloc, nx); b.st[0] = nloc; b.st[1] = nx; }
        const unsigned old = xb_add(&bar[XB_XSUB(b.x)], 1u);
        const unsigned gen = old / nloc;
        if (old + 1u == (gen + 1u) * nloc) {
            __builtin_amdgcn_fence(__ATOMIC_RELEASE, "agent");
            asm volatile("s_waitcnt vmcnt(0)" ::: "memory");
            const unsigned og = xb_add(&bar[XB_TOP], 1u);
            const unsigned tg = og / nx;
            if (og + 1u == (tg + 1u) * nx) xb_add(&bar[XB_TOPGEN], 1u);
            else XB_SPIN(xb_ld(&bar[XB_TOPGEN]) == tg, bar);
            __builtin_amdgcn_fence(__ATOMIC_ACQUIRE, "agent");
            xb_add(&bar[XB_XGEN(b.x)], 1u);
            asm volatile("s_waitcnt vmcnt(0)" ::: "memory");
        } else {
            XB_SPIN(xb_ld(&bar[XB_XGEN(b.x)]) == gen, bar);
            __builtin_amdgcn_fence(__ATOMIC_ACQUIRE, "agent");
            asm volatile("s_waitcnt vmcnt(0)" ::: "memory");
        }
    } else if (F.wave != 0) conv_shadow(F, bidx);
    __syncthreads();
}
constexpr int PH_PRO = 3, PH_PER_LAYER = 8, N_PHASES = PH_PRO + DEPTH * PH_PER_LAYER;

#ifndef LB_T
#define LB_T (NWAVES * 64)
#endif
__global__ void __launch_bounds__(LB_T, 1) mega_fwd(Args args) {
    extern __shared__ __attribute__((aligned(16))) unsigned char lds_raw[];
    Frame F;
    F.lds = (LAS unsigned char*)lds_raw; F.MISC = (volatile LAS unsigned*)(F.lds + MISC_OFF);
    F.wave = __builtin_amdgcn_readfirstlane(TID_ >> 6);
    F.G = gridDim.x; F.gw = blockIdx.x * NWAVES + F.wave; F.NGW = F.G * NWAVES;
    F.ws = (GAS unsigned char*)args.ws; F.ctl = (unsigned*)(F.ws + WS_CTL);
    if (TID_ < 64) F.MISC[TID_] = 0u;
    __syncthreads();
    const int lo = args.ph_lo, hi = args.ph_hi;
    XcdBarrier bar; bar.bar = (unsigned*)F.ctl + CW_BAR; bar.x = 0; bar.st = nullptr;
    if (hi - lo > 1) bar = xcd_barrier_post((unsigned*)F.ctl + CW_BAR, F.MISC + 8);
#define IN(k) (lo <= (k) && (k) < hi)
#if REPEAT_N > 1
#define REPS(k) (((k) == REPEAT_PHASE) ? REPEAT_N : 1)
#define REPBAR() xcd_barrier(bar)
#else
#define REPS(k) 1
#define REPBAR() do {} while (0)
#endif
    const bool conv_sh = CONV_SHADOW && CONV_IN_QUEUES && (hi - lo == N_PHASES) && (F.G == 256) && (REPEAT_N == 1);
    F.nconv = (CONV_IN_QUEUES && !conv_sh) ? CONV_ITEMS : 0;
    int bar_idx = 0;
#define SEAM(k) do { if (IN(k) && IN((k) + 1)) { if (conv_sh && bar_idx < 10) xcd_barrier_bg(bar, F, bar_idx); else xcd_barrier(bar); ++bar_idx; } } while (0)

    if (IN(0)) for (int rep_ = 0; rep_ < REPS(0); ++rep_) { if (rep_) REPBAR();
#if EN_PRO
 p0a_prologue(F);
#endif
 } SEAM(0);
    if (IN(1)) for (int rep_ = 0; rep_ < REPS(1); ++rep_) { if (rep_) REPBAR(); p0b_modreduce(F); } SEAM(1);
    if (IN(2)) for (int rep_ = 0; rep_ < REPS(2); ++rep_) { if (rep_) REPBAR(); const float* mod = (const float*)(F.ws + WS_MOD);
#if WIN_FP8
        if (S % (4 * F.NGW) == 0 && WIN_BF16_TILES == 0) { for (int m = F.gw; m < S; m += 4 * F.NGW) norm_rows<4, true>(inp(I_X), m, F.NGW, inp(I_NORM1_G), mod + DM, mod, nullptr, (unsigned char*)(F.ws + WS_H8), (float*)(F.ws + WS_SA), LANE_); }
        else for (int m = F.gw; m < S; m += F.NGW) norm_row_f8(inp(I_X) + (size_t)m * DM, inp(I_NORM1_G), mod + DM, mod, (unsigned char*)(F.ws + WS_H8) + (size_t)m * DM, (float*)(F.ws + WS_SA) + m, (bf16_t*)(F.ws + WS_H) + (size_t)m * DM, WIN_BF16_TILES != 0, LANE_); } SEAM(2);
#else
        for (int m = F.gw; m < S; m += F.NGW) norm_row(inp(I_X) + (size_t)m * DM, inp(I_NORM1_G), mod + DM, mod, (bf16_t*)(F.ws + WS_H) + (size_t)m * DM, nullptr, LANE_); } SEAM(2);
#endif

#pragma unroll 1
    for (int l = 0; l < DEPTH; ++l) {
        { F.wave = __builtin_amdgcn_readfirstlane(TID_ >> 6);
          int b_ = blockIdx.x; asm volatile("" : "+s"(b_)); F.gw = b_ * NWAVES + F.wave; }
        { GAS unsigned char* wsl = (GAS unsigned char*)args.ws; asm volatile("" : "+s"(wsl)); F.ws = wsl; }
        const int pb = PH_PRO + l * PH_PER_LAYER; const float* mod = (const float*)(F.ws + WS_MOD) + (size_t)l * NMOD;
        if (IN(pb + 0) && !(FUSE_PG && l > 0)) for (int rep_ = 0; rep_ < REPS(pb + 0); ++rep_) { if (rep_) REPBAR();
            pg8::StaticOrder So; So.init(S, LDZ, F.G, (int)blockIdx.x);
#if EN_GEMM
#if WIN_FP8
            constexpr unsigned MB = WIN_BF16_TILES & 0x7fffffffu, M8 = ~MB & 0x7fffffffu; constexpr int NB = __builtin_popcount(MB), N8T = 31 - NB;
            int G_ = F.G, c_ = blockIdx.x; asm volatile("" : "+s"(G_), "+s"(c_));
            { pg8::Gemm gb{(const bf16_t*)(F.ws + WS_H), (const bf16_t*)(F.ws + WS_WIN) + (size_t)l * LDZ * DM, S, LDZ, DM};
              pg8::EpiZ Eb{(bf16_t*)(F.ws + WS_Z), (float*)(F.ws + WS_ZS), LDZ, (bf16_t*)(F.ws + WS_ZH), nullptr, 1.f};
              pg8::SubsetOrder Sb; Sb.o.init(S, NB * 256, G_, c_); Sb.mask = MB;
              pg8::gemm_phase<pg8::EpiZ, pg8::SubsetOrder, true, true>(F.lds, gb, Sb, Eb); }
#if STAGGER_PROBE
            if (bar.x & 1) { for (int i_ = 0; i_ < STAGGER_PROBE; ++i_) __builtin_amdgcn_s_sleep(127); }
#endif
            if (N8T > 0) {
            pg8::Gemm g{(const bf16_t*)(F.ws + WS_H8), (const bf16_t*)(F.ws + WS_WIN8 + (size_t)l * LDZ * DM), S, LDZ, DM / 2};
            const float wam = __uint_as_float(__hip_atomic_load(F.ctl + CW_WAMAX + l, __ATOMIC_RELAXED, __HIP_MEMORY_SCOPE_AGENT));
            pg8::EpiZ E{(bf16_t*)(F.ws + WS_Z), (float*)(F.ws + WS_ZS), LDZ, (bf16_t*)(F.ws + WS_ZH), (const float*)(F.ws + WS_SA), wam > 0.f ? wam * (1.f / 448.f) : 1.f};
#if EPI_PROBE
            E.skip = (rep_ == 0) && (REPS(pb + 0) > 1);
#if EPI_PROBE == 2
            if (E.skip) g.K = DM / 4;
#endif
#endif
            pg8::SplitOrder So2; So2.o.init(S, N8T * 256, G_, c_); So2.mask = M8;
            const int r0 = (32 * NB) % G_, ok8 = (r0 % 8 == 0) && ((G_ - r0) % 8 == 0);
            So2.nlight = ok8 ? r0 : 0; So2.kheavy = (32 * N8T + 2 * So2.nlight + G_ - 1) / G_; So2.klight = So2.kheavy - 2;
            pg8::gemm_phase<pg8::EpiZ, pg8::SplitOrder, true, true, true>(F.lds, g, So2, E); }
#else
            pg8::Gemm g{(const bf16_t*)(F.ws + WS_H), (const bf16_t*)(F.ws + WS_WIN) + (size_t)l * LDZ * DM, S, LDZ, DM};
            pg8::EpiZ E{(bf16_t*)(F.ws + WS_Z), (float*)(F.ws + WS_ZS), LDZ, (bf16_t*)(F.ws + WS_ZH), nullptr, 1.f};
            pg8::gemm_phase<pg8::EpiZ, pg8::StaticOrder, true, true>(F.lds, g, So, E);
#endif
#endif
 } if (!(FUSE_PG && l > 0)) SEAM(pb + 0);
        if (IN(pb + 1)) for (int rep_ = 0; rep_ < REPS(pb + 1); ++rep_) { if (rep_) REPBAR(); const int q = 2 * l + 8 * rep_;
            for (int it = deq(F, q); it < N_IDX_ITEMS + 513 + 64 + F.nconv; it = deq(F, q)) {
                if (it == 0) fox_cumsum_item(F, l);
                else if (it <= 512) {
#if EN_G1
 for (int rr_ = 0; rr_ < REP_G1; ++rr_) gla_g1_item(F, l, it - 1);
#endif
 } else if (it <= 512 + N_IDX_ITEMS) {
#if EN_IDX
 for (int rr_ = 0; rr_ < REP_IDX; ++rr_) indexer_item(F, it - 513);
#endif
 } else if (it < N_IDX_ITEMS + 513 + 64) fox_norm_item(F, l, it - (N_IDX_ITEMS + 513));
                else conv_item(F, l, 0, it - (N_IDX_ITEMS + 513 + 64)); } } SEAM(pb + 1);
        if (IN(pb + 2)) for (int rep_ = 0; rep_ < REPS(pb + 2); ++rep_) { if (rep_) REPBAR();
#if EN_SEL
 phase_select(F, l * (((S / 2 + F.G - 1) / F.G) + NWAVES));
#endif
 } SEAM(pb + 2);
        if (IN(pb + 3)) for (int rep_ = 0; rep_ < REPS(pb + 3); ++rep_) { if (rep_) REPBAR();
#if EN_ATT
 phase_attn(F, l, 2 * l + 1 + 8 * rep_);
#endif
 } SEAM(pb + 3);
        if (IN(pb + 4)) for (int rep_ = 0; rep_ < REPS(pb + 4); ++rep_) { if (rep_) REPBAR();
            pg8::StaticOrder So; So.init(S, DM, F.G, (int)blockIdx.x);
            const float* xin = l == 0 ? inp(I_X) : (const float*)(F.ws + WS_X);
#if EN_GEMM
#if WO_FP8
            const unsigned ovf = __builtin_amdgcn_readfirstlane(__hip_atomic_load(F.ctl + CW_MIXOVF + l, __ATOMIC_RELAXED, __HIP_MEMORY_SCOPE_AGENT));
            if (ovf == 0u) {
                const float wam = __uint_as_float(__hip_atomic_load(F.ctl + CW_WAMAX + 2 + l, __ATOMIC_RELAXED, __HIP_MEMORY_SCOPE_AGENT));
                pg8::Gemm g{(const bf16_t*)(F.ws + WS_MIX8), (const bf16_t*)(F.ws + WS_WO8 + (size_t)l * DM * DM), S, DM, DM / 2};
                pg8::EpiRes E{xin, (float*)(F.ws + WS_X), mod + 2 * DM, DM, (wam > 0.f ? wam * (1.f / 448.f) : 1.f) * (1.f / MIX_S)};
                pg8::gemm_phase<pg8::EpiRes, pg8::StaticOrder, true, true, true>(F.lds, g, So, E);
            } else
#endif
            { pg8::Gemm g{(const bf16_t*)(F.ws + WS_MIX), (const bf16_t*)(F.ws + WS_WO) + (size_t)l * DM * DM, S, DM, DM};
              pg8::EpiRes E{xin, (float*)(F.ws + WS_X), mod + 2 * DM, DM, 1.f};
              pg8::gemm_phase<pg8::EpiRes, pg8::StaticOrder, true, true>(F.lds, g, So, E); }
#endif
 } SEAM(pb + 4);
        if (IN(pb + 5)) for (int rep_ = 0; rep_ < REPS(pb + 5); ++rep_) { if (rep_) REPBAR(); if (S % (4 * F.NGW) == 0) { for (int m = F.gw; m < S; m += 4 * F.NGW) norm_rows<4, false>((const float*)(F.ws + WS_X), m, F.NGW, inp(I_NORM2_G) + (size_t)l * DM, mod + 4 * DM, mod + 3 * DM, (bf16_t*)(F.ws + WS_H), nullptr, nullptr, LANE_); }
            else for (int m = F.gw; m < S; m += F.NGW) norm_row((const float*)(F.ws + WS_X) + (size_t)m * DM, inp(I_NORM2_G) + (size_t)l * DM, mod + 4 * DM, mod + 3 * DM, (bf16_t*)(F.ws + WS_H) + (size_t)m * DM, nullptr, LANE_); } SEAM(pb + 5);
        if (IN(pb + 6)) for (int rep_ = 0; rep_ < REPS(pb + 6); ++rep_) { if (rep_) REPBAR(); pg8::Gemm g{(const bf16_t*)(F.ws + WS_H), (const bf16_t*)(F.ws + WS_WQ) + (size_t)l * DM * DM, S, DM, DM};
            pg8::StaticOrder So; So.init(S, DM, F.G, (int)blockIdx.x); pg8::EpiBf16<0> E{(bf16_t*)(F.ws + WS_QP), DM, nullptr, 0, 0, 1.f};
#if EN_GEMM
            pg8::gemm_phase<pg8::EpiBf16<0>, pg8::StaticOrder, true, true>(F.lds, g, So, E);
#endif
 } SEAM(pb + 6);
        if (IN(pb + 7)) for (int rep_ = 0; rep_ < REPS(pb + 7); ++rep_) { if (rep_) REPBAR();
#if EN_TOPK && EN_GATHER
            if (FUSE_PG && l + 1 < DEPTH) {
                const int q = 4 + l;
                for (int it = deq(F, q); it < PG_ITEMS; it = deq(F, q)) {
                    const int code = __builtin_amdgcn_readfirstlane((int)PGTAB.v[it]);
                    if (!(code & 0x8000)) { const int tb = code;
                        peer_topk_item(F, l, tb * 8 + F.wave);
                        asm volatile("s_waitcnt vmcnt(0)" ::: "memory"); __syncthreads();
                        peer_gather_group<2>(F, l, tb * 32 + F.wave * 4, 1);
                        peer_gather_group<2>(F, l, tb * 32 + F.wave * 4 + 2, 1);
                        asm volatile("s_waitcnt vmcnt(0)" ::: "memory"); __syncthreads();
                        if (TID_ == 0) { __builtin_amdgcn_fence(__ATOMIC_RELEASE, "agent"); asm volatile("s_waitcnt vmcnt(0)" ::: "memory");
                            __hip_atomic_fetch_add(F.ctl + CW_PANEL + 64 * l + (tb >> 3), 1u, __ATOMIC_RELAXED, __HIP_MEMORY_SCOPE_AGENT); }
                    } else { const int pm = (code & 0x7fff) >> 5, pn = code & 31;
                        if (TID_ == 0) { unsigned sp = 0;
                            while (__hip_atomic_load(F.ctl + CW_PANEL + 64 * l + pm, __ATOMIC_RELAXED, __HIP_MEMORY_SCOPE_AGENT) < 8u) { __builtin_amdgcn_s_sleep(8); if (++sp > (1u << 24)) break; }
                            __builtin_amdgcn_fence(__ATOMIC_ACQUIRE, "agent"); asm volatile("s_waitcnt vmcnt(0)" ::: "memory"); }
                        __syncthreads();
                        pg8::Gemm g{(const bf16_t*)(F.ws + WS_H), (const bf16_t*)(F.ws + WS_WIN) + (size_t)(l + 1) * LDZ * DM, S, LDZ, DM};
                        pg8::OneUnit So{{pm, pn}}; pg8::EpiZ E{(bf16_t*)(F.ws + WS_Z), (float*)(F.ws + WS_ZS), LDZ, (bf16_t*)(F.ws + WS_ZH)};
                        pg8::gemm_phase<pg8::EpiZ, pg8::OneUnit, true, true>(F.lds, g, So, E);
                    }
                }
            } else
            for (int tb = blockIdx.x; tb < S / 32; tb += F.G) {
#if TOPK_PROBE
                peer_topk_item(F, l, tb * 8 + F.wave); __builtin_amdgcn_sched_barrier(0);
#endif
                peer_topk_item(F, l, tb * 8 + F.wave);
                asm volatile("s_waitcnt vmcnt(0)" ::: "memory"); __syncthreads();
#if GATHER_PROBE
                peer_gather_group<2, GATHER_PROBE>(F, l, tb * 32 + F.wave * 4, 1);
                peer_gather_group<2, GATHER_PROBE>(F, l, tb * 32 + F.wave * 4 + 2, 1);
#endif
#if PEER_SWEEP_ALIGN
#if PEER_U4
                peer_gather_group<4, 0, 1>(F, l, tb * 32 + F.wave * 4, 1, 0);
#else
                peer_gather_group<2, 0, 1>(F, l, tb * 32 + F.wave * 4, 1, 0);
                peer_gather_group<2, 0, 1>(F, l, tb * 32 + F.wave * 4 + 2, 1, 1);
#endif
                peer_gather_group<2, 0, 2>(F, l, tb * 32 + F.wave * 4, 1, 0);
                peer_gather_group<2, 0, 2>(F, l, tb * 32 + F.wave * 4 + 2, 1, 1);
#else
                peer_gather_group<2>(F, l, tb * 32 + F.wave * 4, 1);
                peer_gather_group<2>(F, l, tb * 32 + F.wave * 4 + 2, 1);
#endif
                __syncthreads(); }
#endif
        } SEAM(pb + 7);
    }
#if DIAG
    diag_phase(F, bar);
#endif
#undef IN
#undef SEAM
}

extern "C" void kernel_launch(void* const* d_in, const int* in_sizes, int n_in, void* d_out, int out_size, void* d_ws, size_t ws_size, hipStream_t stream) {
    static int grid = 0;
    if (grid == 0) {
        if (n_in != 18 || out_size != S * DM || ws_size < WS_END) { fprintf(stderr, "kernel_launch: unexpected shapes (n_in %d out %d ws %zu)\n", n_in, out_size, ws_size); grid = -1; return; }
        int dev = 0, cus = 0, per_cu = 0;
        if (hipGetDevice(&dev) != hipSuccess || hipDeviceGetAttribute(&cus, hipDeviceAttributeMultiprocessorCount, dev) != hipSuccess) { grid = -1; return; }
        if (hipFuncSetAttribute((const void*)mega_fwd, hipFuncAttributeMaxDynamicSharedMemorySize, LDS_BYTES) != hipSuccess) { fprintf(stderr, "kernel_launch: hipFuncSetAttribute failed\n"); grid = -1; return; }
        if (hipOccupancyMaxActiveBlocksPerMultiprocessor(&per_cu, (const void*)mega_fwd, NWAVES * 64, LDS_BYTES) != hipSuccess || per_cu < 1) { fprintf(stderr, "kernel_launch: occupancy query says %d blocks per CU\n", per_cu); (void)hipGetLastError(); }
        grid = cus;
    }
    if (grid < 0) return;
    (void)in_sizes;
    if (hipMemsetAsync((char*)d_ws + WS_CTL, 0, CTL_ZERO_BYTES, stream) != hipSuccess) { fprintf(stderr, "kernel_launch: memset failed\n"); return; }
    Args a{};
    for (int i = 0; i < 18; ++i) a.in[i] = (const float*)d_in[i];
    a.out = (float*)d_out; a.ws = (unsigned char*)d_ws;
#if MK_MULTI
    for (int ph = 0; ph < N_PHASES; ++ph) { a.ph_lo = ph; a.ph_hi = ph + 1; hipLaunchKernelGGL(mega_fwd, dim3(grid), dim3(NWAVES * 64), LDS_BYTES, stream, a); }
#else
    a.ph_lo = 0; a.ph_hi = N_PHASES;
#if MK_COOP
    void* kargs[] = {(void*)&a};
    hipError_t e = hipLaunchCooperativeKernel((const void*)mega_fwd, dim3(grid), dim3(NWAVES * 64), kargs, LDS_BYTES, stream);
    if (e != hipSuccess) fprintf(stderr, "kernel_launch: cooperative launch failed: %s (grid %d)\n", hipGetErrorString(e), grid);
#else
    hipLaunchKernelGGL(mega_fwd, dim3(grid), dim3(NWAVES * 64), LDS_BYTES, stream, a);
#endif
#endif
}
```
